# Optimizing an MI355X kernel written in HIP

```python
import math
import jax, jax.numpy as jnp
from jax import lax
import numpy as np

D_MODEL = 1024
BATCH = 8
SEQ = 4096
DEPTH = 4

MEM_LEN = 256
SSM_WIDTH = D_MODEL // 2
SSM_GROUP = 16
SSM_GROUPS = SSM_WIDTH // SSM_GROUP
SSM_STATE = 64
DT_MIN = 1e-3
DT_MAX = 1e-1
MLA_HEADS = 8
MLA_NOPE = 64
MLA_ROPE = 32
MLA_V = 64
MLA_Q_RANK = 256
MLA_KV_RANK = 128
MLA_WIDTH = MLA_HEADS * MLA_V
ROPE_THETA = 10000.0
Q_BLOCK = 128
X_HEADS = 4
X_HEAD_DIM = 128
X_WIDTH = X_HEADS * X_HEAD_DIM
N_BRANCH = 3
IN_WIDTHS = (SSM_WIDTH, SSM_WIDTH, MLA_Q_RANK, MLA_KV_RANK, MLA_ROPE, MLA_WIDTH, X_WIDTH, X_WIDTH, N_BRANCH * D_MODEL)
D_IN = sum(IN_WIDTHS)
ALPHA = (2 * DEPTH) ** 0.25
BETA = (8 * DEPTH) ** -0.25
NORM_EPS = 1e-5
POS_OFFSET_MAX = 1024

kernel_name = 'hybrid_s5_mla_memory_gated_deepnorm'


def _layer_norm(x, g, b):
    xf = x.astype(jnp.float32)
    mu = jnp.mean(xf, axis=-1, keepdims=True)
    var = jnp.mean(jnp.square(xf - mu), axis=-1, keepdims=True)
    y = (xf - mu) * lax.rsqrt(var + NORM_EPS) * g.astype(jnp.float32) + b.astype(jnp.float32)
    return y.astype(x.dtype)


def _rms_norm(x, g):
    xf = x.astype(jnp.float32)
    y = xf * lax.rsqrt(jnp.mean(jnp.square(xf), axis=-1, keepdims=True) + NORM_EPS) * g.astype(jnp.float32)
    return y.astype(x.dtype)


def _rope_tables(positions):
    inv_freq = ROPE_THETA ** (-jnp.arange(0, MLA_ROPE, 2, dtype=jnp.float32) / MLA_ROPE)
    ang = positions.astype(jnp.float32)[..., None] * inv_freq
    return jnp.cos(ang)[:, :, None, :], jnp.sin(ang)[:, :, None, :]


def _apply_rope(t, cos, sin):
    tf = t.astype(jnp.float32)
    t1, t2 = jnp.split(tf, 2, axis=-1)
    out = jnp.concatenate([t1 * cos - t2 * sin, t1 * sin + t2 * cos], axis=-1)
    return out.astype(t.dtype)


def _complex_scan_combine(e1, e2):
    a1r, a1i, b1r, b1i = e1
    a2r, a2i, b2r, b2i = e2
    ar = a1r * a2r - a1i * a2i
    ai = a1r * a2i + a1i * a2r
    br = a2r * b1r - a2i * b1i + b2r
    bi = a2r * b1i + a2i * b1r + b2i
    return ar, ai, br, bi


def _s5_ssm(u, a_re, a_im, log_dt, b_re, b_im, c_re, c_im, d_skip):
    bsz, s, _ = u.shape
    f32 = jnp.float32
    uf = u.astype(f32).reshape(bsz, s, SSM_GROUPS, SSM_GROUP)
    dt = jnp.exp(log_dt.astype(f32))[:, None]
    lr, li = a_re.astype(f32), a_im.astype(f32)
    mag = jnp.exp(lr * dt)
    lb_re = mag * jnp.cos(li * dt)
    lb_im = mag * jnp.sin(li * dt)
    nr, ni = lb_re - 1.0, lb_im
    den = lr * lr + li * li
    f_re = (nr * lr + ni * li) / den
    f_im = (ni * lr - nr * li) / den
    br, bi = b_re.astype(f32), b_im.astype(f32)
    bb_re = f_re[..., None] * br - f_im[..., None] * bi
    bb_im = f_re[..., None] * bi + f_im[..., None] * br
    bu_re = jnp.einsum('bsgc,gpc->bsgp', uf, bb_re)
    bu_im = jnp.einsum('bsgc,gpc->bsgp', uf, bb_im)
    a_re_t = jnp.broadcast_to(lb_re, bu_re.shape)
    a_im_t = jnp.broadcast_to(lb_im, bu_im.shape)
    _, _, h_re, h_im = lax.associative_scan(_complex_scan_combine, (a_re_t, a_im_t, bu_re, bu_im), axis=1)
    y = (jnp.einsum('bsgp,gcp->bsgc', h_re, c_re.astype(f32))
         - jnp.einsum('bsgp,gcp->bsgc', h_im, c_im.astype(f32)))
    y = y.reshape(bsz, s, SSM_WIDTH) + d_skip.astype(f32) * u.astype(f32)
    return y.astype(u.dtype)


def _s5_glu(y, w_glu, b_glu):
    g = jax.nn.gelu(y)
    a, b = jnp.split(g @ w_glu + b_glu, 2, axis=-1)
    return a * jax.nn.sigmoid(b)


def _mla_attention(c_q, c_kv, k_rope_in, q_norm, w_uq, kv_norm, w_ukv, cos, sin):
    bsz, s, _ = c_q.shape
    q = (_rms_norm(c_q, q_norm) @ w_uq).reshape(bsz, s, MLA_HEADS, MLA_NOPE + MLA_ROPE)
    q_nope = q[..., :MLA_NOPE]
    q_rope = _apply_rope(q[..., MLA_NOPE:], cos, sin)
    kv = (_rms_norm(c_kv, kv_norm) @ w_ukv).reshape(bsz, s, MLA_HEADS, MLA_NOPE + MLA_V)
    k_nope, v = kv[..., :MLA_NOPE], kv[..., MLA_NOPE:]
    k_rope = _apply_rope(k_rope_in[:, :, None, :], cos, sin)[:, :, 0, :]
    scale = (MLA_NOPE + MLA_ROPE) ** -0.5
    neg = jnp.finfo(jnp.float32).min
    outs = []
    for blk in range(s // Q_BLOCK):
        q0 = blk * Q_BLOCK
        kend = q0 + Q_BLOCK
        sc = (jnp.einsum('bqhd,bkhd->bhqk', q_nope[:, q0:kend], k_nope[:, :kend])
              + jnp.einsum('bqhr,bkr->bhqk', q_rope[:, q0:kend], k_rope[:, :kend]))
        sc = sc.astype(jnp.float32) * scale
        causal = (q0 + jnp.arange(Q_BLOCK))[:, None] >= jnp.arange(kend)[None, :]
        p = jax.nn.softmax(jnp.where(causal, sc, neg), axis=-1)
        outs.append(jnp.einsum('bhqk,bkhd->bqhd', p.astype(v.dtype), v[:, :kend]))
    return jnp.concatenate(outs, axis=1).reshape(bsz, s, MLA_WIDTH)


def _memory_attention(q_in, mem, w_mem_kv):
    bsz, s, _ = q_in.shape
    m = mem.shape[1]
    kv = (mem @ w_mem_kv).reshape(bsz, m, 2, X_HEADS, X_HEAD_DIM)
    k, v = kv[:, :, 0], kv[:, :, 1]
    q = q_in.reshape(bsz, s, X_HEADS, X_HEAD_DIM)
    sc = jnp.einsum('bshd,bmhd->bhsm', q, k).astype(jnp.float32) * X_HEAD_DIM ** -0.5
    p = jax.nn.softmax(sc, axis=-1)
    return jnp.einsum('bhsm,bmhd->bshd', p.astype(v.dtype), v).reshape(bsz, s, X_WIDTH)


def setup_inputs(seed: int = 0) -> dict:
    key = jax.random.key(seed)
    ks = jax.random.split(key, 26)
    f32 = jnp.float32

    def nrm(k, shape, scale):
        return scale * jax.random.normal(k, shape, f32)

    x = nrm(ks[0], (BATCH, SEQ, D_MODEL), 1.0)
    mem = nrm(ks[1], (BATCH, MEM_LEN, D_MODEL), 1.0)
    offsets = jax.random.randint(ks[2], (BATCH, 1), 0, POS_OFFSET_MAX, dtype=jnp.int32)
    positions = offsets + jnp.arange(SEQ, dtype=jnp.int32)[None, :]
    w_in = nrm(ks[3], (DEPTH, D_MODEL, D_IN), D_MODEL ** -0.5)
    b_gate = nrm(ks[4], (DEPTH, N_BRANCH * D_MODEL), 0.01)
    ssm_a_re = -0.5 + nrm(ks[5], (DEPTH, SSM_GROUPS, SSM_STATE), 0.01)
    ssm_a_im = math.pi * jnp.arange(SSM_STATE, dtype=f32) + nrm(ks[6], (DEPTH, SSM_GROUPS, SSM_STATE), 0.01)
    ssm_log_dt = jax.random.uniform(ks[7], (DEPTH, SSM_GROUPS), f32, math.log(DT_MIN), math.log(DT_MAX))
    ssm_b_re = nrm(ks[8], (DEPTH, SSM_GROUPS, SSM_STATE, SSM_GROUP), (2 * SSM_GROUP) ** -0.5)
    ssm_b_im = nrm(ks[9], (DEPTH, SSM_GROUPS, SSM_STATE, SSM_GROUP), (2 * SSM_GROUP) ** -0.5)
    ssm_c_re = nrm(ks[10], (DEPTH, SSM_GROUPS, SSM_GROUP, SSM_STATE), (2 * SSM_STATE) ** -0.5)
    ssm_c_im = nrm(ks[11], (DEPTH, SSM_GROUPS, SSM_GROUP, SSM_STATE), (2 * SSM_STATE) ** -0.5)
    ssm_d = nrm(ks[12], (DEPTH, SSM_WIDTH), 1.0)
    w_glu = nrm(ks[13], (DEPTH, SSM_WIDTH, 2 * SSM_WIDTH), SSM_WIDTH ** -0.5)
    b_glu = nrm(ks[14], (DEPTH, 2 * SSM_WIDTH), 0.01)
    mla_q_norm = 1.0 + nrm(ks[15], (DEPTH, MLA_Q_RANK), 0.01)
    w_uq = nrm(ks[16], (DEPTH, MLA_Q_RANK, MLA_HEADS * (MLA_NOPE + MLA_ROPE)), MLA_Q_RANK ** -0.5)
    mla_kv_norm = 1.0 + nrm(ks[17], (DEPTH, MLA_KV_RANK), 0.01)
    w_ukv = nrm(ks[18], (DEPTH, MLA_KV_RANK, MLA_HEADS * (MLA_NOPE + MLA_V)), MLA_KV_RANK ** -0.5)
    w_mem_kv = nrm(ks[19], (DEPTH, D_MODEL, 2 * X_WIDTH), D_MODEL ** -0.5)
    p_ssm = nrm(ks[20], (DEPTH, SSM_WIDTH, D_MODEL), BETA * SSM_WIDTH ** -0.5)
    p_mla = nrm(ks[21], (DEPTH, MLA_WIDTH, D_MODEL), BETA * MLA_WIDTH ** -0.5)
    p_mem = nrm(ks[22], (DEPTH, X_WIDTH, D_MODEL), BETA * X_WIDTH ** -0.5)
    w_out = nrm(ks[23], (DEPTH, D_MODEL, D_MODEL), BETA * D_MODEL ** -0.5)
    ln_g = 1.0 + nrm(ks[24], (DEPTH, D_MODEL), 0.01)
    ln_b = nrm(ks[25], (DEPTH, D_MODEL), 0.01)
    return {'x': x, 'mem': mem, 'positions': positions, 'w_in': w_in, 'b_gate': b_gate,
            'ssm_a_re': ssm_a_re, 'ssm_a_im': ssm_a_im, 'ssm_log_dt': ssm_log_dt,
            'ssm_b_re': ssm_b_re, 'ssm_b_im': ssm_b_im, 'ssm_c_re': ssm_c_re, 'ssm_c_im': ssm_c_im,
            'ssm_d': ssm_d, 'w_glu': w_glu, 'b_glu': b_glu,
            'mla_q_norm': mla_q_norm, 'w_uq': w_uq, 'mla_kv_norm': mla_kv_norm, 'w_ukv': w_ukv,
            'w_mem_kv': w_mem_kv, 'p_ssm': p_ssm, 'p_mla': p_mla, 'p_mem': p_mem,
            'w_out': w_out, 'ln_g': ln_g, 'ln_b': ln_b}


def reference(x, mem, positions, w_in, b_gate, ssm_a_re, ssm_a_im, ssm_log_dt, ssm_b_re, ssm_b_im,
              ssm_c_re, ssm_c_im, ssm_d, w_glu, b_glu, mla_q_norm, w_uq, mla_kv_norm, w_ukv,
              w_mem_kv, p_ssm, p_mla, p_mem, w_out, ln_g, ln_b):
    bsz, s, d = x.shape
    cos, sin = _rope_tables(positions)
    split_points = np.cumsum(IN_WIDTHS)[:-1].tolist()
    for l in range(DEPTH):
        proj = x @ w_in[l]
        u, z_ssm, c_q, c_kv, k_rope, z_mla, q_mem, z_mem, gate_logits = jnp.split(proj, split_points, axis=-1)
        gates = jax.nn.sigmoid((gate_logits + b_gate[l]).astype(jnp.float32)).astype(x.dtype)
        gates = gates.reshape(bsz, s, N_BRANCH, d)
        y_ssm = _s5_ssm(u, ssm_a_re[l], ssm_a_im[l], ssm_log_dt[l], ssm_b_re[l], ssm_b_im[l],
                        ssm_c_re[l], ssm_c_im[l], ssm_d[l])
        y_ssm = _s5_glu(y_ssm, w_glu[l], b_glu[l]) * jax.nn.silu(z_ssm)
        y_mla = _mla_attention(c_q, c_kv, k_rope, mla_q_norm[l], w_uq[l], mla_kv_norm[l], w_ukv[l], cos, sin)
        y_mla = y_mla * jax.nn.silu(z_mla)
        y_mem = _memory_attention(q_mem, mem, w_mem_kv[l]) * jax.nn.silu(z_mem)
        merged = (gates[:, :, 0] * (y_ssm @ p_ssm[l])
                  + gates[:, :, 1] * (y_mla @ p_mla[l])
                  + gates[:, :, 2] * (y_mem @ p_mem[l]))
        x = _layer_norm(ALPHA * x + merged @ w_out[l], ln_g[l], ln_b[l])
    return x
```

```cpp
#include <hip/hip_runtime.h>
#include <hip/hip_cooperative_groups.h>
#include <cstdio>
#include <cstdint>
namespace cg = cooperative_groups;

#ifndef MK_MULTI
#define MK_MULTI 0
#endif

#ifndef K1MASK
#define K1MASK 15
#endif
#ifndef PHMASK
#define PHMASK 255
#endif
#define LAS __attribute__((address_space(3)))
typedef unsigned short bf16_t;
typedef short bf16x8 __attribute__((ext_vector_type(8)));
typedef float f32x2 __attribute__((ext_vector_type(2)));
typedef float f32x4 __attribute__((ext_vector_type(4)));
typedef float f32x16 __attribute__((ext_vector_type(16)));
typedef unsigned u32x2 __attribute__((ext_vector_type(2)));
typedef unsigned u32x4 __attribute__((ext_vector_type(4)));
typedef __bf16 bf16x2_t __attribute__((ext_vector_type(2)));

constexpr int DM = 1024, NB = 8, SEQ = 4096, DEPTH = 4, MEML = 256;
constexpr int MTOK = NB * SEQ;
constexpr int DIN = 6048;
constexpr int PAW = 3072;
constexpr float LN_EPS = 1e-5f;
constexpr float ALPHA = 1.6817928305074292f;
constexpr float LOG2E = 1.4426950408889634f;
constexpr float MLA_SCALE = 0.10206207261596577f * LOG2E;
constexpr float QMEM_SCALE = 0.08838834764831845f * LOG2E;
constexpr int SSM_L = 512, SSM_NC = SEQ / SSM_L;

constexpr size_t MiB = 1u << 20;
constexpr size_t WS_TAB = 1 * MiB;
constexpr size_t TAB_L = 288 * 1024;
constexpr size_t WS_ROPE = 3 * MiB;
constexpr size_t WS_SS = 7 * MiB;
constexpr size_t WS_SQP = 8 * MiB;
constexpr size_t WS_SKP = WS_SQP + 512 * 1024;
constexpr size_t WS_MEMB = 9 * MiB;
constexpr size_t WS_MEMKV = 13 * MiB;
constexpr size_t WS_WB = 21 * MiB;
constexpr size_t WB_WIN = 0, WB_WGLU = 12 * MiB, WB_WUQ = 13 * MiB, WB_WUKV = WB_WUQ + 512 * 1024, WB_WMEM = 14 * MiB, WB_WP = 18 * MiB, WB_WOUT = 21 * MiB;
constexpr size_t WS_XB = 45 * MiB;
constexpr size_t WS_PA = 109 * MiB;
constexpr size_t WS_R = 301 * MiB;
constexpr size_t R_Q = 0, R_KN = 48 * MiB, R_KR = 80 * MiB, R_V = 82 * MiB;
constexpr size_t WS_END = 493 * MiB;

constexpr int C_U = 0, C_ZS = 512, C_CQ = 1024, C_CKV = 1280, C_KR = 1408, C_ZM = 1536, C_QX = 2048, C_ZX = 2560;

__device__ __forceinline__ unsigned cvtpk(float lo, float hi) { f32x2 v = {lo, hi}; bf16x2_t b = __builtin_convertvector(v, bf16x2_t); return __builtin_bit_cast(unsigned, b); }
__device__ __forceinline__ bf16_t f2bf(float f) { return (bf16_t)(cvtpk(f, 0.f) & 0xffffu); }
__device__ __forceinline__ float bflo(unsigned w) { return __uint_as_float(w << 16); }
__device__ __forceinline__ float bfhi(unsigned w) { return __uint_as_float(w & 0xffff0000u); }
__device__ __forceinline__ float bf2f(bf16_t b) { return __uint_as_float((unsigned)b << 16); }
__device__ __forceinline__ float sigmoidf_(float x) { return __builtin_amdgcn_rcpf(1.0f + __expf(-x)); }
__device__ __forceinline__ float siluf_(float x) { return x * sigmoidf_(x); }
__device__ __forceinline__ float gelu_tanh(float x) { const float z = 0.7978845608028654f * (x + 0.044715f * x * x * x); return x * sigmoidf_(2.0f * z); }
__device__ __forceinline__ float wave_sum(float v) {
#pragma unroll
    for (int o = 1; o < 64; o <<= 1) v += __shfl_xor(v, o);
    return v;
}
#define LDS_WAIT() asm volatile("s_waitcnt lgkmcnt(0)" ::: "memory")
__device__ __forceinline__ int crow(int i, int h) { return (i & 3) + 8 * (i >> 2) + 4 * h; }
__device__ __forceinline__ void cossin_d(double a, double& c, double& s) {
    const double q = rint(a * 0.63661977236758134308);
    const double y = a - q * 1.57079632679489661923;
    const double y2 = y * y;
    const double sp = y * (1.0 + y2 * (-1.0 / 6 + y2 * (1.0 / 120 + y2 * (-1.0 / 5040 + y2 * (1.0 / 362880 + y2 * (-1.0 / 39916800 + y2 * (1.0 / 6227020800.0)))))));
    const double cp = 1.0 + y2 * (-0.5 + y2 * (1.0 / 24 + y2 * (-1.0 / 720 + y2 * (1.0 / 40320 + y2 * (-1.0 / 3628800 + y2 * (1.0 / 479001600.0))))));
    const int qi = ((int)((long long)q)) & 3;
    c = (qi == 0) ? cp : (qi == 1) ? -sp : (qi == 2) ? -cp : sp;
    s = (qi == 0) ? sp : (qi == 1) ? cp : (qi == 2) ? -sp : -cp;
}

namespace pg8 {
constexpr int BM = 256, BK = 64, HALF = 128, HTB = HALF * BK * 2, STAGE_BYTES = 8 * HTB, NXCD = 8, WGM = 8;
__host__ __device__ __forceinline__ int lds_byte(int r, int c) { const int st = (r >> 4) * 2 + (c >> 5), rr = r & 15, cc = c & 31, ob = rr * 64 + cc * 2; return st * 1024 + (ob ^ (((ob >> 9) & 1) << 5)); }
__host__ __device__ __forceinline__ void stage_rc(int b, int& R, int& C) { const int st = b / 1024, sb = b % 1024, swz = sb ^ (((sb >> 9) & 1) << 5); R = (st >> 1) * 16 + swz / 64; C = (st & 1) * 32 + (swz % 64) / 2; }
__host__ __device__ __forceinline__ int perm32(int rho) { const int n = rho >> 4, i = rho & 15; return 8 * (i >> 2) + 4 * n + (i & 3); }

struct Unit { int pm, pn, sub; const char* a; const char* b; };

struct StaticOrder {
    int nM, nN, nwg, G, c; const char* A; const char* B; size_t tA, tB;
    __device__ void init(int M, int N, int G_, int c_, const void* A_, int lda, const void* B_, int K) { nM = M / BM; nN = N / BM; nwg = nM * nN; G = G_; c = c_; A = (const char*)A_; B = (const char*)B_; tA = (size_t)BM * lda * 2; tB = (size_t)BM * K * 2; }
    __device__ bool next(int i, Unit& u) const {
        const long L = (long)i * G + c; if (L >= nwg) return false;
        int wgid = (int)L; { const int q = nwg / NXCD, r = nwg % NXCD, xcd = wgid % NXCD, off = wgid / NXCD; wgid = (xcd < r ? xcd * (q + 1) : r * (q + 1) + (xcd - r) * q) + off; }
        const int nig = WGM * nN, gid = wgid / nig, fm = gid * WGM, gsz = (nM - fm) < WGM ? (nM - fm) : WGM;
        u.pm = fm + ((wgid % nig) % gsz); u.pn = (wgid % nig) / gsz; u.sub = 0; u.a = A + (size_t)u.pm * tA; u.b = B + (size_t)u.pn * tB; return true;
    }
};

template <class Epi, class Sched>
__device__ __forceinline__ void gemm_phase(LAS unsigned char* lds, const int K_, const int lda_, const Sched& S, const Epi& E) {
    int K = K_, lda = lda_, tid = threadIdx.x;
    asm volatile("" : "+s"(K), "+s"(lda), "+v"(tid));
    const int wid = __builtin_amdgcn_readfirstlane(tid >> 6), lane = tid & 63, wr = wid >> 2, wc = wid & 3, fr = lane & 15, fq = lane >> 4;
    const int nt = K / BK;
    unsigned voffA[2], voffB[2];
#pragma unroll
    for (int i = 0; i < 2; ++i) { int R, C; stage_rc(tid * 16 + i * 8192, R, C); const int Rb = (R & ~31) + perm32(R & 31);
        voffA[i] = (unsigned)(R * lda + C) * 2u; voffB[i] = (unsigned)(Rb * K + C) * 2u; }
    const size_t kstep = (size_t)(BK * 2);
    const size_t hA = (size_t)HALF * lda * 2, hB = (size_t)HALF * K * 2;
    const unsigned ldsw = (unsigned)wid * 1024u;
    const int aoff = lds_byte(wr * 64 + fr, fq * 8), boff = lds_byte(wc * 32 + fr, fq * 8);
#define PG8_SA(b, h) (((b) * 2 + (h)) * HTB)
#define PG8_SB(b, h) ((4 + (b) * 2 + (h)) * HTB)
#define PG8_STAGE(bufoff, gbase, voff) do { _Pragma("unroll") for (int _i = 0; _i < 2; ++_i) \
        __builtin_amdgcn_global_load_lds((const unsigned*)((const char*)(gbase) + (voff)[_i]), (LAS unsigned*)(lds + (bufoff) + ldsw + _i * 8192), 16, 0, 0); } while (0)
#define PG8_LDA(dst, b, h) do { _Pragma("unroll") for (int m = 0; m < 4; ++m) _Pragma("unroll") for (int k = 0; k < 2; ++k) dst[m][k] = *(const LAS bf16x8*)(lds + PG8_SA(b, h) + aoff + m * 2048 + k * 1024); } while (0)
#define PG8_LDB(dst, b, h) do { _Pragma("unroll") for (int n = 0; n < 2; ++n) _Pragma("unroll") for (int k = 0; k < 2; ++k) dst[n][k] = *(const LAS bf16x8*)(lds + PG8_SB(b, h) + boff + n * 2048 + k * 1024); } while (0)
#define PG8_MMA(ai, bj, At, Bt) do { __builtin_amdgcn_s_setprio(1); _Pragma("unroll") for (int m = 0; m < 4; ++m) _Pragma("unroll") for (int n = 0; n < 2; ++n) _Pragma("unroll") for (int k = 0; k < 2; ++k) \
        acc[ai][bj][m][n] = __builtin_amdgcn_mfma_f32_16x16x32_bf16(Bt[n][k], At[m][k], acc[ai][bj][m][n], 0, 0, 0); __builtin_amdgcn_s_setprio(0); } while (0)
#define PG8_WAIT_V(n) asm volatile("s_waitcnt vmcnt(" #n ")" ::: "memory")
#define PG8_WAIT_L(n) asm volatile("s_waitcnt lgkmcnt(" #n ")" ::: "memory")
#define PG8_BAR __builtin_amdgcn_s_barrier()
#define PG8_SCHED __builtin_amdgcn_sched_barrier(0)
    Unit cur, nxt; int ui = 0;
    if (!S.next(0, cur)) return;
    f32x4 acc[2][2][4][2];
#pragma unroll
    for (int a = 0; a < 2; ++a)
#pragma unroll
        for (int b = 0; b < 2; ++b)
#pragma unroll
            for (int m = 0; m < 4; ++m)
#pragma unroll
                for (int n = 0; n < 2; ++n) acc[a][b][m][n] = (f32x4){0.f, 0.f, 0.f, 0.f};
    bf16x8 At[4][2], B0[2][2], B1[2][2];
    const char* cA = cur.a; const char* cB = cur.b;
    PG8_STAGE(PG8_SB(0, 0), cB, voffB); PG8_STAGE(PG8_SB(0, 1), cB + hB, voffB); PG8_STAGE(PG8_SA(0, 0), cA, voffA); PG8_STAGE(PG8_SA(0, 1), cA + hA, voffA);
    if (wr == 1) PG8_BAR;
    PG8_WAIT_V(2); PG8_BAR;
    PG8_STAGE(PG8_SB(1, 0), cB + kstep, voffB); PG8_STAGE(PG8_SA(1, 0), cA + kstep, voffA); PG8_STAGE(PG8_SB(1, 1), cB + hB + kstep, voffB);
    PG8_WAIT_V(6); PG8_BAR;
    for (;;) {
        const bool has_next = S.next(ui + 1, nxt);
        const char* nA = has_next ? nxt.a : cA; const char* nB = has_next ? nxt.b : cB;
        for (int t = 0; t < nt; t += 2) {
            const bool last = (t == nt - 2);
            const char* a1 = cA + (size_t)(t + 1) * kstep;
            const char* a2 = last ? nA : cA + (size_t)(t + 2) * kstep; const char* b2 = last ? nB : cB + (size_t)(t + 2) * kstep;
            const char* a3 = a2 + kstep; const char* b3 = b2 + kstep;
            PG8_LDB(B0, 0, 0); PG8_LDB(B1, 0, 1); PG8_SCHED; PG8_LDA(At, 0, 0); PG8_STAGE(PG8_SA(1, 1), a1 + hA, voffA);
            PG8_WAIT_V(8); PG8_WAIT_L(0); PG8_BAR; PG8_MMA(0, 0, At, B0); PG8_MMA(0, 1, At, B1); PG8_BAR; PG8_SCHED;
            PG8_LDA(At, 0, 1); PG8_STAGE(PG8_SB(0, 0), b2, voffB); PG8_STAGE(PG8_SB(0, 1), b2 + hB, voffB); PG8_STAGE(PG8_SA(0, 0), a2, voffA);
            PG8_WAIT_V(8); PG8_WAIT_L(0); PG8_BAR; PG8_MMA(1, 0, At, B0); PG8_MMA(1, 1, At, B1); PG8_BAR; PG8_SCHED;
            PG8_LDB(B0, 1, 0); PG8_LDB(B1, 1, 1); PG8_SCHED; PG8_LDA(At, 1, 0); PG8_STAGE(PG8_SA(0, 1), a2 + hA, voffA);
            PG8_WAIT_V(8); PG8_WAIT_L(0); PG8_BAR; PG8_MMA(0, 0, At, B0); PG8_MMA(0, 1, At, B1); PG8_BAR; PG8_SCHED;
            PG8_LDA(At, 1, 1); PG8_STAGE(PG8_SB(1, 0), b3, voffB); PG8_STAGE(PG8_SB(1, 1), b3 + hB, voffB); PG8_STAGE(PG8_SA(1, 0), a3, voffA);
            PG8_WAIT_V(8); PG8_WAIT_L(0); PG8_BAR; PG8_MMA(1, 0, At, B0); PG8_MMA(1, 1, At, B1); PG8_BAR; PG8_SCHED;
        }
        if (wr == 0) PG8_BAR;
        E(acc, cur, wr, wc, fr, fq);
        if (!has_next) break;
        if (!E.keep(cur)) {
#pragma unroll
        for (int a = 0; a < 2; ++a)
#pragma unroll
            for (int b = 0; b < 2; ++b)
#pragma unroll
                for (int m = 0; m < 4; ++m)
#pragma unroll
                    for (int n = 0; n < 2; ++n) acc[a][b][m][n] = (f32x4){0.f, 0.f, 0.f, 0.f};
        }
        cur = nxt; cA = nA; cB = nB; ++ui;
        if (wr == 1) PG8_BAR;
    }
    PG8_WAIT_V(0);
    PG8_BAR;
#undef PG8_SA
#undef PG8_SB
#undef PG8_STAGE
#undef PG8_LDA
#undef PG8_LDB
#undef PG8_MMA
#undef PG8_WAIT_V
#undef PG8_WAIT_L
#undef PG8_BAR
#undef PG8_SCHED
}
typedef f32x4 Acc[2][2][4][2];
#define EPI_ROW(u, ai, m) ((u).pm * 256 + (ai) * 128 + wr * 64 + (m) * 16 + fr)
#define EPI_COL(u, bj) ((u).pn * 256 + (bj) * 128 + wc * 32 + 8 * fq)

struct EpiIn {
    bf16_t* PA; float* SQP; float* SKP; bf16_t* KR; const float* ROPE;
    __device__ __forceinline__ bool keep(const Unit&) const { return false; }
    __device__ __forceinline__ void operator()(Acc& acc, const Unit& u, int wr, int wc, int fr, int fq) const {
        const int pn = u.pn; const bool act = (pn == 2 || pn == 3 || pn == 6 || pn == 7 || pn == 10 || pn == 11);
#pragma unroll
        for (int ai = 0; ai < 2; ++ai)
#pragma unroll
            for (int m = 0; m < 4; ++m) { const int row = EPI_ROW(u, ai, m); bf16_t* rowp = PA + (size_t)row * PAW + EPI_COL(u, 0);
#pragma unroll
                for (int bj = 0; bj < 2; ++bj) { f32x4 v0 = acc[ai][bj][m][0], v1 = acc[ai][bj][m][1];
                    if (act) {
#pragma unroll
                        for (int e = 0; e < 4; ++e) { v0[e] = siluf_(v0[e]); v1[e] = siluf_(v1[e]); } }
                    u32x4 w; w.x = cvtpk(v0[0], v0[1]); w.y = cvtpk(v0[2], v0[3]); w.z = cvtpk(v1[0], v1[1]); w.w = cvtpk(v1[2], v1[3]);
                    *(u32x4*)(rowp + bj * 128) = w; }
                if (pn == 4 || pn == 5) {
                    float s = 0.f;
#pragma unroll
                    for (int bj = 0; bj < 2; ++bj) if (pn == 4 || bj == 0) {
#pragma unroll
                        for (int n = 0; n < 2; ++n) { const f32x4 x = acc[ai][bj][m][n]; s += (x[0] * x[0] + x[1] * x[1]) + (x[2] * x[2] + x[3] * x[3]); } }
                    s += __shfl_xor(s, 16); s += __shfl_xor(s, 32);
                    if (fq == 0) (pn == 4 ? SQP : SKP)[(size_t)row * 4 + wc] = s;
                    if (pn == 5 && wc == 0) {
                        f32x4 o[2];
#pragma unroll
                        for (int n = 0; n < 2; ++n) { const f32x4 v = acc[ai][1][m][n]; const f32x4 cs = *(const f32x4*)(ROPE + (size_t)row * 32 + 2 * (4 * fq + 2 * n));
                            o[n][0] = v[0] * cs[0] - v[1] * cs[1]; o[n][1] = v[0] * cs[1] + v[1] * cs[0]; o[n][2] = v[2] * cs[2] - v[3] * cs[3]; o[n][3] = v[2] * cs[3] + v[3] * cs[2]; }
                        u32x4 w; w.x = cvtpk(o[0][0], o[0][1]); w.y = cvtpk(o[0][2], o[0][3]); w.z = cvtpk(o[1][0], o[1][1]); w.w = cvtpk(o[1][2], o[1][3]);
                        *(u32x4*)(KR + (size_t)row * 32 + 8 * fq) = w;
                    }
                }
                asm volatile("" ::: "memory");
            }
    }
};
struct EpiPlain {
    bf16_t* O; int ldc;
    __device__ __forceinline__ bool keep(const Unit&) const { return false; }
    __device__ __forceinline__ void operator()(Acc& acc, const Unit& u, int wr, int wc, int fr, int fq) const {
#pragma unroll
        for (int ai = 0; ai < 2; ++ai)
#pragma unroll
            for (int m = 0; m < 4; ++m) { bf16_t* rowp = O + (size_t)EPI_ROW(u, ai, m) * ldc + EPI_COL(u, 0);
#pragma unroll
                for (int bj = 0; bj < 2; ++bj) { const f32x4 v0 = acc[ai][bj][m][0], v1 = acc[ai][bj][m][1];
                    u32x4 w; w.x = cvtpk(v0[0], v0[1]); w.y = cvtpk(v0[2], v0[3]); w.z = cvtpk(v1[0], v1[1]); w.w = cvtpk(v1[2], v1[3]);
                    *(u32x4*)(rowp + bj * 128) = w; } }
    }
};
struct EpiGate {
    bf16_t* G; const float* bias;
    __device__ __forceinline__ bool keep(const Unit&) const { return false; }
    __device__ __forceinline__ void operator()(Acc& acc, const Unit& u, int wr, int wc, int fr, int fq) const {
        f32x4 bv[2][2];
#pragma unroll
        for (int bj = 0; bj < 2; ++bj)
#pragma unroll
            for (int n = 0; n < 2; ++n) bv[bj][n] = *(const f32x4*)(bias + EPI_COL(u, bj) + 4 * n);
#pragma unroll
        for (int ai = 0; ai < 2; ++ai)
#pragma unroll
            for (int m = 0; m < 4; ++m) { bf16_t* rowp = G + (size_t)EPI_ROW(u, ai, m) * PAW + EPI_COL(u, 0);
#pragma unroll
                for (int bj = 0; bj < 2; ++bj) { f32x4 v0 = acc[ai][bj][m][0] + bv[bj][0], v1 = acc[ai][bj][m][1] + bv[bj][1];
#pragma unroll
                    for (int e = 0; e < 4; ++e) { v0[e] = sigmoidf_(v0[e]); v1[e] = sigmoidf_(v1[e]); }
                    u32x4 w; w.x = cvtpk(v0[0], v0[1]); w.y = cvtpk(v0[2], v0[3]); w.z = cvtpk(v1[0], v1[1]); w.w = cvtpk(v1[2], v1[3]);
                    *(u32x4*)(rowp + bj * 128) = w; }
                asm volatile("" ::: "memory"); }
    }
};
struct EpiQ {
    bf16_t* Q; const float* SQP; const float* ROPE;
    __device__ __forceinline__ bool keep(const Unit&) const { return false; }
    __device__ __forceinline__ void operator()(Acc& acc, const Unit& u, int wr, int wc, int fr, int fq) const {
#pragma unroll
        for (int ai = 0; ai < 2; ++ai)
#pragma unroll
            for (int m = 0; m < 4; ++m) { const int row = EPI_ROW(u, ai, m); const f32x4 sq = *(const f32x4*)(SQP + (size_t)row * 4);
                const float sr = 1.0f / sqrtf(((sq[0] + sq[1]) + (sq[2] + sq[3])) * (1.0f / 256.0f) + LN_EPS);
#pragma unroll
                for (int bj = 0; bj < 2; ++bj) { const int col = EPI_COL(u, bj); f32x4 v[2];
#pragma unroll
                    for (int n = 0; n < 2; ++n) { v[n] = acc[ai][bj][m][n] * sr; const int d = (col + 4 * n) % 96;
                        if (d >= 64) { const f32x4 cs = *(const f32x4*)(ROPE + (size_t)row * 32 + (d - 64)); const f32x4 t = v[n];
                            v[n][0] = t[0] * cs[0] - t[1] * cs[1]; v[n][1] = t[0] * cs[1] + t[1] * cs[0]; v[n][2] = t[2] * cs[2] - t[3] * cs[3]; v[n][3] = t[2] * cs[3] + t[3] * cs[2]; } }
                    u32x4 w; w.x = cvtpk(v[0][0], v[0][1]); w.y = cvtpk(v[0][2], v[0][3]); w.z = cvtpk(v[1][0], v[1][1]); w.w = cvtpk(v[1][2], v[1][3]);
                    *(u32x4*)(Q + (size_t)row * 768 + col) = w; }
                asm volatile("" ::: "memory"); }
    }
};
struct EpiKV {
    bf16_t* KN; bf16_t* V; const float* SKP;
    __device__ __forceinline__ bool keep(const Unit&) const { return false; }
    __device__ __forceinline__ void operator()(Acc& acc, const Unit& u, int wr, int wc, int fr, int fq) const {
#pragma unroll
        for (int ai = 0; ai < 2; ++ai)
#pragma unroll
            for (int m = 0; m < 4; ++m) { const int row = EPI_ROW(u, ai, m); const f32x4 sq = *(const f32x4*)(SKP + (size_t)row * 4);
                const float sr = 1.0f / sqrtf(((sq[0] + sq[1]) + (sq[2] + sq[3])) * (1.0f / 128.0f) + LN_EPS);
#pragma unroll
                for (int bj = 0; bj < 2; ++bj) { const int head = 2 * u.pn + bj, local = wc * 32 + 8 * fq; const f32x4 v0 = acc[ai][bj][m][0] * sr, v1 = acc[ai][bj][m][1] * sr;
                    u32x4 w; w.x = cvtpk(v0[0], v0[1]); w.y = cvtpk(v0[2], v0[3]); w.z = cvtpk(v1[0], v1[1]); w.w = cvtpk(v1[2], v1[3]);
                    bf16_t* dst = (wc < 2) ? KN + (size_t)row * 512 + head * 64 + local : V + (size_t)row * 512 + head * 64 + (local - 64);
                    *(u32x4*)dst = w; }
                asm volatile("" ::: "memory"); }
    }
};
struct EpiGlu {
    bf16_t* PA; const float* bglu;
    __device__ __forceinline__ bool keep(const Unit&) const { return false; }
    __device__ __forceinline__ void operator()(Acc& acc, const Unit& u, int wr, int wc, int fr, int fq) const {
        const int j0 = 128 * u.pn + wc * 32 + 8 * fq;
        f32x4 ba[2], bb[2];
#pragma unroll
        for (int n = 0; n < 2; ++n) { ba[n] = *(const f32x4*)(bglu + j0 + 4 * n); bb[n] = *(const f32x4*)(bglu + 512 + j0 + 4 * n); }
#pragma unroll
        for (int ai = 0; ai < 2; ++ai)
#pragma unroll
            for (int m = 0; m < 4; ++m) { bf16_t* p = PA + (size_t)EPI_ROW(u, ai, m) * PAW + C_ZS + j0; const u32x4 z = *(const u32x4*)p; float y[8];
#pragma unroll
                for (int n = 0; n < 2; ++n) { const f32x4 a = acc[ai][0][m][n] + ba[n], b = acc[ai][1][m][n] + bb[n];
#pragma unroll
                    for (int e = 0; e < 4; ++e) y[4 * n + e] = a[e] * sigmoidf_(b[e]); }
                u32x4 w; w.x = cvtpk(y[0] * bflo(z.x), y[1] * bfhi(z.x)); w.y = cvtpk(y[2] * bflo(z.y), y[3] * bfhi(z.y)); w.z = cvtpk(y[4] * bflo(z.z), y[5] * bfhi(z.z)); w.w = cvtpk(y[6] * bflo(z.w), y[7] * bfhi(z.w));
                *(u32x4*)p = w; asm volatile("" ::: "memory"); }
    }
};
struct EpiMerge {
    bf16_t* G;
    __device__ __forceinline__ bool keep(const Unit& u) const { return u.sub < 2; }
    __device__ __forceinline__ void operator()(Acc& acc, const Unit& u, int wr, int wc, int fr, int fq) const {
        const int sub = u.sub;
#pragma unroll
        for (int ai = 0; ai < 2; ++ai)
#pragma unroll
            for (int m = 0; m < 4; ++m) { bf16_t* rowp = G + (size_t)EPI_ROW(u, ai, m) * PAW + EPI_COL(u, 0);
#pragma unroll
                for (int bj = 0; bj < 2; ++bj) { const u32x4 ga = *(const u32x4*)(rowp + bj * 128 + sub * 1024);
                    float f[8] = {bflo(ga.x), bfhi(ga.x), bflo(ga.y), bfhi(ga.y), bflo(ga.z), bfhi(ga.z), bflo(ga.w), bfhi(ga.w)};
                    if (sub < 2) { const u32x4 gb = *(const u32x4*)(rowp + bj * 128 + (sub + 1) * 1024);
                        const float d[8] = {bflo(gb.x), bfhi(gb.x), bflo(gb.y), bfhi(gb.y), bflo(gb.z), bfhi(gb.z), bflo(gb.w), bfhi(gb.w)};
#pragma unroll
                        for (int e = 0; e < 8; ++e) f[e] = f[e] / fmaxf(d[e], 1e-30f); }
                    f32x4 v0 = acc[ai][bj][m][0], v1 = acc[ai][bj][m][1];
#pragma unroll
                    for (int e = 0; e < 4; ++e) { v0[e] *= f[e]; v1[e] *= f[4 + e]; }
                    acc[ai][bj][m][0] = v0; acc[ai][bj][m][1] = v1;
                    if (sub == 2) { u32x4 w; w.x = cvtpk(v0[0], v0[1]); w.y = cvtpk(v0[2], v0[3]); w.z = cvtpk(v1[0], v1[1]); w.w = cvtpk(v1[2], v1[3]); *(u32x4*)(rowp + bj * 128) = w; } } }
    }
};
struct MergeOrder {
    int G, c; const char* PA; const char* WP;
    __device__ bool next(int i, Unit& u) const {
        const int tile = (i / 3) * G + c; if (tile >= 512) return false;
        u.sub = i % 3; u.pm = tile >> 2; u.pn = tile & 3;
        const int colA = (u.sub == 0) ? C_ZS : (u.sub == 1) ? C_ZM : C_ZX;
        u.a = PA + ((size_t)u.pm * 256 * PAW + colA) * 2; u.b = WP + (size_t)u.sub * (1024 * 512 * 2) + (size_t)u.pn * (256 * 512 * 2); return true;
    }
};
struct EpiOut {
    const float* xres; float* out;
    __device__ __forceinline__ bool keep(const Unit&) const { return false; }
    __device__ __forceinline__ void operator()(Acc& acc, const Unit& u, int wr, int wc, int fr, int fq) const {
#pragma unroll
        for (int ai = 0; ai < 2; ++ai)
#pragma unroll
            for (int m = 0; m < 4; ++m) { const size_t off = (size_t)EPI_ROW(u, ai, m) * DM + EPI_COL(u, 0);
#pragma unroll
                for (int bj = 0; bj < 2; ++bj)
#pragma unroll
                    for (int n = 0; n < 2; ++n) { const f32x4 x = *(const f32x4*)(xres + off + bj * 128 + 4 * n); *(f32x4*)(out + off + bj * 128 + 4 * n) = x * ALPHA + acc[ai][bj][m][n]; } }
    }
};
}

#define MFMA32(a, b, c) __builtin_amdgcn_mfma_f32_32x32x16_bf16((a), (b), (c), 0, 0, 0)
template <int DQK, int DK1, int DV, bool CAUSAL>
__device__ __forceinline__ void attn_unit(LAS unsigned char* lds, const bf16_t* Q, int ldq, const bf16_t* K1, int ldk1, const bf16_t* K2, int ldk2,
                                          const bf16_t* V, int ldv, bf16_t* ZO, int ldo, int q0, int nt) {
    constexpr int KROW = (DQK + 8) * 2, VROW = 136, KBUF = 64 * KROW, VBUF = DV * VROW, BUF = KBUF + VBUF;
    constexpr int KCH = DQK / 8, VCH = DV / 8, NKL = (64 * KCH + 511) / 512, NVL = (64 * VCH) / 512, NS = DQK / 16, NDB = DV / 32;
    int tid = threadIdx.x; asm volatile("" : "+v"(tid));
    const int lane = tid & 63, r = lane & 31, h = lane >> 5, w = __builtin_amdgcn_readfirstlane(tid >> 6);
    bf16x8 qf[NS];
    { const bf16_t* qrow = Q + (size_t)(q0 + 32 * w + r) * ldq + 8 * h;
#pragma unroll
      for (int s = 0; s < NS; ++s) qf[s] = *(const bf16x8*)(qrow + 16 * s); }
    f32x16 o[NDB];
#pragma unroll
    for (int db = 0; db < NDB; ++db)
#pragma unroll
        for (int i = 0; i < 16; ++i) o[db][i] = 0.f;
    float mrun = -1e30f, lrun = 0.f;
    u32x4 kreg[NKL], vreg[NVL];
#define ATT_LOAD(t) do { \
    _Pragma("unroll") for (int i_ = 0; i_ < NKL; ++i_) { const int c_ = tid + 512 * i_; if (c_ < 64 * KCH) { const int row_ = c_ / KCH, col_ = 8 * (c_ % KCH); const size_t kv_ = (size_t)(64 * (t) + row_); \
        const bf16_t* src_ = (col_ < DK1) ? K1 + kv_ * ldk1 + col_ : K2 + kv_ * ldk2 + (col_ - DK1); kreg[i_] = *(const u32x4*)src_; } } \
    _Pragma("unroll") for (int i_ = 0; i_ < NVL; ++i_) { const int c_ = tid + 512 * i_; const int row_ = c_ / VCH, ch_ = c_ % VCH; vreg[i_] = *(const u32x4*)(V + (size_t)(64 * (t) + row_) * ldv + 8 * ch_); } } while (0)
#define ATT_STORE(buf) do { LAS unsigned char* kb_ = lds + (buf) * BUF; LAS unsigned char* vb_ = kb_ + KBUF; \
    _Pragma("unroll") for (int i_ = 0; i_ < NKL; ++i_) { const int c_ = tid + 512 * i_; if (c_ < 64 * KCH) { const int row_ = c_ / KCH, col_ = 8 * (c_ % KCH); *(LAS u32x4*)(kb_ + row_ * KROW + col_ * 2) = kreg[i_]; } } \
    _Pragma("unroll") for (int i_ = 0; i_ < NVL; ++i_) { const int c_ = tid + 512 * i_; const int row_ = c_ / VCH, ch_ = c_ % VCH; const u32x4 v_ = vreg[i_]; LAS unsigned char* p_ = vb_ + (8 * ch_) * VROW + row_ * 2; \
        *(LAS bf16_t*)(p_) = (bf16_t)(v_.x & 0xffff); *(LAS bf16_t*)(p_ + VROW) = (bf16_t)(v_.x >> 16); *(LAS bf16_t*)(p_ + 2 * VROW) = (bf16_t)(v_.y & 0xffff); *(LAS bf16_t*)(p_ + 3 * VROW) = (bf16_t)(v_.y >> 16); \
        *(LAS bf16_t*)(p_ + 4 * VROW) = (bf16_t)(v_.z & 0xffff); *(LAS bf16_t*)(p_ + 5 * VROW) = (bf16_t)(v_.z >> 16); *(LAS bf16_t*)(p_ + 6 * VROW) = (bf16_t)(v_.w & 0xffff); *(LAS bf16_t*)(p_ + 7 * VROW) = (bf16_t)(v_.w >> 16); } } while (0)
    ATT_LOAD(0); ATT_STORE(0); __syncthreads();
    const int qg = q0 + 32 * w + r;
    for (int t = 0; t < nt; ++t) {
        const int buf = t & 1;
        if (t + 1 < nt) ATT_LOAD(t + 1);
        const bool active = !CAUSAL || (64 * t <= q0 + 32 * w + 31);
        if (active) {
            LAS unsigned char* kb = lds + buf * BUF; LAS unsigned char* vb = kb + KBUF;
            f32x16 s0, s1;
#pragma unroll
            for (int i = 0; i < 16; ++i) { s0[i] = 0.f; s1[i] = 0.f; }
#pragma unroll
            for (int s = 0; s < NS; ++s) { const bf16x8 k0 = *(const LAS bf16x8*)(kb + r * KROW + (16 * s + 8 * h) * 2); const bf16x8 k1 = *(const LAS bf16x8*)(kb + (32 + r) * KROW + (16 * s + 8 * h) * 2);
                s0 = MFMA32(k0, qf[s], s0); s1 = MFMA32(k1, qf[s], s1); }
            if (CAUSAL && (64 * t + 63 > q0 + 32 * w)) {
#pragma unroll
                for (int i = 0; i < 16; ++i) { const int kv = 64 * t + crow(i, h); if (kv > qg) s0[i] = -1e30f; if (kv + 32 > qg) s1[i] = -1e30f; } }
            float mx = fmaxf(s0[0], s1[0]);
#pragma unroll
            for (int i = 1; i < 16; ++i) mx = fmaxf(mx, fmaxf(s0[i], s1[i]));
            mx = fmaxf(mx, __shfl_xor(mx, 32));
            const float mn = fmaxf(mrun, mx), alpha = __builtin_amdgcn_exp2f(mrun - mn); mrun = mn;
            float ps = 0.f;
#pragma unroll
            for (int i = 0; i < 16; ++i) { s0[i] = __builtin_amdgcn_exp2f(s0[i] - mn); s1[i] = __builtin_amdgcn_exp2f(s1[i] - mn); ps += s0[i] + s1[i]; }
            lrun = lrun * alpha + ps;
#pragma unroll
            for (int db = 0; db < NDB; ++db)
#pragma unroll
                for (int i = 0; i < 16; ++i) o[db][i] *= alpha;
            bf16x8 pf[4];
#pragma unroll
            for (int s = 0; s < 2; ++s) { u32x4 a, b;
                a.x = cvtpk(s0[8 * s], s0[8 * s + 1]); a.y = cvtpk(s0[8 * s + 2], s0[8 * s + 3]); a.z = cvtpk(s0[8 * s + 4], s0[8 * s + 5]); a.w = cvtpk(s0[8 * s + 6], s0[8 * s + 7]);
                b.x = cvtpk(s1[8 * s], s1[8 * s + 1]); b.y = cvtpk(s1[8 * s + 2], s1[8 * s + 3]); b.z = cvtpk(s1[8 * s + 4], s1[8 * s + 5]); b.w = cvtpk(s1[8 * s + 6], s1[8 * s + 7]);
                pf[s] = __builtin_bit_cast(bf16x8, a); pf[2 + s] = __builtin_bit_cast(bf16x8, b); }
#pragma unroll
            for (int db = 0; db < NDB; ++db)
#pragma unroll
                for (int ks = 0; ks < 4; ++ks) {
                    const LAS unsigned char* vp = vb + (32 * db + r) * VROW + (16 * ks + 4 * h) * 2;
                    const u32x2 lo = *(const LAS u32x2*)vp, hi = *(const LAS u32x2*)(vp + 16);
                    u32x4 vv; vv.x = lo.x; vv.y = lo.y; vv.z = hi.x; vv.w = hi.y;
                    o[db] = MFMA32(__builtin_bit_cast(bf16x8, vv), pf[ks], o[db]); }
        }
        if (t + 1 < nt) ATT_STORE(buf ^ 1);
        __syncthreads();
    }
#undef ATT_LOAD
#undef ATT_STORE
    const float lt = lrun + __shfl_xor(lrun, 32), inv = 1.0f / lt;
#pragma unroll
    for (int db = 0; db < NDB; ++db)
#pragma unroll
        for (int g4 = 0; g4 < 4; ++g4) { bf16_t* zp = ZO + (size_t)qg * ldo + 32 * db + 8 * g4 + 4 * h; const u32x2 z = *(const u32x2*)zp;
            u32x2 wv; wv.x = cvtpk(o[db][4 * g4] * inv * bflo(z.x), o[db][4 * g4 + 1] * inv * bfhi(z.x)); wv.y = cvtpk(o[db][4 * g4 + 2] * inv * bflo(z.y), o[db][4 * g4 + 3] * inv * bfhi(z.y));
            *(u32x2*)zp = wv; }
}

template <bool OUT>
__device__ __forceinline__ void ssm_task(LAS unsigned char* wl, int task, bf16_t* PA, const unsigned char* tab, const float* dskip, f32x2* SS) {
    int lane = threadIdx.x & 63; asm volatile("" : "+v"(lane));
    const int r = lane & 31, h = lane >> 5, row16 = lane & 15, quad = lane >> 4;
    const int chunk = task & 7, g = (task >> 3) & 31, b = task >> 8;
    const bf16_t* BBt = (const bf16_t*)tab; const bf16_t* CMt = (const bf16_t*)(tab + 128 * 1024);
    const f32x2* LAM = (const f32x2*)(tab + 256 * 1024); const f32x2* LAML = (const f32x2*)(tab + 272 * 1024);
    bf16x8 bbf[4], cmf[4];
#pragma unroll
    for (int nb = 0; nb < 4; ++nb) bbf[nb] = *(const bf16x8*)(BBt + ((size_t)(g * 128 + 32 * nb + r)) * 16 + 8 * h);
    if (OUT) {
#pragma unroll
        for (int ks = 0; ks < 4; ++ks) cmf[ks] = *(const bf16x8*)(CMt + ((size_t)(g * 16 + row16)) * 128 + 32 * ks + 8 * quad);
    }
    const f32x2 lam = LAM[g * 64 + lane];
    const float dsk = OUT ? dskip[16 * g + row16] : 0.f;
    float hr = 0.f, hi = 0.f;
    f32x2* ssb = SS + ((size_t)(b * 32 + g) * SSM_NC) * 64 + lane;
    if (OUT) { const f32x2 lL = LAML[g * 64 + lane];
        for (int k = 0; k < chunk; ++k) { const f32x2 s = ssb[(size_t)k * 64]; const float nr = lL.x * hr - lL.y * hi + s.x, ni = lL.x * hi + lL.y * hr + s.y; hr = nr; hi = ni; } }
    LAS float* W = (LAS float*)wl;
    for (int sub = 0; sub < SSM_L / 32; ++sub) {
        const size_t tok0 = (size_t)b * SEQ + chunk * SSM_L + sub * 32;
        const bf16x8 uf = *(const bf16x8*)(PA + (tok0 + r) * PAW + C_U + 16 * g + 8 * h);
#pragma unroll
        for (int nb = 0; nb < 4; ++nb) { f32x16 z;
#pragma unroll
            for (int i = 0; i < 16; ++i) z[i] = 0.f;
            const f32x16 bu = MFMA32(uf, bbf[nb], z);
#pragma unroll
            for (int i = 0; i < 16; ++i) W[crow(i, h) * 132 + 32 * nb + r] = bu[i]; }
        LDS_WAIT();
        f32x2 bq[32];
#pragma unroll
        for (int t = 0; t < 32; ++t) bq[t] = *(const LAS f32x2*)(W + t * 132 + 2 * lane);
        LDS_WAIT();
#pragma unroll
        for (int t = 0; t < 32; ++t) { const float nr = lam.x * hr - lam.y * hi + bq[t].x, ni = lam.x * hi + lam.y * hr + bq[t].y; hr = nr; hi = ni;
            if (OUT) *(LAS unsigned*)((LAS unsigned char*)W + t * 528 + 4 * lane) = cvtpk(hr, hi); }
        if (OUT) {
            LDS_WAIT();
#pragma unroll
            for (int mb = 0; mb < 2; ++mb) { f32x4 acc = (f32x4){0.f, 0.f, 0.f, 0.f};
#pragma unroll
                for (int ks = 0; ks < 4; ++ks) { const bf16x8 af = *(const LAS bf16x8*)((LAS unsigned char*)W + (16 * mb + row16) * 528 + (32 * ks + 8 * quad) * 2);
                    acc = __builtin_amdgcn_mfma_f32_16x16x32_bf16(af, cmf[ks], acc, 0, 0, 0); }
#pragma unroll
                for (int j = 0; j < 4; ++j) { bf16_t* p = PA + (tok0 + 16 * mb + 4 * quad + j) * PAW + C_U + 16 * g + row16; const float y = acc[j] + dsk * bf2f(*p); *p = f2bf(gelu_tanh(y)); } }
            LDS_WAIT();
        }
    }
    if (!OUT) ssb[(size_t)chunk * 64] = (f32x2){hr, hi};
}

enum { MAT_PLAIN = 0, MAT_WIN = 1, MAT_WGLU = 2, MAT_WUQ = 3 };
__device__ __forceinline__ void cvt_item(const float* W, int ldw, int K, bf16_t* WT, int mat, int item, int nblk, LAS float* scr, int lane, const float* kscale) {
    const int kb = item / nblk, nb = item % nblk, k0 = 64 * kb, n0 = 32 * nb, n = n0 + (lane & 31);
    int src = n; float sc = 1.f;
    if (mat == MAT_WIN) {
        if (n < 1408) src = n; else if (n < 1440) { const int j = n - 1408; src = 1408 + ((j & 1) ? 16 + (j >> 1) : (j >> 1)); } else if (n < 1536) src = -1; else src = n - 96;
        if (n >= C_QX && n < C_ZX) sc = QMEM_SCALE;
    } else if (mat == MAT_WGLU) { const int pn = n >> 8, bj = (n >> 7) & 1, i = n & 127; src = bj * 512 + 128 * pn + i; }
    else if (mat == MAT_WUQ) { const int hd = n / 96; int d = n % 96; if (d >= 64) { const int j = d - 64; d = 64 + ((j & 1) ? 16 + (j >> 1) : (j >> 1)); } src = 96 * hd + d; sc = MLA_SCALE; }
#pragma unroll 8
    for (int i = 0; i < 32; ++i) { const int kk = 2 * i + (lane >> 5); float v = (src >= 0) ? W[(size_t)(k0 + kk) * ldw + src] : 0.f; v *= sc; if (kscale) v *= kscale[k0 + kk]; scr[kk * 33 + (lane & 31)] = v; }
    LDS_WAIT();
    const int c = lane & 7;
#pragma unroll
    for (int j = 0; j < 4; ++j) { const int nn = (lane >> 3) + 8 * j; const LAS float* s = scr + (8 * c) * 33 + nn;
        u32x4 o; o.x = cvtpk(s[0 * 33], s[1 * 33]); o.y = cvtpk(s[2 * 33], s[3 * 33]); o.z = cvtpk(s[4 * 33], s[5 * 33]); o.w = cvtpk(s[6 * 33], s[7 * 33]);
        *(u32x4*)(WT + (size_t)(n0 + nn) * K + k0 + 8 * c) = o; }
    LDS_WAIT();
}

struct Args { const void* in[26]; float* out; unsigned char* ws; int ph_lo, ph_hi; };

__device__ __forceinline__ void convert_layer(const Args& a, int l, LAS float* scr, int gw, int NGW, int lane) {
    unsigned char* wb = a.ws + WS_WB;
    constexpr int I_WIN = 16 * 192, I_GLU = 8 * 32, I_UQ = 4 * 24, I_UKV = 2 * 32, I_MEM = 16 * 32, I_P = 8 * 32, I_OUT = 16 * 32;
    constexpr int NIT = I_WIN + I_GLU + I_UQ + I_UKV + I_MEM + 3 * I_P + I_OUT;
    for (int it = gw; it < NIT; it += NGW) {
        int r = it;
        if (r < I_WIN) { cvt_item((const float*)a.in[3] + (size_t)l * DM * DIN, DIN, 1024, (bf16_t*)(wb + WB_WIN), MAT_WIN, r, 192, scr, lane, nullptr); continue; } r -= I_WIN;
        if (r < I_GLU) { cvt_item((const float*)a.in[13] + (size_t)l * 512 * 1024, 1024, 512, (bf16_t*)(wb + WB_WGLU), MAT_WGLU, r, 32, scr, lane, nullptr); continue; } r -= I_GLU;
        if (r < I_UQ) { cvt_item((const float*)a.in[16] + (size_t)l * 256 * 768, 768, 256, (bf16_t*)(wb + WB_WUQ), MAT_WUQ, r, 24, scr, lane, (const float*)a.in[15] + l * 256); continue; } r -= I_UQ;
        if (r < I_UKV) { cvt_item((const float*)a.in[18] + (size_t)l * 128 * 1024, 1024, 128, (bf16_t*)(wb + WB_WUKV), MAT_PLAIN, r, 32, scr, lane, (const float*)a.in[17] + l * 128); continue; } r -= I_UKV;
        if (r < I_MEM) { cvt_item((const float*)a.in[19] + (size_t)l * 1024 * 1024, 1024, 1024, (bf16_t*)(wb + WB_WMEM), MAT_PLAIN, r, 32, scr, lane, nullptr); continue; } r -= I_MEM;
        if (r < 3 * I_P) { const int which = r / I_P; cvt_item((const float*)a.in[20 + which] + (size_t)l * 512 * 1024, 1024, 512, (bf16_t*)(wb + WB_WP) + (size_t)which * 1024 * 512, MAT_PLAIN, r % I_P, 32, scr, lane, nullptr); continue; } r -= 3 * I_P;
        cvt_item((const float*)a.in[23] + (size_t)l * 1024 * 1024, 1024, 1024, (bf16_t*)(wb + WB_WOUT), MAT_PLAIN, r, 32, scr, lane, nullptr);
    }
}

constexpr int NWAVES = 8, LDS_BYTES = 147456;
constexpr int N_PHASES = 1 + 7 * DEPTH;

__global__ void __launch_bounds__(NWAVES * 64, 2) mk_fwd(Args args) {
    extern __shared__ __attribute__((aligned(16))) unsigned char lds_raw[];
    LAS unsigned char* lds = (LAS unsigned char*)lds_raw;
    const int G = gridDim.x, cu = blockIdx.x, NGW = G * NWAVES;
    unsigned char* ws = args.ws;
    bf16_t* XB = (bf16_t*)(ws + WS_XB); bf16_t* PA = (bf16_t*)(ws + WS_PA); bf16_t* RG = (bf16_t*)(ws + WS_R);
    bf16_t* QB = (bf16_t*)(ws + WS_R + R_Q); bf16_t* KN = (bf16_t*)(ws + WS_R + R_KN); bf16_t* KR = (bf16_t*)(ws + WS_R + R_KR); bf16_t* VB = (bf16_t*)(ws + WS_R + R_V);
    bf16_t* MEMB = (bf16_t*)(ws + WS_MEMB); bf16_t* MEMKV = (bf16_t*)(ws + WS_MEMKV);
    float* SQP = (float*)(ws + WS_SQP); float* SKP = (float*)(ws + WS_SKP); float* ROPE = (float*)(ws + WS_ROPE); f32x2* SS = (f32x2*)(ws + WS_SS);
    unsigned char* wb = ws + WS_WB;
    const float* xin = (const float*)args.in[0];
    float* out = args.out;

    if (args.ph_lo == 0 && (PHMASK & 1)) {
        int tid = threadIdx.x; asm volatile("" : "+v"(tid));
        const int lane = tid & 63, wave = __builtin_amdgcn_readfirstlane(tid >> 6), gw = cu * NWAVES + wave;

            convert_layer(args, 0, (LAS float*)(lds + wave * 16384), gw, NGW, lane);
            { const size_t n4 = (size_t)MTOK * DM / 4;
              for (size_t i = (size_t)cu * 512 + tid; i < n4; i += (size_t)G * 512) { const f32x4 v = ((const f32x4*)xin)[i]; u32x2 w; w.x = cvtpk(v[0], v[1]); w.y = cvtpk(v[2], v[3]); ((u32x2*)XB)[i] = w; } }
            { const size_t n4 = (size_t)NB * MEML * DM / 4; const float* mem = (const float*)args.in[1];
              for (size_t i = (size_t)cu * 512 + tid; i < n4; i += (size_t)G * 512) { const f32x4 v = ((const f32x4*)mem)[i]; u32x2 w; w.x = cvtpk(v[0], v[1]); w.y = cvtpk(v[2], v[3]); ((u32x2*)MEMB)[i] = w; } }
            { const int* pos = (const int*)args.in[2];
              for (int i = cu * 512 + tid; i < MTOK * 16; i += G * 512) { const int m = i >> 4, f = i & 15; const double invf = exp(-(double)f * (9.210340371976184 / 16.0)); double c, s; cossin_d((double)pos[m] * invf, c, s);
                  ROPE[(size_t)i * 2] = (float)c; ROPE[(size_t)i * 2 + 1] = (float)s; } }
            {
              for (int i = cu * 512 + tid; i < DEPTH * 32 * 64; i += G * 512) { const int p = i & 63, g = (i >> 6) & 31, l = i >> 11;
                  unsigned char* tab = ws + WS_TAB + (size_t)l * TAB_L; bf16_t* BBt = (bf16_t*)tab; bf16_t* CMt = (bf16_t*)(tab + 128 * 1024); f32x2* LAM = (f32x2*)(tab + 256 * 1024); f32x2* LAML = (f32x2*)(tab + 272 * 1024);
                  const double dt = exp((double)((const float*)args.in[7])[l * 32 + g]); const double lr = ((const float*)args.in[5])[(l * 32 + g) * 64 + p], li = ((const float*)args.in[6])[(l * 32 + g) * 64 + p];
                  const double mag = exp(lr * dt); double c, s; cossin_d(li * dt, c, s); const double lbr = mag * c, lbi = mag * s, nr = lbr - 1.0, ni = lbi, den = lr * lr + li * li;
                  const double fre = (nr * lr + ni * li) / den, fim = (ni * lr - nr * li) / den;
                  const float* bre = (const float*)args.in[8] + ((size_t)(l * 32 + g) * 64 + p) * 16; const float* bim = (const float*)args.in[9] + ((size_t)(l * 32 + g) * 64 + p) * 16;
                  for (int cc = 0; cc < 16; ++cc) { const double br = bre[cc], bi = bim[cc]; BBt[((size_t)g * 128 + 2 * p) * 16 + cc] = f2bf((float)(fre * br - fim * bi)); BBt[((size_t)g * 128 + 2 * p + 1) * 16 + cc] = f2bf((float)(fre * bi + fim * br)); }
                  const float* cre = (const float*)args.in[10] + (size_t)(l * 32 + g) * 16 * 64; const float* cim = (const float*)args.in[11] + (size_t)(l * 32 + g) * 16 * 64;
                  for (int cc = 0; cc < 16; ++cc) { CMt[((size_t)g * 16 + cc) * 128 + 2 * p] = f2bf(cre[cc * 64 + p]); CMt[((size_t)g * 16 + cc) * 128 + 2 * p + 1] = f2bf(-cim[cc * 64 + p]); }
                  LAM[g * 64 + p] = (f32x2){(float)lbr, (float)lbi};
                  const double magL = exp(lr * dt * (double)SSM_L); double cL, sL; cossin_d(li * dt * (double)SSM_L, cL, sL); LAML[g * 64 + p] = (f32x2){(float)(magL * cL), (float)(magL * sL)}; } }
#if !MK_MULTI
        if (args.ph_hi > 1) { __threadfence(); cg::this_grid().sync(); }
#endif
    }
    for (int ph = (args.ph_lo > 1 ? args.ph_lo : 1); ph < args.ph_hi; ++ph) {
        int tid = threadIdx.x; asm volatile("" : "+v"(tid));
        const int lane = tid & 63, wave = __builtin_amdgcn_readfirstlane(tid >> 6), gw = cu * NWAVES + wave;
        {
            const int l = (ph - 1) / 7, k = (ph - 1) % 7;
            const unsigned char* tab = ws + WS_TAB + (size_t)l * TAB_L;
            if (k == 0 && (PHMASK & 2)) {
                { pg8::StaticOrder S; S.init(MTOK, PAW, G, cu, XB, DM, wb + WB_WIN, DM); pg8::EpiIn E{PA, SQP, SKP, KR, ROPE}; pg8::gemm_phase(lds, DM, DM, S, E); }
                { pg8::StaticOrder S; S.init(NB * MEML, 1024, G, cu, MEMB, DM, wb + WB_WMEM, DM); pg8::EpiPlain E{MEMKV, 1024}; pg8::gemm_phase(lds, DM, DM, S, E); }
            } else if (k == 1 && (PHMASK & 4)) {
                if (K1MASK & 1) { pg8::StaticOrder S; S.init(MTOK, 768, G, cu, PA + C_CQ, PAW, wb + WB_WUQ, 256); pg8::EpiQ E{QB, SQP, ROPE}; pg8::gemm_phase(lds, 256, PAW, S, E); }
                if (K1MASK & 2) { pg8::StaticOrder S; S.init(MTOK, 1024, G, cu, PA + C_CKV, PAW, wb + WB_WUKV, 128); pg8::EpiKV E{KN, VB, SKP}; pg8::gemm_phase(lds, 128, PAW, S, E); }
                if (K1MASK & 4) for (int task = gw; task < NB * 32 * SSM_NC; task += NGW) ssm_task<false>(lds + wave * 16896, task, PA, tab, (const float*)args.in[12] + l * 512, SS);
                __syncthreads();
                if (K1MASK & 8) for (int ui = cu; ui < NB * 4 * 16; ui += G) { const int b = ui >> 6, hh = (ui >> 4) & 3, qb = ui & 15; const size_t t0 = (size_t)b * SEQ;
#pragma unroll 1
                    for (int e = 0; e < 2; ++e)
                    attn_unit<128, 128, 64, false>(lds, PA + t0 * PAW + C_QX + 128 * hh, PAW, MEMKV + (size_t)b * MEML * 1024 + 128 * hh, 1024, nullptr, 0,
                                                    MEMKV + (size_t)b * MEML * 1024 + 512 + 128 * hh + 64 * e, 1024, PA + t0 * PAW + C_ZX + 128 * hh + 64 * e, PAW, 256 * qb, MEML / 64); }
            } else if (k == 2 && (PHMASK & 8)) {
                for (int pi = cu; pi < NB * 8 * 8; pi += G) { const int bh = pi >> 3, j = pi & 7, b = bh >> 3, hh = bh & 7; const size_t t0 = (size_t)b * SEQ;
#pragma unroll 1
                    for (int e = 0; e < 2; ++e) { const int qb = e ? 15 - j : j;
                        attn_unit<96, 64, 64, true>(lds, QB + t0 * 768 + 96 * hh, 768, KN + t0 * 512 + 64 * hh, 512, KR + t0 * 32, 32, VB + t0 * 512 + 64 * hh, 512, PA + t0 * PAW + C_ZM + 64 * hh, PAW, 256 * qb, 4 * (qb + 1)); } }
                for (int task = gw; task < NB * 32 * SSM_NC; task += NGW) ssm_task<true>(lds + wave * 16896, task, PA, tab, (const float*)args.in[12] + l * 512, SS);
                __syncthreads();
            } else if (k == 3 && (PHMASK & 16)) {
                { pg8::StaticOrder S; S.init(MTOK, PAW, G, cu, XB, DM, wb + WB_WIN + (size_t)PAW * DM * 2, DM); pg8::EpiGate E{RG, (const float*)args.in[4] + l * 3072}; pg8::gemm_phase(lds, DM, DM, S, E); }
                { pg8::StaticOrder S; S.init(MTOK, 1024, G, cu, PA + C_U, PAW, wb + WB_WGLU, 512); pg8::EpiGlu E{PA, (const float*)args.in[14] + l * 1024}; pg8::gemm_phase(lds, 512, PAW, S, E); }
            } else if (k == 4 && (PHMASK & 32)) {
                pg8::MergeOrder S{G, cu, (const char*)PA, (const char*)(wb + WB_WP)}; pg8::EpiMerge E{RG}; pg8::gemm_phase(lds, 512, PAW, S, E);
            } else if (k == 5 && (PHMASK & 64)) {
                pg8::StaticOrder S; S.init(MTOK, DM, G, cu, RG, PAW, wb + WB_WOUT, DM); pg8::EpiOut E{l == 0 ? xin : (const float*)out, out}; pg8::gemm_phase(lds, DM, PAW, S, E);
            } else if (k == 6 && (PHMASK & 128)) {
                const float* lg = (const float*)args.in[24] + l * DM; const float* lb = (const float*)args.in[25] + l * DM;
                f32x4 gv[4], bv[4];
#pragma unroll
                for (int j = 0; j < 4; ++j) { gv[j] = ((const f32x4*)lg)[lane + 64 * j]; bv[j] = ((const f32x4*)lb)[lane + 64 * j]; }
                for (int m = gw; m < MTOK; m += NGW) { f32x4* xr = (f32x4*)(out + (size_t)m * DM) + lane; f32x4 v[4]; float s = 0.f;
#pragma unroll
                    for (int j = 0; j < 4; ++j) { v[j] = xr[64 * j]; s += (v[j][0] + v[j][1]) + (v[j][2] + v[j][3]); }
                    const float mean = wave_sum(s) * (1.f / DM); float s2 = 0.f;
#pragma unroll
                    for (int j = 0; j < 4; ++j) { v[j] = v[j] - mean; s2 += (v[j][0] * v[j][0] + v[j][1] * v[j][1]) + (v[j][2] * v[j][2] + v[j][3] * v[j][3]); }
                    const float rstd = 1.f / sqrtf(wave_sum(s2) * (1.f / DM) + LN_EPS);
                    u32x2* xb = (u32x2*)(XB + (size_t)m * DM) + lane;
#pragma unroll
                    for (int j = 0; j < 4; ++j) { const f32x4 y = v[j] * rstd * gv[j] + bv[j]; xr[64 * j] = y; u32x2 w; w.x = cvtpk(y[0], y[1]); w.y = cvtpk(y[2], y[3]); xb[64 * j] = w; } }
                if (l + 1 < DEPTH) convert_layer(args, l + 1, (LAS float*)(lds + wave * 16384), gw, NGW, lane);
            }
        }
#if !MK_MULTI
        if (ph + 1 < args.ph_hi) { __threadfence(); cg::this_grid().sync(); }
#endif
    }
}

extern "C" void kernel_launch(void* const* d_in, const int* in_sizes, int n_in, void* d_out, int out_size, void* d_ws, size_t ws_size, hipStream_t stream) {
    static int grid = 0;
    if (grid == 0) {
        if (n_in != 26 || out_size != MTOK * DM || ws_size < WS_END) { fprintf(stderr, "kernel_launch: unexpected sizes n_in %d out %d ws %zu\n", n_in, out_size, ws_size); grid = -1; return; }
        int dev = 0, cus = 0, per_cu = 0;
        hipGetDevice(&dev); hipDeviceGetAttribute(&cus, hipDeviceAttributeMultiprocessorCount, dev);
        hipFuncSetAttribute((const void*)mk_fwd, hipFuncAttributeMaxDynamicSharedMemorySize, LDS_BYTES);
        hipOccupancyMaxActiveBlocksPerMultiprocessor(&per_cu, (const void*)mk_fwd, NWAVES * 64, LDS_BYTES);
        if (per_cu < 1) { fprintf(stderr, "kernel_launch: occupancy query says %d blocks/CU\n", per_cu); per_cu = 1; }
        (void)hipGetLastError();
        grid = cus * 1;
    }
    if (grid < 0) return;
    Args a{};
    for (int i = 0; i < 26; ++i) a.in[i] = d_in[i];
    a.out = (float*)d_out; a.ws = (unsigned char*)d_ws;
#if MK_MULTI
    for (int ph = 0; ph < N_PHASES; ++ph) { a.ph_lo = ph; a.ph_hi = ph + 1; hipLaunchKernelGGL(mk_fwd, dim3(grid), dim3(NWAVES * 64), LDS_BYTES, stream, a); }
#else
    a.ph_lo = 0; a.ph_hi = N_PHASES;
    void* kargs[] = {&a};
    hipError_t e = hipLaunchCooperativeKernel((const void*)mk_fwd, dim3(grid), dim3(NWAVES * 64), kargs, LDS_BYTES, stream);
    if (e != hipSuccess) fprintf(stderr, "cooperative launch failed: %s (grid %d)\n", hipGetErrorString(e), grid);
#endif
}
```

```cpp
#include <hip/hip_runtime.h>
#include <hip/hip_cooperative_groups.h>
#include <cstdio>
#include <cstdint>
namespace cg = cooperative_groups;

#ifndef MK_MULTI
#define MK_MULTI 0
#endif

#ifndef K1MASK
#define K1MASK 15
#endif
#ifndef PHMASK
#define PHMASK 255
#endif
#define LAS __attribute__((address_space(3)))
typedef unsigned short bf16_t;
typedef short bf16x8 __attribute__((ext_vector_type(8)));
typedef float f32x2 __attribute__((ext_vector_type(2)));
typedef float f32x4 __attribute__((ext_vector_type(4)));
typedef float f32x16 __attribute__((ext_vector_type(16)));
typedef unsigned u32x2 __attribute__((ext_vector_type(2)));
typedef unsigned u32x4 __attribute__((ext_vector_type(4)));
typedef __bf16 bf16x2_t __attribute__((ext_vector_type(2)));

constexpr int DM = 1024, NB = 8, SEQ = 4096, DEPTH = 4, MEML = 256;
constexpr int MTOK = NB * SEQ;
constexpr int DIN = 6048;
constexpr int PAW = 3072;
constexpr float LN_EPS = 1e-5f;
constexpr float ALPHA = 1.6817928305074292f;
constexpr float LOG2E = 1.4426950408889634f;
constexpr float MLA_SCALE = 0.10206207261596577f * LOG2E;
constexpr float QMEM_SCALE = 0.08838834764831845f * LOG2E;
constexpr int SSM_L = 512, SSM_NC = SEQ / SSM_L;

constexpr size_t MiB = 1u << 20;
constexpr size_t WS_TAB = 1 * MiB;
constexpr size_t TAB_L = 288 * 1024;
constexpr size_t WS_ROPE = 3 * MiB;
constexpr size_t WS_SS = 7 * MiB;
constexpr size_t WS_SQP = 8 * MiB;
constexpr size_t WS_SKP = WS_SQP + 512 * 1024;
constexpr size_t WS_MEMB = 9 * MiB;
constexpr size_t WS_MEMKV = 13 * MiB;
constexpr size_t WS_WB = 21 * MiB;
constexpr size_t WB_WIN = 0, WB_WGLU = 12 * MiB, WB_WUQ = 13 * MiB, WB_WUKV = WB_WUQ + 512 * 1024, WB_WMEM = 14 * MiB, WB_WP = 18 * MiB, WB_WOUT = 21 * MiB;
constexpr size_t WS_XB = 45 * MiB;
constexpr size_t WS_PA = 109 * MiB;
constexpr size_t WS_R = 301 * MiB;
constexpr size_t R_Q = 0, R_KN = 48 * MiB, R_KR = 80 * MiB, R_V = 82 * MiB;
constexpr size_t WS_END = 493 * MiB;

constexpr int C_U = 0, C_ZS = 512, C_CQ = 1024, C_CKV = 1280, C_KR = 1408, C_ZM = 1536, C_QX = 2048, C_ZX = 2560;

__device__ __forceinline__ unsigned cvtpk(float lo, float hi) { f32x2 v = {lo, hi}; bf16x2_t b = __builtin_convertvector(v, bf16x2_t); return __builtin_bit_cast(unsigned, b); }
__device__ __forceinline__ bf16_t f2bf(float f) { return (bf16_t)(cvtpk(f, 0.f) & 0xffffu); }
__device__ __forceinline__ float bflo(unsigned w) { return __uint_as_float(w << 16); }
__device__ __forceinline__ float bfhi(unsigned w) { return __uint_as_float(w & 0xffff0000u); }
__device__ __forceinline__ float bf2f(bf16_t b) { return __uint_as_float((unsigned)b << 16); }
__device__ __forceinline__ float sigmoidf_(float x) { return __builtin_amdgcn_rcpf(1.0f + __expf(-x)); }
__device__ __forceinline__ float siluf_(float x) { return x * sigmoidf_(x); }
__device__ __forceinline__ float gelu_tanh(float x) { const float z = 0.7978845608028654f * (x + 0.044715f * x * x * x); return x * sigmoidf_(2.0f * z); }
__device__ __forceinline__ float wave_sum(float v) {
#pragma unroll
    for (int o = 1; o < 64; o <<= 1) v += __shfl_xor(v, o);
    return v;
}
#define LDS_WAIT() asm volatile("s_waitcnt lgkmcnt(0)" ::: "memory")
__device__ __forceinline__ int crow(int i, int h) { return (i & 3) + 8 * (i >> 2) + 4 * h; }
__device__ __forceinline__ void cossin_d(double a, double& c, double& s) {
    const double q = rint(a * 0.63661977236758134308);
    const double y = a - q * 1.57079632679489661923;
    const double y2 = y * y;
    const double sp = y * (1.0 + y2 * (-1.0 / 6 + y2 * (1.0 / 120 + y2 * (-1.0 / 5040 + y2 * (1.0 / 362880 + y2 * (-1.0 / 39916800 + y2 * (1.0 / 6227020800.0)))))));
    const double cp = 1.0 + y2 * (-0.5 + y2 * (1.0 / 24 + y2 * (-1.0 / 720 + y2 * (1.0 / 40320 + y2 * (-1.0 / 3628800 + y2 * (1.0 / 479001600.0))))));
    const int qi = ((int)((long long)q)) & 3;
    c = (qi == 0) ? cp : (qi == 1) ? -sp : (qi == 2) ? -cp : sp;
    s = (qi == 0) ? sp : (qi == 1) ? cp : (qi == 2) ? -sp : -cp;
}

namespace pg8 {
constexpr int BM = 256, BK = 64, HALF = 128, HTB = HALF * BK * 2, STAGE_BYTES = 8 * HTB, NXCD = 8, WGM = 8;
__host__ __device__ __forceinline__ int lds_byte(int r, int c) { const int st = (r >> 4) * 2 + (c >> 5), rr = r & 15, cc = c & 31, ob = rr * 64 + cc * 2; return st * 1024 + (ob ^ (((ob >> 9) & 1) << 5)); }
__host__ __device__ __forceinline__ void stage_rc(int b, int& R, int& C) { const int st = b / 1024, sb = b % 1024, swz = sb ^ (((sb >> 9) & 1) << 5); R = (st >> 1) * 16 + swz / 64; C = (st & 1) * 32 + (swz % 64) / 2; }
__host__ __device__ __forceinline__ int perm32(int rho) { const int n = rho >> 4, i = rho & 15; return 8 * (i >> 2) + 4 * n + (i & 3); }

struct Unit { int pm, pn, sub; const char* a; const char* b; };

struct StaticOrder {
    int nM, nN, nwg, G, c; const char* A; const char* B; size_t tA, tB;
    __device__ void init(int M, int N, int G_, int c_, const void* A_, int lda, const void* B_, int K) { nM = M / BM; nN = N / BM; nwg = nM * nN; G = G_; c = c_; A = (const char*)A_; B = (const char*)B_; tA = (size_t)BM * lda * 2; tB = (size_t)BM * K * 2; }
    __device__ bool next(int i, Unit& u) const {
        const long L = (long)i * G + c; if (L >= nwg) return false;
        int wgid = (int)L; { const int q = nwg / NXCD, r = nwg % NXCD, xcd = wgid % NXCD, off = wgid / NXCD; wgid = (xcd < r ? xcd * (q + 1) : r * (q + 1) + (xcd - r) * q) + off; }
        const int nig = WGM * nN, gid = wgid / nig, fm = gid * WGM, gsz = (nM - fm) < WGM ? (nM - fm) : WGM;
        u.pm = fm + ((wgid % nig) % gsz); u.pn = (wgid % nig) / gsz; u.sub = 0; u.a = A + (size_t)u.pm * tA; u.b = B + (size_t)u.pn * tB; return true;
    }
};

template <class Epi, class Sched>
__device__ __forceinline__ void gemm_phase(LAS unsigned char* lds, const int K_, const int lda_, const Sched& S, const Epi& E) {
    int K = K_, lda = lda_, tid = threadIdx.x;
    asm volatile("" : "+s"(K), "+s"(lda), "+v"(tid));
    const int wid = __builtin_amdgcn_readfirstlane(tid >> 6), lane = tid & 63, wr = wid >> 2, wc = wid & 3, fr = lane & 15, fq = lane >> 4;
    const int nt = K / BK;
    unsigned voffA[2], voffB[2];
#pragma unroll
    for (int i = 0; i < 2; ++i) { int R, C; stage_rc(tid * 16 + i * 8192, R, C); const int Rb = (R & ~31) + perm32(R & 31);
        voffA[i] = (unsigned)(R * lda + C) * 2u; voffB[i] = (unsigned)(Rb * K + C) * 2u; }
    const size_t kstep = (size_t)(BK * 2);
    const size_t hA = (size_t)HALF * lda * 2, hB = (size_t)HALF * K * 2;
    const unsigned ldsw = (unsigned)wid * 1024u;
    const int aoff = lds_byte(wr * 64 + fr, fq * 8), boff = lds_byte(wc * 32 + fr, fq * 8);
#define PG8_SA(b, h) (((b) * 2 + (h)) * HTB)
#define PG8_SB(b, h) ((4 + (b) * 2 + (h)) * HTB)
#define PG8_STAGE(bufoff, gbase, voff) do { _Pragma("unroll") for (int _i = 0; _i < 2; ++_i) \
        __builtin_amdgcn_global_load_lds((const unsigned*)((const char*)(gbase) + (voff)[_i]), (LAS unsigned*)(lds + (bufoff) + ldsw + _i * 8192), 16, 0, 0); } while (0)
#define PG8_LDA(dst, b, h) do { _Pragma("unroll") for (int m = 0; m < 4; ++m) _Pragma("unroll") for (int k = 0; k < 2; ++k) dst[m][k] = *(const LAS bf16x8*)(lds + PG8_SA(b, h) + aoff + m * 2048 + k * 1024); } while (0)
#define PG8_LDB(dst, b, h) do { _Pragma("unroll") for (int n = 0; n < 2; ++n) _Pragma("unroll") for (int k = 0; k < 2; ++k) dst[n][k] = *(const LAS bf16x8*)(lds + PG8_SB(b, h) + boff + n * 2048 + k * 1024); } while (0)
#define PG8_MMA(ai, bj, At, Bt) do { __builtin_amdgcn_s_setprio(1); _Pragma("unroll") for (int m = 0; m < 4; ++m) _Pragma("unroll") for (int n = 0; n < 2; ++n) _Pragma("unroll") for (int k = 0; k < 2; ++k) \
        acc[ai][bj][m][n] = __builtin_amdgcn_mfma_f32_16x16x32_bf16(Bt[n][k], At[m][k], acc[ai][bj][m][n], 0, 0, 0); __builtin_amdgcn_s_setprio(0); } while (0)
#define PG8_WAIT_V(n) asm volatile("s_waitcnt vmcnt(" #n ")" ::: "memory")
#define PG8_WAIT_L(n) asm volatile("s_waitcnt lgkmcnt(" #n ")" ::: "memory")
#define PG8_BAR __builtin_amdgcn_s_barrier()
#define PG8_SCHED __builtin_amdgcn_sched_barrier(0)
    Unit cur, nxt; int ui = 0;
    if (!S.next(0, cur)) return;
    f32x4 acc[2][2][4][2];
#pragma unroll
    for (int a = 0; a < 2; ++a)
#pragma unroll
        for (int b = 0; b < 2; ++b)
#pragma unroll
            for (int m = 0; m < 4; ++m)
#pragma unroll
                for (int n = 0; n < 2; ++n) acc[a][b][m][n] = (f32x4){0.f, 0.f, 0.f, 0.f};
    bf16x8 At[4][2], B0[2][2], B1[2][2];
    const char* cA = cur.a; const char* cB = cur.b;
    PG8_STAGE(PG8_SB(0, 0), cB, voffB); PG8_STAGE(PG8_SB(0, 1), cB + hB, voffB); PG8_STAGE(PG8_SA(0, 0), cA, voffA); PG8_STAGE(PG8_SA(0, 1), cA + hA, voffA);
    if (wr == 1) PG8_BAR;
    PG8_WAIT_V(2); PG8_BAR;
    PG8_STAGE(PG8_SB(1, 0), cB + kstep, voffB); PG8_STAGE(PG8_SA(1, 0), cA + kstep, voffA); PG8_STAGE(PG8_SB(1, 1), cB + hB + kstep, voffB);
    PG8_WAIT_V(6); PG8_BAR;
    for (;;) {
        const bool has_next = S.next(ui + 1, nxt);
        const char* nA = has_next ? nxt.a : cA; const char* nB = has_next ? nxt.b : cB;
        for (int t = 0; t < nt; t += 2) {
            const bool last = (t == nt - 2);
            const char* a1 = cA + (size_t)(t + 1) * kstep;
            const char* a2 = last ? nA : cA + (size_t)(t + 2) * kstep; const char* b2 = last ? nB : cB + (size_t)(t + 2) * kstep;
            const char* a3 = a2 + kstep; const char* b3 = b2 + kstep;
            PG8_LDB(B0, 0, 0); PG8_LDB(B1, 0, 1); PG8_SCHED; PG8_LDA(At, 0, 0); PG8_STAGE(PG8_SA(1, 1), a1 + hA, voffA);
            PG8_WAIT_V(8); PG8_WAIT_L(0); PG8_BAR; PG8_MMA(0, 0, At, B0); PG8_MMA(0, 1, At, B1); PG8_BAR; PG8_SCHED;
            PG8_LDA(At, 0, 1); PG8_STAGE(PG8_SB(0, 0), b2, voffB); PG8_STAGE(PG8_SB(0, 1), b2 + hB, voffB); PG8_STAGE(PG8_SA(0, 0), a2, voffA);
            PG8_WAIT_V(8); PG8_WAIT_L(0); PG8_BAR; PG8_MMA(1, 0, At, B0); PG8_MMA(1, 1, At, B1); PG8_BAR; PG8_SCHED;
            PG8_LDB(B0, 1, 0); PG8_LDB(B1, 1, 1); PG8_SCHED; PG8_LDA(At, 1, 0); PG8_STAGE(PG8_SA(0, 1), a2 + hA, voffA);
            PG8_WAIT_V(8); PG8_WAIT_L(0); PG8_BAR; PG8_MMA(0, 0, At, B0); PG8_MMA(0, 1, At, B1); PG8_BAR; PG8_SCHED;
            PG8_LDA(At, 1, 1); PG8_STAGE(PG8_SB(1, 0), b3, voffB); PG8_STAGE(PG8_SB(1, 1), b3 + hB, voffB); PG8_STAGE(PG8_SA(1, 0), a3, voffA);
            PG8_WAIT_V(8); PG8_WAIT_L(0); PG8_BAR; PG8_MMA(1, 0, At, B0); PG8_MMA(1, 1, At, B1); PG8_BAR; PG8_SCHED;
        }
        if (wr == 0) PG8_BAR;
        E(acc, cur, wr, wc, fr, fq);
        if (!has_next) break;
        if (!E.keep(cur)) {
#pragma unroll
        for (int a = 0; a < 2; ++a)
#pragma unroll
            for (int b = 0; b < 2; ++b)
#pragma unroll
                for (int m = 0; m < 4; ++m)
#pragma unroll
                    for (int n = 0; n < 2; ++n) acc[a][b][m][n] = (f32x4){0.f, 0.f, 0.f, 0.f};
        }
        cur = nxt; cA = nA; cB = nB; ++ui;
        if (wr == 1) PG8_BAR;
    }
    PG8_WAIT_V(0);
    PG8_BAR;
#undef PG8_SA
#undef PG8_SB
#undef PG8_STAGE
#undef PG8_LDA
#undef PG8_LDB
#undef PG8_MMA
#undef PG8_WAIT_V
#undef PG8_WAIT_L
#undef PG8_BAR
#undef PG8_SCHED
}
typedef f32x4 Acc[2][2][4][2];
#define EPI_ROW(u, ai, m) ((u).pm * 256 + (ai) * 128 + wr * 64 + (m) * 16 + fr)
#define EPI_COL(u, bj) ((u).pn * 256 + (bj) * 128 + wc * 32 + 8 * fq)

struct EpiIn {
    bf16_t* PA; float* SQP; float* SKP; bf16_t* KR; const float* ROPE;
    __device__ __forceinline__ bool keep(const Unit&) const { return false; }
    __device__ __forceinline__ void operator()(Acc& acc, const Unit& u, int wr, int wc, int fr, int fq) const {
        const int pn = u.pn; const bool act = (pn == 2 || pn == 3 || pn == 6 || pn == 7 || pn == 10 || pn == 11);
#pragma unroll
        for (int ai = 0; ai < 2; ++ai)
#pragma unroll
            for (int m = 0; m < 4; ++m) { const int row = EPI_ROW(u, ai, m); bf16_t* rowp = PA + (size_t)row * PAW + EPI_COL(u, 0);
#pragma unroll
                for (int bj = 0; bj < 2; ++bj) { f32x4 v0 = acc[ai][bj][m][0], v1 = acc[ai][bj][m][1];
                    if (act) {
#pragma unroll
                        for (int e = 0; e < 4; ++e) { v0[e] = siluf_(v0[e]); v1[e] = siluf_(v1[e]); } }
                    u32x4 w; w.x = cvtpk(v0[0], v0[1]); w.y = cvtpk(v0[2], v0[3]); w.z = cvtpk(v1[0], v1[1]); w.w = cvtpk(v1[2], v1[3]);
                    *(u32x4*)(rowp + bj * 128) = w; }
                if (pn == 4 || pn == 5) {
                    float s = 0.f;
#pragma unroll
                    for (int bj = 0; bj < 2; ++bj) if (pn == 4 || bj == 0) {
#pragma unroll
                        for (int n = 0; n < 2; ++n) { const f32x4 x = acc[ai][bj][m][n]; s += (x[0] * x[0] + x[1] * x[1]) + (x[2] * x[2] + x[3] * x[3]); } }
                    s += __shfl_xor(s, 16); s += __shfl_xor(s, 32);
                    if (fq == 0) (pn == 4 ? SQP : SKP)[(size_t)row * 4 + wc] = s;
                    if (pn == 5 && wc == 0) {
                        f32x4 o[2];
#pragma unroll
                        for (int n = 0; n < 2; ++n) { const f32x4 v = acc[ai][1][m][n]; const f32x4 cs = *(const f32x4*)(ROPE + (size_t)row * 32 + 2 * (4 * fq + 2 * n));
                            o[n][0] = v[0] * cs[0] - v[1] * cs[1]; o[n][1] = v[0] * cs[1] + v[1] * cs[0]; o[n][2] = v[2] * cs[2] - v[3] * cs[3]; o[n][3] = v[2] * cs[3] + v[3] * cs[2]; }
                        u32x4 w; w.x = cvtpk(o[0][0], o[0][1]); w.y = cvtpk(o[0][2], o[0][3]); w.z = cvtpk(o[1][0], o[1][1]); w.w = cvtpk(o[1][2], o[1][3]);
                        *(u32x4*)(KR + (size_t)row * 32 + 8 * fq) = w;
                    }
                }
                asm volatile("" ::: "memory");
            }
    }
};
struct EpiPlain {
    bf16_t* O; int ldc;
    __device__ __forceinline__ bool keep(const Unit&) const { return false; }
    __device__ __forceinline__ void operator()(Acc& acc, const Unit& u, int wr, int wc, int fr, int fq) const {
#pragma unroll
        for (int ai = 0; ai < 2; ++ai)
#pragma unroll
            for (int m = 0; m < 4; ++m) { bf16_t* rowp = O + (size_t)EPI_ROW(u, ai, m) * ldc + EPI_COL(u, 0);
#pragma unroll
                for (int bj = 0; bj < 2; ++bj) { const f32x4 v0 = acc[ai][bj][m][0], v1 = acc[ai][bj][m][1];
                    u32x4 w; w.x = cvtpk(v0[0], v0[1]); w.y = cvtpk(v0[2], v0[3]); w.z = cvtpk(v1[0], v1[1]); w.w = cvtpk(v1[2], v1[3]);
                    *(u32x4*)(rowp + bj * 128) = w; } }
    }
};
struct EpiGate {
    bf16_t* G; const float* bias;
    __device__ __forceinline__ bool keep(const Unit&) const { return false; }
    __device__ __forceinline__ void operator()(Acc& acc, const Unit& u, int wr, int wc, int fr, int fq) const {
        f32x4 bv[2][2];
#pragma unroll
        for (int bj = 0; bj < 2; ++bj)
#pragma unroll
            for (int n = 0; n < 2; ++n) bv[bj][n] = *(const f32x4*)(bias + EPI_COL(u, bj) + 4 * n);
#pragma unroll
        for (int ai = 0; ai < 2; ++ai)
#pragma unroll
            for (int m = 0; m < 4; ++m) { bf16_t* rowp = G + (size_t)EPI_ROW(u, ai, m) * PAW + EPI_COL(u, 0);
#pragma unroll
                for (int bj = 0; bj < 2; ++bj) { f32x4 v0 = acc[ai][bj][m][0] + bv[bj][0], v1 = acc[ai][bj][m][1] + bv[bj][1];
#pragma unroll
                    for (int e = 0; e < 4; ++e) { v0[e] = sigmoidf_(v0[e]); v1[e] = sigmoidf_(v1[e]); }
                    u32x4 w; w.x = cvtpk(v0[0], v0[1]); w.y = cvtpk(v0[2], v0[3]); w.z = cvtpk(v1[0], v1[1]); w.w = cvtpk(v1[2], v1[3]);
                    *(u32x4*)(rowp + bj * 128) = w; }
                asm volatile("" ::: "memory"); }
    }
};
struct EpiQ {
    bf16_t* Q; const float* SQP; const float* ROPE;
    __device__ __forceinline__ bool keep(const Unit&) const { return false; }
    __device__ __forceinline__ void operator()(Acc& acc, const Unit& u, int wr, int wc, int fr, int fq) const {
#pragma unroll
        for (int ai = 0; ai < 2; ++ai)
#pragma unroll
            for (int m = 0; m < 4; ++m) { const int row = EPI_ROW(u, ai, m); const f32x4 sq = *(const f32x4*)(SQP + (size_t)row * 4);
                const float sr = 1.0f / sqrtf(((sq[0] + sq[1]) + (sq[2] + sq[3])) * (1.0f / 256.0f) + LN_EPS);
#pragma unroll
                for (int bj = 0; bj < 2; ++bj) { const int col = EPI_COL(u, bj); f32x4 v[2];
#pragma unroll
                    for (int n = 0; n < 2; ++n) { v[n] = acc[ai][bj][m][n] * sr; const int d = (col + 4 * n) % 96;
                        if (d >= 64) { const f32x4 cs = *(const f32x4*)(ROPE + (size_t)row * 32 + (d - 64)); const f32x4 t = v[n];
                            v[n][0] = t[0] * cs[0] - t[1] * cs[1]; v[n][1] = t[0] * cs[1] + t[1] * cs[0]; v[n][2] = t[2] * cs[2] - t[3] * cs[3]; v[n][3] = t[2] * cs[3] + t[3] * cs[2]; } }
                    u32x4 w; w.x = cvtpk(v[0][0], v[0][1]); w.y = cvtpk(v[0][2], v[0][3]); w.z = cvtpk(v[1][0], v[1][1]); w.w = cvtpk(v[1][2], v[1][3]);
                    *(u32x4*)(Q + (size_t)row * 768 + col) = w; }
                asm volatile("" ::: "memory"); }
    }
};
struct EpiKV {
    bf16_t* KN; bf16_t* V; const float* SKP;
    __device__ __forceinline__ bool keep(const Unit&) const { return false; }
    __device__ __forceinline__ void operator()(Acc& acc, const Unit& u, int wr, int wc, int fr, int fq) const {
#pragma unroll
        for (int ai = 0; ai < 2; ++ai)
#pragma unroll
            for (int m = 0; m < 4; ++m) { const int row = EPI_ROW(u, ai, m); const f32x4 sq = *(const f32x4*)(SKP + (size_t)row * 4);
                const float sr = 1.0f / sqrtf(((sq[0] + sq[1]) + (sq[2] + sq[3])) * (1.0f / 128.0f) + LN_EPS);
#pragma unroll
                for (int bj = 0; bj < 2; ++bj) { const int head = 2 * u.pn + bj, local = wc * 32 + 8 * fq; const f32x4 v0 = acc[ai][bj][m][0] * sr, v1 = acc[ai][bj][m][1] * sr;
                    u32x4 w; w.x = cvtpk(v0[0], v0[1]); w.y = cvtpk(v0[2], v0[3]); w.z = cvtpk(v1[0], v1[1]); w.w = cvtpk(v1[2], v1[3]);
                    bf16_t* dst = (wc < 2) ? KN + (size_t)row * 512 + head * 64 + local : V + (size_t)row * 512 + head * 64 + (local - 64);
                    *(u32x4*)dst = w; }
                asm volatile("" ::: "memory"); }
    }
};
struct EpiGlu {
    bf16_t* PA; const float* bglu;
    __device__ __forceinline__ bool keep(const Unit&) const { return false; }
    __device__ __forceinline__ void operator()(Acc& acc, const Unit& u, int wr, int wc, int fr, int fq) const {
        const int j0 = 128 * u.pn + wc * 32 + 8 * fq;
        f32x4 ba[2], bb[2];
#pragma unroll
        for (int n = 0; n < 2; ++n) { ba[n] = *(const f32x4*)(bglu + j0 + 4 * n); bb[n] = *(const f32x4*)(bglu + 512 + j0 + 4 * n); }
#pragma unroll
        for (int ai = 0; ai < 2; ++ai)
#pragma unroll
            for (int m = 0; m < 4; ++m) { bf16_t* p = PA + (size_t)EPI_ROW(u, ai, m) * PAW + C_ZS + j0; const u32x4 z = *(const u32x4*)p; float y[8];
#pragma unroll
                for (int n = 0; n < 2; ++n) { const f32x4 a = acc[ai][0][m][n] + ba[n], b = acc[ai][1][m][n] + bb[n];
#pragma unroll
                    for (int e = 0; e < 4; ++e) y[4 * n + e] = a[e] * sigmoidf_(b[e]); }
                u32x4 w; w.x = cvtpk(y[0] * bflo(z.x), y[1] * bfhi(z.x)); w.y = cvtpk(y[2] * bflo(z.y), y[3] * bfhi(z.y)); w.z = cvtpk(y[4] * bflo(z.z), y[5] * bfhi(z.z)); w.w = cvtpk(y[6] * bflo(z.w), y[7] * bfhi(z.w));
                *(u32x4*)p = w; asm volatile("" ::: "memory"); }
    }
};
struct EpiMerge {
    bf16_t* G;
    __device__ __forceinline__ bool keep(const Unit& u) const { return u.sub < 2; }
    __device__ __forceinline__ void operator()(Acc& acc, const Unit& u, int wr, int wc, int fr, int fq) const {
        const int sub = u.sub;
#pragma unroll
        for (int ai = 0; ai < 2; ++ai)
#pragma unroll
            for (int m = 0; m < 4; ++m) { bf16_t* rowp = G + (size_t)EPI_ROW(u, ai, m) * PAW + EPI_COL(u, 0);
#pragma unroll
                for (int bj = 0; bj < 2; ++bj) { const u32x4 ga = *(const u32x4*)(rowp + bj * 128 + sub * 1024);
                    float f[8] = {bflo(ga.x), bfhi(ga.x), bflo(ga.y), bfhi(ga.y), bflo(ga.z), bfhi(ga.z), bflo(ga.w), bfhi(ga.w)};
                    if (sub < 2) { const u32x4 gb = *(const u32x4*)(rowp + bj * 128 + (sub + 1) * 1024);
                        const float d[8] = {bflo(gb.x), bfhi(gb.x), bflo(gb.y), bfhi(gb.y), bflo(gb.z), bfhi(gb.z), bflo(gb.w), bfhi(gb.w)};
#pragma unroll
                        for (int e = 0; e < 8; ++e) f[e] = f[e] / fmaxf(d[e], 1e-30f); }
                    f32x4 v0 = acc[ai][bj][m][0], v1 = acc[ai][bj][m][1];
#pragma unroll
                    for (int e = 0; e < 4; ++e) { v0[e] *= f[e]; v1[e] *= f[4 + e]; }
                    acc[ai][bj][m][0] = v0; acc[ai][bj][m][1] = v1;
                    if (sub == 2) { u32x4 w; w.x = cvtpk(v0[0], v0[1]); w.y = cvtpk(v0[2], v0[3]); w.z = cvtpk(v1[0], v1[1]); w.w = cvtpk(v1[2], v1[3]); *(u32x4*)(rowp + bj * 128) = w; } } }
    }
};
struct MergeOrder {
    int G, c; const char* PA; const char* WP;
    __device__ bool next(int i, Unit& u) const {
        const int tile = (i / 3) * G + c; if (tile >= 512) return false;
        u.sub = i % 3; u.pm = tile >> 2; u.pn = tile & 3;
        const int colA = (u.sub == 0) ? C_ZS : (u.sub == 1) ? C_ZM : C_ZX;
        u.a = PA + ((size_t)u.pm * 256 * PAW + colA) * 2; u.b = WP + (size_t)u.sub * (1024 * 512 * 2) + (size_t)u.pn * (256 * 512 * 2); return true;
    }
};
struct EpiOut {
    const float* xres; float* out;
    __device__ __forceinline__ bool keep(const Unit&) const { return false; }
    __device__ __forceinline__ void operator()(Acc& acc, const Unit& u, int wr, int wc, int fr, int fq) const {
#pragma unroll
        for (int ai = 0; ai < 2; ++ai)
#pragma unroll
            for (int m = 0; m < 4; ++m) { const size_t off = (size_t)EPI_ROW(u, ai, m) * DM + EPI_COL(u, 0);
#pragma unroll
                for (int bj = 0; bj < 2; ++bj)
#pragma unroll
                    for (int n = 0; n < 2; ++n) { const f32x4 x = *(const f32x4*)(xres + off + bj * 128 + 4 * n); *(f32x4*)(out + off + bj * 128 + 4 * n) = x * ALPHA + acc[ai][bj][m][n]; } }
    }
};
}

#define MFMA32(a, b, c) __builtin_amdgcn_mfma_f32_32x32x16_bf16((a), (b), (c), 0, 0, 0)
template <int DQK, int DK1, int DV, bool CAUSAL>
__device__ __forceinline__ void attn_unit(LAS unsigned char* lds, const bf16_t* Q, int ldq, const bf16_t* K1, int ldk1, const bf16_t* K2, int ldk2,
                                          const bf16_t* V, int ldv, bf16_t* ZO, int ldo, int q0, int nt) {
    constexpr int KROW = (DQK + 8) * 2, VROW = 136, KBUF = 64 * KROW, VBUF = DV * VROW, BUF = KBUF + VBUF;
    constexpr int KCH = DQK / 8, VCH = DV / 8, NKL = (64 * KCH + 511) / 512, NVL = (64 * VCH) / 512, NS = DQK / 16, NDB = DV / 32;
    int tid = threadIdx.x; asm volatile("" : "+v"(tid));
    const int lane = tid & 63, r = lane & 31, h = lane >> 5, w = __builtin_amdgcn_readfirstlane(tid >> 6);
    bf16x8 qf[NS];
    { const bf16_t* qrow = Q + (size_t)(q0 + 32 * w + r) * ldq + 8 * h;
#pragma unroll
      for (int s = 0; s < NS; ++s) qf[s] = *(const bf16x8*)(qrow + 16 * s); }
    f32x16 o[NDB];
#pragma unroll
    for (int db = 0; db < NDB; ++db)
#pragma unroll
        for (int i = 0; i < 16; ++i) o[db][i] = 0.f;
    float mrun = -1e30f, lrun = 0.f;
    u32x4 kreg[NKL], vreg[NVL];
#define ATT_LOAD(t) do { \
    _Pragma("unroll") for (int i_ = 0; i_ < NKL; ++i_) { const int c_ = tid + 512 * i_; if (c_ < 64 * KCH) { const int row_ = c_ / KCH, col_ = 8 * (c_ % KCH); const size_t kv_ = (size_t)(64 * (t) + row_); \
        const bf16_t* src_ = (col_ < DK1) ? K1 + kv_ * ldk1 + col_ : K2 + kv_ * ldk2 + (col_ - DK1); kreg[i_] = *(const u32x4*)src_; } } \
    _Pragma("unroll") for (int i_ = 0; i_ < NVL; ++i_) { const int c_ = tid + 512 * i_; const int row_ = c_ / VCH, ch_ = c_ % VCH; vreg[i_] = *(const u32x4*)(V + (size_t)(64 * (t) + row_) * ldv + 8 * ch_); } } while (0)
#define ATT_STORE(buf) do { LAS unsigned char* kb_ = lds + (buf) * BUF; LAS unsigned char* vb_ = kb_ + KBUF; \
    _Pragma("unroll") for (int i_ = 0; i_ < NKL; ++i_) { const int c_ = tid + 512 * i_; if (c_ < 64 * KCH) { const int row_ = c_ / KCH, col_ = 8 * (c_ % KCH); *(LAS u32x4*)(kb_ + row_ * KROW + col_ * 2) = kreg[i_]; } } \
    _Pragma("unroll") for (int i_ = 0; i_ < NVL; ++i_) { const int c_ = tid + 512 * i_; const int row_ = c_ / VCH, ch_ = c_ % VCH; const u32x4 v_ = vreg[i_]; LAS unsigned char* p_ = vb_ + (8 * ch_) * VROW + row_ * 2; \
        *(LAS bf16_t*)(p_) = (bf16_t)(v_.x & 0xffff); *(LAS bf16_t*)(p_ + VROW) = (bf16_t)(v_.x >> 16); *(LAS bf16_t*)(p_ + 2 * VROW) = (bf16_t)(v_.y & 0xffff); *(LAS bf16_t*)(p_ + 3 * VROW) = (bf16_t)(v_.y >> 16); \
        *(LAS bf16_t*)(p_ + 4 * VROW) = (bf16_t)(v_.z & 0xffff); *(LAS bf16_t*)(p_ + 5 * VROW) = (bf16_t)(v_.z >> 16); *(LAS bf16_t*)(p_ + 6 * VROW) = (bf16_t)(v_.w & 0xffff); *(LAS bf16_t*)(p_ + 7 * VROW) = (bf16_t)(v_.w >> 16); } } while (0)
    ATT_LOAD(0); ATT_STORE(0); __syncthreads();
    const int qg = q0 + 32 * w + r;
    for (int t = 0; t < nt; ++t) {
        const int buf = t & 1;
        if (t + 1 < nt) ATT_LOAD(t + 1);
        const bool active = !CAUSAL || (64 * t <= q0 + 32 * w + 31);
        if (active) {
            LAS unsigned char* kb = lds + buf * BUF; LAS unsigned char* vb = kb + KBUF;
            f32x16 s0, s1;
#pragma unroll
            for (int i = 0; i < 16; ++i) { s0[i] = 0.f; s1[i] = 0.f; }
#pragma unroll
            for (int s = 0; s < NS; ++s) { const bf16x8 k0 = *(const LAS bf16x8*)(kb + r * KROW + (16 * s + 8 * h) * 2); const bf16x8 k1 = *(const LAS bf16x8*)(kb + (32 + r) * KROW + (16 * s + 8 * h) * 2);
                s0 = MFMA32(k0, qf[s], s0); s1 = MFMA32(k1, qf[s], s1); }
            if (CAUSAL && (64 * t + 63 > q0 + 32 * w)) {
#pragma unroll
                for (int i = 0; i < 16; ++i) { const int kv = 64 * t + crow(i, h); if (kv > qg) s0[i] = -1e30f; if (kv + 32 > qg) s1[i] = -1e30f; } }
            float mx = fmaxf(s0[0], s1[0]);
#pragma unroll
            for (int i = 1; i < 16; ++i) mx = fmaxf(mx, fmaxf(s0[i], s1[i]));
            mx = fmaxf(mx, __shfl_xor(mx, 32));
            const float mn = fmaxf(mrun, mx), alpha = __builtin_amdgcn_exp2f(mrun - mn); mrun = mn;
            float ps = 0.f;
#pragma unroll
            for (int i = 0; i < 16; ++i) { s0[i] = __builtin_amdgcn_exp2f(s0[i] - mn); s1[i] = __builtin_amdgcn_exp2f(s1[i] - mn); ps += s0[i] + s1[i]; }
            lrun = lrun * alpha + ps;
#pragma unroll
            for (int db = 0; db < NDB; ++db)
#pragma unroll
                for (int i = 0; i < 16; ++i) o[db][i] *= alpha;
            bf16x8 pf[4];
#pragma unroll
            for (int s = 0; s < 2; ++s) { u32x4 a, b;
                a.x = cvtpk(s0[8 * s], s0[8 * s + 1]); a.y = cvtpk(s0[8 * s + 2], s0[8 * s + 3]); a.z = cvtpk(s0[8 * s + 4], s0[8 * s + 5]); a.w = cvtpk(s0[8 * s + 6], s0[8 * s + 7]);
                b.x = cvtpk(s1[8 * s], s1[8 * s + 1]); b.y = cvtpk(s1[8 * s + 2], s1[8 * s + 3]); b.z = cvtpk(s1[8 * s + 4], s1[8 * s + 5]); b.w = cvtpk(s1[8 * s + 6], s1[8 * s + 7]);
                pf[s] = __builtin_bit_cast(bf16x8, a); pf[2 + s] = __builtin_bit_cast(bf16x8, b); }
#pragma unroll
            for (int db = 0; db < NDB; ++db)
#pragma unroll
                for (int ks = 0; ks < 4; ++ks) {
                    const LAS unsigned char* vp = vb + (32 * db + r) * VROW + (16 * ks + 4 * h) * 2;
                    const u32x2 lo = *(const LAS u32x2*)vp, hi = *(const LAS u32x2*)(vp + 16);
                    u32x4 vv; vv.x = lo.x; vv.y = lo.y; vv.z = hi.x; vv.w = hi.y;
                    o[db] = MFMA32(__builtin_bit_cast(bf16x8, vv), pf[ks], o[db]); }
        }
        if (t + 1 < nt) ATT_STORE(buf ^ 1);
        __syncthreads();
    }
#undef ATT_LOAD
#undef ATT_STORE
    const float lt = lrun + __shfl_xor(lrun, 32), inv = 1.0f / lt;
#pragma unroll
    for (int db = 0; db < NDB; ++db)
#pragma unroll
        for (int g4 = 0; g4 < 4; ++g4) { bf16_t* zp = ZO + (size_t)qg * ldo + 32 * db + 8 * g4 + 4 * h; const u32x2 z = *(const u32x2*)zp;
            u32x2 wv; wv.x = cvtpk(o[db][4 * g4] * inv * bflo(z.x), o[db][4 * g4 + 1] * inv * bfhi(z.x)); wv.y = cvtpk(o[db][4 * g4 + 2] * inv * bflo(z.y), o[db][4 * g4 + 3] * inv * bfhi(z.y));
            *(u32x2*)zp = wv; }
}

template <bool OUT>
__device__ __forceinline__ void ssm_task(LAS unsigned char* wl, int task, bf16_t* PA, const unsigned char* tab, const float* dskip, f32x2* SS) {
    int lane = threadIdx.x & 63; asm volatile("" : "+v"(lane));
    const int r = lane & 31, h = lane >> 5, row16 = lane & 15, quad = lane >> 4;
    const int chunk = task & 7, g = (task >> 3) & 31, b = task >> 8;
    const bf16_t* BBt = (const bf16_t*)tab; const bf16_t* CMt = (const bf16_t*)(tab + 128 * 1024);
    const f32x2* LAM = (const f32x2*)(tab + 256 * 1024); const f32x2* LAML = (const f32x2*)(tab + 272 * 1024);
    bf16x8 bbf[4], cmf[4];
#pragma unroll
    for (int nb = 0; nb < 4; ++nb) bbf[nb] = *(const bf16x8*)(BBt + ((size_t)(g * 128 + 32 * nb + r)) * 16 + 8 * h);
    if (OUT) {
#pragma unroll
        for (int ks = 0; ks < 4; ++ks) cmf[ks] = *(const bf16x8*)(CMt + ((size_t)(g * 16 + row16)) * 128 + 32 * ks + 8 * quad);
    }
    const f32x2 lam = LAM[g * 64 + lane];
    const float dsk = OUT ? dskip[16 * g + row16] : 0.f;
    float hr = 0.f, hi = 0.f;
    f32x2* ssb = SS + ((size_t)(b * 32 + g) * SSM_NC) * 64 + lane;
    if (OUT) { const f32x2 lL = LAML[g * 64 + lane];
        for (int k = 0; k < chunk; ++k) { const f32x2 s = ssb[(size_t)k * 64]; const float nr = lL.x * hr - lL.y * hi + s.x, ni = lL.x * hi + lL.y * hr + s.y; hr = nr; hi = ni; } }
    LAS float* W = (LAS float*)wl;
    for (int sub = 0; sub < SSM_L / 32; ++sub) {
        const size_t tok0 = (size_t)b * SEQ + chunk * SSM_L + sub * 32;
        const bf16x8 uf = *(const bf16x8*)(PA + (tok0 + r) * PAW + C_U + 16 * g + 8 * h);
#pragma unroll
        for (int nb = 0; nb < 4; ++nb) { f32x16 z;
#pragma unroll
            for (int i = 0; i < 16; ++i) z[i] = 0.f;
            const f32x16 bu = MFMA32(uf, bbf[nb], z);
#pragma unroll
            for (int i = 0; i < 16; ++i) W[crow(i, h) * 132 + 32 * nb + r] = bu[i]; }
        LDS_WAIT();
        f32x2 bq[32];
#pragma unroll
        for (int t = 0; t < 32; ++t) bq[t] = *(const LAS f32x2*)(W + t * 132 + 2 * lane);
        LDS_WAIT();
#pragma unroll
        for (int t = 0; t < 32; ++t) { const float nr = lam.x * hr - lam.y * hi + bq[t].x, ni = lam.x * hi + lam.y * hr + bq[t].y; hr = nr; hi = ni;
            if (OUT) *(LAS unsigned*)((LAS unsigned char*)W + t * 528 + 4 * lane) = cvtpk(hr, hi); }
        if (OUT) {
            LDS_WAIT();
#pragma unroll
            for (int mb = 0; mb < 2; ++mb) { f32x4 acc = (f32x4){0.f, 0.f, 0.f, 0.f};
#pragma unroll
                for (int ks = 0; ks < 4; ++ks) { const bf16x8 af = *(const LAS bf16x8*)((LAS unsigned char*)W + (16 * mb + row16) * 528 + (32 * ks + 8 * quad) * 2);
                    acc = __builtin_amdgcn_mfma_f32_16x16x32_bf16(af, cmf[ks], acc, 0, 0, 0); }
#pragma unroll
                for (int j = 0; j < 4; ++j) { bf16_t* p = PA + (tok0 + 16 * mb + 4 * quad + j) * PAW + C_U + 16 * g + row16; const float y = acc[j] + dsk * bf2f(*p); *p = f2bf(gelu_tanh(y)); } }
            LDS_WAIT();
        }
    }
    if (!OUT) ssb[(size_t)chunk * 64] = (f32x2){hr, hi};
}

enum { MAT_PLAIN = 0, MAT_WIN = 1, MAT_WGLU = 2, MAT_WUQ = 3 };
__device__ __forceinline__ void cvt_item(const float* W, int ldw, int K, bf16_t* WT, int mat, int item, int nblk, LAS float* scr, int lane, const float* kscale) {
    const int kb = item / nblk, nb = item % nblk, k0 = 64 * kb, n0 = 32 * nb, n = n0 + (lane & 31);
    int src = n; float sc = 1.f;
    if (mat == MAT_WIN) {
        if (n < 1408) src = n; else if (n < 1440) { const int j = n - 1408; src = 1408 + ((j & 1) ? 16 + (j >> 1) : (j >> 1)); } else if (n < 1536) src = -1; else src = n - 96;
        if (n >= C_QX && n < C_ZX) sc = QMEM_SCALE;
    } else if (mat == MAT_WGLU) { const int pn = n >> 8, bj = (n >> 7) & 1, i = n & 127; src = bj * 512 + 128 * pn + i; }
    else if (mat == MAT_WUQ) { const int hd = n / 96; int d = n % 96; if (d >= 64) { const int j = d - 64; d = 64 + ((j & 1) ? 16 + (j >> 1) : (j >> 1)); } src = 96 * hd + d; sc = MLA_SCALE; }
#pragma unroll 8
    for (int i = 0; i < 32; ++i) { const int kk = 2 * i + (lane >> 5); float v = (src >= 0) ? W[(size_t)(k0 + kk) * ldw + src] : 0.f; v *= sc; if (kscale) v *= kscale[k0 + kk]; scr[kk * 33 + (lane & 31)] = v; }
    LDS_WAIT();
    const int c = lane & 7;
#pragma unroll
    for (int j = 0; j < 4; ++j) { const int nn = (lane >> 3) + 8 * j; const LAS float* s = scr + (8 * c) * 33 + nn;
        u32x4 o; o.x = cvtpk(s[0 * 33], s[1 * 33]); o.y = cvtpk(s[2 * 33], s[3 * 33]); o.z = cvtpk(s[4 * 33], s[5 * 33]); o.w = cvtpk(s[6 * 33], s[7 * 33]);
        *(u32x4*)(WT + (size_t)(n0 + nn) * K + k0 + 8 * c) = o; }
    LDS_WAIT();
}

struct Args { const void* in[26]; float* out; unsigned char* ws; int ph_lo, ph_hi; };

__device__ __forceinline__ void convert_layer(const Args& a, int l, LAS float* scr, int gw, int NGW, int lane) {
    unsigned char* wb = a.ws + WS_WB;
    constexpr int I_WIN = 16 * 192, I_GLU = 8 * 32, I_UQ = 4 * 24, I_UKV = 2 * 32, I_MEM = 16 * 32, I_P = 8 * 32, I_OUT = 16 * 32;
    constexpr int NIT = I_WIN + I_GLU + I_UQ + I_UKV + I_MEM + 3 * I_P + I_OUT;
    for (int it = gw; it < NIT; it += NGW) {
        int r = it;
        if (r < I_WIN) { cvt_item((const float*)a.in[3] + (size_t)l * DM * DIN, DIN, 1024, (bf16_t*)(wb + WB_WIN), MAT_WIN, r, 192, scr, lane, nullptr); continue; } r -= I_WIN;
        if (r < I_GLU) { cvt_item((const float*)a.in[13] + (size_t)l * 512 * 1024, 1024, 512, (bf16_t*)(wb + WB_WGLU), MAT_WGLU, r, 32, scr, lane, nullptr); continue; } r -= I_GLU;
        if (r < I_UQ) { cvt_item((const float*)a.in[16] + (size_t)l * 256 * 768, 768, 256, (bf16_t*)(wb + WB_WUQ), MAT_WUQ, r, 24, scr, lane, (const float*)a.in[15] + l * 256); continue; } r -= I_UQ;
        if (r < I_UKV) { cvt_item((const float*)a.in[18] + (size_t)l * 128 * 1024, 1024, 128, (bf16_t*)(wb + WB_WUKV), MAT_PLAIN, r, 32, scr, lane, (const float*)a.in[17] + l * 128); continue; } r -= I_UKV;
        if (r < I_MEM) { cvt_item((const float*)a.in[19] + (size_t)l * 1024 * 1024, 1024, 1024, (bf16_t*)(wb + WB_WMEM), MAT_PLAIN, r, 32, scr, lane, nullptr); continue; } r -= I_MEM;
        if (r < 3 * I_P) { const int which = r / I_P; cvt_item((const float*)a.in[20 + which] + (size_t)l * 512 * 1024, 1024, 512, (bf16_t*)(wb + WB_WP) + (size_t)which * 1024 * 512, MAT_PLAIN, r % I_P, 32, scr, lane, nullptr); continue; } r -= 3 * I_P;
        cvt_item((const float*)a.in[23] + (size_t)l * 1024 * 1024, 1024, 1024, (bf16_t*)(wb + WB_WOUT), MAT_PLAIN, r, 32, scr, lane, nullptr);
    }
}


typedef unsigned gu32_plain;
#define XB_TMO      128
#define XB_XCNT(j)  (256  + 64 * (j))
#define XB_XSUB(j)  (1280 + 64 * (j))
#define XB_XGEN(j)  (2304 + 64 * (j))
#define XB_TOP      3328
#define XB_TOPGEN   3392
#define XCD_BAR_WORDS 3456
#define XB_SPIN_CAP (1u << 18)

__device__ __forceinline__ unsigned xb_ld(unsigned* p)              { return __hip_atomic_load(p, __ATOMIC_RELAXED, __HIP_MEMORY_SCOPE_AGENT); }
__device__ __forceinline__ unsigned xb_add(unsigned* p, unsigned v) { return __hip_atomic_fetch_add(p, v, __ATOMIC_RELAXED, __HIP_MEMORY_SCOPE_AGENT); }
__device__ __forceinline__ unsigned xb_xcc_id() { return (unsigned)__builtin_amdgcn_s_getreg((3 << 11) | 20) & 0xFu; }
#define XB_SPIN(cond, bar) do { unsigned _sp = 0; while (cond) { __builtin_amdgcn_s_sleep(1); \
    if ((++_sp & 255u) == 0u) { if (xb_ld(&(bar)[XB_TMO])) break; if (_sp > XB_SPIN_CAP) { atomicAdd(&(bar)[XB_TMO], 1u); break; } } } } while (0)

struct XcdBarrier {
    unsigned* bar; unsigned x;
    volatile LAS unsigned* st;
};

__device__ __forceinline__ XcdBarrier xcd_barrier_post(unsigned* bar, volatile LAS unsigned* st) {
    XcdBarrier b; b.bar = bar; b.x = xb_xcc_id(); b.st = st;
    if (threadIdx.x == 0) (void)xb_add(&bar[XB_XCNT(b.x)], 1u);
    return b;
}
__device__ __forceinline__ void xcd_barrier_complete(unsigned* bar, unsigned x, unsigned& nloc, unsigned& nx) {
    const unsigned G = gridDim.x * gridDim.y * gridDim.z;
    unsigned sum, cnt, mine, sp = 0u;
    for (;;) {
        sum = 0u; cnt = 0u; mine = 0u;
#pragma unroll
        for (unsigned j = 0; j < 16; ++j) { const unsigned c = xb_ld(&bar[XB_XCNT(j)]); sum += c; cnt += (c > 0u) ? 1u : 0u; mine = (j == x) ? c : mine; }
        if (sum == G) break;
        __builtin_amdgcn_s_sleep(1);
        if ((++sp & 255u) == 0u) { if (xb_ld(&bar[XB_TMO])) break; if (sp > XB_SPIN_CAP) { atomicAdd(&bar[XB_TMO], 1u); break; } }
    }
    nloc = mine > 0u ? mine : 1u; nx = cnt > 0u ? cnt : 1u;
}

__device__ __forceinline__ void xcd_barrier(const XcdBarrier& b) {
    asm volatile("s_waitcnt vmcnt(0)" ::: "memory");
    __syncthreads();
    if (threadIdx.x == 0) {
        unsigned* bar = b.bar;
        __builtin_amdgcn_s_waitcnt(0);
        unsigned nloc = b.st[0], nx = b.st[1];
        if (nloc == 0u) { xcd_barrier_complete(bar, b.x, nloc, nx); b.st[0] = nloc; b.st[1] = nx; }
        const unsigned old = xb_add(&bar[XB_XSUB(b.x)], 1u);
        const unsigned gen = old / nloc;
        if (old + 1u == (gen + 1u) * nloc) {
            __builtin_amdgcn_fence(__ATOMIC_RELEASE, "agent");
            asm volatile("s_waitcnt vmcnt(0)" ::: "memory");
            const unsigned og = xb_add(&bar[XB_TOP], 1u);
            const unsigned tg = og / nx;
            if (og + 1u == (tg + 1u) * nx) xb_add(&bar[XB_TOPGEN], 1u);
            else XB_SPIN(xb_ld(&bar[XB_TOPGEN]) == tg, bar);
            __builtin_amdgcn_fence(__ATOMIC_ACQUIRE, "agent");
            xb_add(&bar[XB_XGEN(b.x)], 1u);
            asm volatile("s_waitcnt vmcnt(0)" ::: "memory");
        } else {
            XB_SPIN(xb_ld(&bar[XB_XGEN(b.x)]) == gen, bar);
            __builtin_amdgcn_fence(__ATOMIC_ACQUIRE, "agent");
            asm volatile("s_waitcnt vmcnt(0)" ::: "memory");
        }
    }
    __syncthreads();
}
constexpr int NWAVES = 8, LDS_BYTES = 147456, LDS_BARST = 147392;
constexpr size_t WS_CTL = 0, CTL_BYTES = 16384;
constexpr int N_PHASES = 1 + 7 * DEPTH;

__global__ void __launch_bounds__(NWAVES * 64, 2) mk_fwd(Args args) {
    extern __shared__ __attribute__((aligned(16))) unsigned char lds_raw[];
    LAS unsigned char* lds = (LAS unsigned char*)lds_raw;
    const int G = gridDim.x, cu = blockIdx.x, NGW = G * NWAVES;
    unsigned char* ws = args.ws;
#if !MK_MULTI
    if (threadIdx.x < 2) ((LAS unsigned*)(lds + LDS_BARST))[threadIdx.x] = 0u;
    __syncthreads();
    const XcdBarrier gbar = xcd_barrier_post((unsigned*)(ws + WS_CTL), (volatile LAS unsigned*)(lds + LDS_BARST));
#endif
    bf16_t* XB = (bf16_t*)(ws + WS_XB); bf16_t* PA = (bf16_t*)(ws + WS_PA); bf16_t* RG = (bf16_t*)(ws + WS_R);
    bf16_t* QB = (bf16_t*)(ws + WS_R + R_Q); bf16_t* KN = (bf16_t*)(ws + WS_R + R_KN); bf16_t* KR = (bf16_t*)(ws + WS_R + R_KR); bf16_t* VB = (bf16_t*)(ws + WS_R + R_V);
    bf16_t* MEMB = (bf16_t*)(ws + WS_MEMB); bf16_t* MEMKV = (bf16_t*)(ws + WS_MEMKV);
    float* SQP = (float*)(ws + WS_SQP); float* SKP = (float*)(ws + WS_SKP); float* ROPE = (float*)(ws + WS_ROPE); f32x2* SS = (f32x2*)(ws + WS_SS);
    unsigned char* wb = ws + WS_WB;
    const float* xin = (const float*)args.in[0];
    float* out = args.out;

    if (args.ph_lo == 0 && (PHMASK & 1)) {
        int tid = threadIdx.x; asm volatile("" : "+v"(tid));
        const int lane = tid & 63, wave = __builtin_amdgcn_readfirstlane(tid >> 6), gw = cu * NWAVES + wave;

            convert_layer(args, 0, (LAS float*)(lds + wave * 16384), gw, NGW, lane);
            { const size_t n4 = (size_t)MTOK * DM / 4;
              for (size_t i = (size_t)cu * 512 + tid; i < n4; i += (size_t)G * 512) { const f32x4 v = ((const f32x4*)xin)[i]; u32x2 w; w.x = cvtpk(v[0], v[1]); w.y = cvtpk(v[2], v[3]); ((u32x2*)XB)[i] = w; } }
            { const size_t n4 = (size_t)NB * MEML * DM / 4; const float* mem = (const float*)args.in[1];
              for (size_t i = (size_t)cu * 512 + tid; i < n4; i += (size_t)G * 512) { const f32x4 v = ((const f32x4*)mem)[i]; u32x2 w; w.x = cvtpk(v[0], v[1]); w.y = cvtpk(v[2], v[3]); ((u32x2*)MEMB)[i] = w; } }
            { const int* pos = (const int*)args.in[2];
              for (int i = cu * 512 + tid; i < MTOK * 16; i += G * 512) { const int m = i >> 4, f = i & 15; const double invf = exp(-(double)f * (9.210340371976184 / 16.0)); double c, s; cossin_d((double)pos[m] * invf, c, s);
                  ROPE[(size_t)i * 2] = (float)c; ROPE[(size_t)i * 2 + 1] = (float)s; } }
            {
              for (int i = cu * 512 + tid; i < DEPTH * 32 * 64; i += G * 512) { const int p = i & 63, g = (i >> 6) & 31, l = i >> 11;
                  unsigned char* tab = ws + WS_TAB + (size_t)l * TAB_L; bf16_t* BBt = (bf16_t*)tab; bf16_t* CMt = (bf16_t*)(tab + 128 * 1024); f32x2* LAM = (f32x2*)(tab + 256 * 1024); f32x2* LAML = (f32x2*)(tab + 272 * 1024);
                  const double dt = exp((double)((const float*)args.in[7])[l * 32 + g]); const double lr = ((const float*)args.in[5])[(l * 32 + g) * 64 + p], li = ((const float*)args.in[6])[(l * 32 + g) * 64 + p];
                  const double mag = exp(lr * dt); double c, s; cossin_d(li * dt, c, s); const double lbr = mag * c, lbi = mag * s, nr = lbr - 1.0, ni = lbi, den = lr * lr + li * li;
                  const double fre = (nr * lr + ni * li) / den, fim = (ni * lr - nr * li) / den;
                  const float* bre = (const float*)args.in[8] + ((size_t)(l * 32 + g) * 64 + p) * 16; const float* bim = (const float*)args.in[9] + ((size_t)(l * 32 + g) * 64 + p) * 16;
                  for (int cc = 0; cc < 16; ++cc) { const double br = bre[cc], bi = bim[cc]; BBt[((size_t)g * 128 + 2 * p) * 16 + cc] = f2bf((float)(fre * br - fim * bi)); BBt[((size_t)g * 128 + 2 * p + 1) * 16 + cc] = f2bf((float)(fre * bi + fim * br)); }
                  const float* cre = (const float*)args.in[10] + (size_t)(l * 32 + g) * 16 * 64; const float* cim = (const float*)args.in[11] + (size_t)(l * 32 + g) * 16 * 64;
                  for (int cc = 0; cc < 16; ++cc) { CMt[((size_t)g * 16 + cc) * 128 + 2 * p] = f2bf(cre[cc * 64 + p]); CMt[((size_t)g * 16 + cc) * 128 + 2 * p + 1] = f2bf(-cim[cc * 64 + p]); }
                  LAM[g * 64 + p] = (f32x2){(float)lbr, (float)lbi};
                  const double magL = exp(lr * dt * (double)SSM_L); double cL, sL; cossin_d(li * dt * (double)SSM_L, cL, sL); LAML[g * 64 + p] = (f32x2){(float)(magL * cL), (float)(magL * sL)}; } }
#if !MK_MULTI
        if (args.ph_hi > 1) { __threadfence(); cg::this_grid().sync(); }
#endif
    }
    for (int ph = (args.ph_lo > 1 ? args.ph_lo : 1); ph < args.ph_hi; ++ph) {
        int tid = threadIdx.x; asm volatile("" : "+v"(tid));
        const int lane = tid & 63, wave = __builtin_amdgcn_readfirstlane(tid >> 6), gw = cu * NWAVES + wave;
        {
            const int l = (ph - 1) / 7, k = (ph - 1) % 7;
            const unsigned char* tab = ws + WS_TAB + (size_t)l * TAB_L;
            if (k == 0 && (PHMASK & 2)) {
                { pg8::StaticOrder S; S.init(MTOK, PAW, G, cu, XB, DM, wb + WB_WIN, DM); pg8::EpiIn E{PA, SQP, SKP, KR, ROPE}; pg8::gemm_phase(lds, DM, DM, S, E); }
                { pg8::StaticOrder S; S.init(NB * MEML, 1024, G, cu, MEMB, DM, wb + WB_WMEM, DM); pg8::EpiPlain E{MEMKV, 1024}; pg8::gemm_phase(lds, DM, DM, S, E); }
            } else if (k == 1 && (PHMASK & 4)) {
                if (K1MASK & 1) { pg8::StaticOrder S; S.init(MTOK, 768, G, cu, PA + C_CQ, PAW, wb + WB_WUQ, 256); pg8::EpiQ E{QB, SQP, ROPE}; pg8::gemm_phase(lds, 256, PAW, S, E); }
                if (K1MASK & 2) { pg8::StaticOrder S; S.init(MTOK, 1024, G, cu, PA + C_CKV, PAW, wb + WB_WUKV, 128); pg8::EpiKV E{KN, VB, SKP}; pg8::gemm_phase(lds, 128, PAW, S, E); }
                if (K1MASK & 4) for (int task = gw; task < NB * 32 * SSM_NC; task += NGW) ssm_task<false>(lds + wave * 16896, task, PA, tab, (const float*)args.in[12] + l * 512, SS);
                __syncthreads();
                if (K1MASK & 8) for (int ui = cu; ui < NB * 4 * 16; ui += G) { const int b = ui >> 6, hh = (ui >> 4) & 3, qb = ui & 15; const size_t t0 = (size_t)b * SEQ;
#pragma unroll 1
                    for (int e = 0; e < 2; ++e)
                    attn_unit<128, 128, 64, false>(lds, PA + t0 * PAW + C_QX + 128 * hh, PAW, MEMKV + (size_t)b * MEML * 1024 + 128 * hh, 1024, nullptr, 0,
                                                    MEMKV + (size_t)b * MEML * 1024 + 512 + 128 * hh + 64 * e, 1024, PA + t0 * PAW + C_ZX + 128 * hh + 64 * e, PAW, 256 * qb, MEML / 64); }
            } else if (k == 2 && (PHMASK & 8)) {
                for (int pi = cu; pi < NB * 8 * 8; pi += G) { const int bh = pi >> 3, j = pi & 7, b = bh >> 3, hh = bh & 7; const size_t t0 = (size_t)b * SEQ;
#pragma unroll 1
                    for (int e = 0; e < 2; ++e) { const int qb = e ? 15 - j : j;
                        attn_unit<96, 64, 64, true>(lds, QB + t0 * 768 + 96 * hh, 768, KN + t0 * 512 + 64 * hh, 512, KR + t0 * 32, 32, VB + t0 * 512 + 64 * hh, 512, PA + t0 * PAW + C_ZM + 64 * hh, PAW, 256 * qb, 4 * (qb + 1)); } }
                for (int task = gw; task < NB * 32 * SSM_NC; task += NGW) ssm_task<true>(lds + wave * 16896, task, PA, tab, (const float*)args.in[12] + l * 512, SS);
                __syncthreads();
            } else if (k == 3 && (PHMASK & 16)) {
                { pg8::StaticOrder S; S.init(MTOK, PAW, G, cu, XB, DM, wb + WB_WIN + (size_t)PAW * DM * 2, DM); pg8::EpiGate E{RG, (const float*)args.in[4] + l * 3072}; pg8::gemm_phase(lds, DM, DM, S, E); }
                { pg8::StaticOrder S; S.init(MTOK, 1024, G, cu, PA + C_U, PAW, wb + WB_WGLU, 512); pg8::EpiGlu E{PA, (const float*)args.in[14] + l * 1024}; pg8::gemm_phase(lds, 512, PAW, S, E); }
            } else if (k == 4 && (PHMASK & 32)) {
                pg8::MergeOrder S{G, cu, (const char*)PA, (const char*)(wb + WB_WP)}; pg8::EpiMerge E{RG}; pg8::gemm_phase(lds, 512, PAW, S, E);
            } else if (k == 5 && (PHMASK & 64)) {
                pg8::StaticOrder S; S.init(MTOK, DM, G, cu, RG, PAW, wb + WB_WOUT, DM); pg8::EpiOut E{l == 0 ? xin : (const float*)out, out}; pg8::gemm_phase(lds, DM, PAW, S, E);
            } else if (k == 6 && (PHMASK & 128)) {
                const float* lg = (const float*)args.in[24] + l * DM; const float* lb = (const float*)args.in[25] + l * DM;
                f32x4 gv[4], bv[4];
#pragma unroll
                for (int j = 0; j < 4; ++j) { gv[j] = ((const f32x4*)lg)[lane + 64 * j]; bv[j] = ((const f32x4*)lb)[lane + 64 * j]; }
                for (int m = gw; m < MTOK; m += NGW) { f32x4* xr = (f32x4*)(out + (size_t)m * DM) + lane; f32x4 v[4]; float s = 0.f;
#pragma unroll
                    for (int j = 0; j < 4; ++j) { v[j] = xr[64 * j]; s += (v[j][0] + v[j][1]) + (v[j][2] + v[j][3]); }
                    const float mean = wave_sum(s) * (1.f / DM); float s2 = 0.f;
#pragma unroll
                    for (int j = 0; j < 4; ++j) { v[j] = v[j] - mean; s2 += (v[j][0] * v[j][0] + v[j][1] * v[j][1]) + (v[j][2] * v[j][2] + v[j][3] * v[j][3]); }
                    const float rstd = 1.f / sqrtf(wave_sum(s2) * (1.f / DM) + LN_EPS);
                    u32x2* xb = (u32x2*)(XB + (size_t)m * DM) + lane;
#pragma unroll
                    for (int j = 0; j < 4; ++j) { const f32x4 y = v[j] * rstd * gv[j] + bv[j]; xr[64 * j] = y; u32x2 w; w.x = cvtpk(y[0], y[1]); w.y = cvtpk(y[2], y[3]); xb[64 * j] = w; } }
                if (l + 1 < DEPTH) convert_layer(args, l + 1, (LAS float*)(lds + wave * 16384), gw, NGW, lane);
            }
        }
#if !MK_MULTI
        if (ph + 1 < args.ph_hi) xcd_barrier(gbar);
#endif
    }
}

extern "C" void kernel_launch(void* const* d_in, const int* in_sizes, int n_in, void* d_out, int out_size, void* d_ws, size_t ws_size, hipStream_t stream) {
    static int grid = 0;
    if (grid == 0) {
        if (n_in != 26 || out_size != MTOK * DM || ws_size < WS_END) { fprintf(stderr, "kernel_launch: unexpected sizes n_in %d out %d ws %zu\n", n_in, out_size, ws_size); grid = -1; return; }
        int dev = 0, cus = 0, per_cu = 0;
        hipGetDevice(&dev); hipDeviceGetAttribute(&cus, hipDeviceAttributeMultiprocessorCount, dev);
        hipFuncSetAttribute((const void*)mk_fwd, hipFuncAttributeMaxDynamicSharedMemorySize, LDS_BYTES);
        hipOccupancyMaxActiveBlocksPerMultiprocessor(&per_cu, (const void*)mk_fwd, NWAVES * 64, LDS_BYTES);
        if (per_cu < 1) { fprintf(stderr, "kernel_launch: occupancy query says %d blocks/CU\n", per_cu); per_cu = 1; }
        (void)hipGetLastError();
        grid = cus * 1;
    }
    if (grid < 0) return;
    Args a{};
    for (int i = 0; i < 26; ++i) a.in[i] = d_in[i];
    a.out = (float*)d_out; a.ws = (unsigned char*)d_ws;
#if MK_MULTI
    for (int ph = 0; ph < N_PHASES; ++ph) { a.ph_lo = ph; a.ph_hi = ph + 1; hipLaunchKernelGGL(mk_fwd, dim3(grid), dim3(NWAVES * 64), LDS_BYTES, stream, a); }
#else
    a.ph_lo = 0; a.ph_hi = N_PHASES;
    if (hipMemsetAsync((char*)d_ws + WS_CTL, 0, CTL_BYTES, stream) != hipSuccess) { fprintf(stderr, "kernel_launch: memset of barrier words failed\n"); return; }
    void* kargs[] = {&a};
    hipError_t e = hipLaunchCooperativeKernel((const void*)mk_fwd, dim3(grid), dim3(NWAVES * 64), kargs, LDS_BYTES, stream);
    if (e != hipSuccess) fprintf(stderr, "cooperative launch failed: %s (grid %d)\n", hipGetErrorString(e), grid);
#endif
}
```

```cpp
#include <hip/hip_runtime.h>
#include <hip/hip_cooperative_groups.h>
#include <cstdio>
#include <cstdint>
namespace cg = cooperative_groups;

#ifndef MK_MULTI
#define MK_MULTI 0
#endif

#ifndef PROBE_JOB
#define PROBE_JOB 0
#endif
#ifndef K1MASK
#define K1MASK 15
#endif
#ifndef PHMASK
#define PHMASK 255
#endif
#define LAS __attribute__((address_space(3)))
typedef unsigned short bf16_t;
typedef short bf16x8 __attribute__((ext_vector_type(8)));
typedef float f32x2 __attribute__((ext_vector_type(2)));
typedef float f32x4 __attribute__((ext_vector_type(4)));
typedef float f32x16 __attribute__((ext_vector_type(16)));
typedef unsigned u32x2 __attribute__((ext_vector_type(2)));
typedef unsigned u32x4 __attribute__((ext_vector_type(4)));
typedef __bf16 bf16x2_t __attribute__((ext_vector_type(2)));

constexpr int DM = 1024, NB = 8, SEQ = 4096, DEPTH = 4, MEML = 256;
constexpr int MTOK = NB * SEQ;
constexpr int DIN = 6048;
constexpr int PAW = 3072;
constexpr float LN_EPS = 1e-5f;
constexpr float ALPHA = 1.6817928305074292f;
constexpr float LOG2E = 1.4426950408889634f;
constexpr float MLA_SCALE = 0.10206207261596577f * LOG2E;
constexpr float QMEM_SCALE = 0.08838834764831845f * LOG2E;
constexpr int SSM_L = 512, SSM_NC = SEQ / SSM_L;

constexpr size_t MiB = 1u << 20;
constexpr size_t WS_TAB = 1 * MiB;
constexpr size_t TAB_L = 288 * 1024;
constexpr size_t WS_ROPE = 3 * MiB;
constexpr size_t WS_SS = 7 * MiB;
constexpr size_t WS_SQP = 8 * MiB;
constexpr size_t WS_SKP = WS_SQP + 512 * 1024;
constexpr size_t WS_MEMB = 9 * MiB;
constexpr size_t WS_MEMKV = 13 * MiB;
constexpr size_t WS_WB = 21 * MiB;
constexpr size_t WB_WIN = 0, WB_WGLU = 12 * MiB, WB_WUQ = 13 * MiB, WB_WUKV = WB_WUQ + 512 * 1024, WB_WMEM = 14 * MiB, WB_WP = 18 * MiB, WB_WOUT = 21 * MiB;
constexpr size_t WS_XB = 45 * MiB;
constexpr size_t WS_PA = 109 * MiB;
constexpr size_t WS_R = 301 * MiB;
constexpr size_t R_Q = 0, R_KN = 48 * MiB, R_KR = 80 * MiB, R_V = 82 * MiB;
constexpr size_t WS_END = 493 * MiB;

constexpr int C_U = 0, C_ZS = 512, C_CQ = 1024, C_CKV = 1280, C_KR = 1408, C_ZM = 1536, C_QX = 2048, C_ZX = 2560;

__device__ __forceinline__ unsigned cvtpk(float lo, float hi) { f32x2 v = {lo, hi}; bf16x2_t b = __builtin_convertvector(v, bf16x2_t); return __builtin_bit_cast(unsigned, b); }
__device__ __forceinline__ bf16_t f2bf(float f) { return (bf16_t)(cvtpk(f, 0.f) & 0xffffu); }
__device__ __forceinline__ float bflo(unsigned w) { return __uint_as_float(w << 16); }
__device__ __forceinline__ float bfhi(unsigned w) { return __uint_as_float(w & 0xffff0000u); }
__device__ __forceinline__ float bf2f(bf16_t b) { return __uint_as_float((unsigned)b << 16); }
__device__ __forceinline__ float sigmoidf_(float x) { return __builtin_amdgcn_rcpf(1.0f + __expf(-x)); }
__device__ __forceinline__ float siluf_(float x) { return x * sigmoidf_(x); }
__device__ __forceinline__ float gelu_tanh(float x) { const float z = 0.7978845608028654f * (x + 0.044715f * x * x * x); return x * sigmoidf_(2.0f * z); }
__device__ __forceinline__ float wave_sum(float v) {
#pragma unroll
    for (int o = 1; o < 64; o <<= 1) v += __shfl_xor(v, o);
    return v;
}
#define LDS_WAIT() asm volatile("s_waitcnt lgkmcnt(0)" ::: "memory")
__device__ __forceinline__ int crow(int i, int h) { return (i & 3) + 8 * (i >> 2) + 4 * h; }
__device__ __forceinline__ void cossin_d(double a, double& c, double& s) {
    const double q = rint(a * 0.63661977236758134308);
    const double y = a - q * 1.57079632679489661923;
    const double y2 = y * y;
    const double sp = y * (1.0 + y2 * (-1.0 / 6 + y2 * (1.0 / 120 + y2 * (-1.0 / 5040 + y2 * (1.0 / 362880 + y2 * (-1.0 / 39916800 + y2 * (1.0 / 6227020800.0)))))));
    const double cp = 1.0 + y2 * (-0.5 + y2 * (1.0 / 24 + y2 * (-1.0 / 720 + y2 * (1.0 / 40320 + y2 * (-1.0 / 3628800 + y2 * (1.0 / 479001600.0))))));
    const int qi = ((int)((long long)q)) & 3;
    c = (qi == 0) ? cp : (qi == 1) ? -sp : (qi == 2) ? -cp : sp;
    s = (qi == 0) ? sp : (qi == 1) ? cp : (qi == 2) ? -sp : -cp;
}

namespace pg8 {
constexpr int BM = 256, BK = 64, HALF = 128, HTB = HALF * BK * 2, STAGE_BYTES = 8 * HTB, NXCD = 8, WGM = 8;
__host__ __device__ __forceinline__ int lds_byte(int r, int c) { const int st = (r >> 4) * 2 + (c >> 5), rr = r & 15, cc = c & 31, ob = rr * 64 + cc * 2; return st * 1024 + (ob ^ (((ob >> 9) & 1) << 5)); }
__host__ __device__ __forceinline__ void stage_rc(int b, int& R, int& C) { const int st = b / 1024, sb = b % 1024, swz = sb ^ (((sb >> 9) & 1) << 5); R = (st >> 1) * 16 + swz / 64; C = (st & 1) * 32 + (swz % 64) / 2; }
__host__ __device__ __forceinline__ int perm32(int rho) { const int n = rho >> 4, i = rho & 15; return 8 * (i >> 2) + 4 * n + (i & 3); }

struct Unit { int pm, pn, sub; const char* a; const char* b; };

struct StaticOrder {
    int nM, nN, nwg, G, c; const char* A; const char* B; size_t tA, tB;
    __device__ void init(int M, int N, int G_, int c_, const void* A_, int lda, const void* B_, int K) { nM = M / BM; nN = N / BM; nwg = nM * nN; G = G_; c = c_; A = (const char*)A_; B = (const char*)B_; tA = (size_t)BM * lda * 2; tB = (size_t)BM * K * 2; }
    __device__ bool next(int i, Unit& u) const {
        const long L = (long)i * G + c; if (L >= nwg) return false;
        int wgid = (int)L; { const int q = nwg / NXCD, r = nwg % NXCD, xcd = wgid % NXCD, off = wgid / NXCD; wgid = (xcd < r ? xcd * (q + 1) : r * (q + 1) + (xcd - r) * q) + off; }
        const int nig = WGM * nN, gid = wgid / nig, fm = gid * WGM, gsz = (nM - fm) < WGM ? (nM - fm) : WGM;
        u.pm = fm + ((wgid % nig) % gsz); u.pn = (wgid % nig) / gsz; u.sub = 0; u.a = A + (size_t)u.pm * tA; u.b = B + (size_t)u.pn * tB; return true;
    }
};

template <class Epi, class Sched>
__device__ __forceinline__ void gemm_phase(LAS unsigned char* lds, const int K_, const int lda_, const Sched& S, const Epi& E) {
    int K = K_, lda = lda_, tid = threadIdx.x;
    asm volatile("" : "+s"(K), "+s"(lda), "+v"(tid));
    const int wid = __builtin_amdgcn_readfirstlane(tid >> 6), lane = tid & 63, wr = wid >> 2, wc = wid & 3, fr = lane & 15, fq = lane >> 4;
    const int nt = K / BK;
    unsigned voffA[2], voffB[2];
#pragma unroll
    for (int i = 0; i < 2; ++i) { int R, C; stage_rc(tid * 16 + i * 8192, R, C); const int Rb = (R & ~31) + perm32(R & 31);
        voffA[i] = (unsigned)(R * lda + C) * 2u; voffB[i] = (unsigned)(Rb * K + C) * 2u; }
    const size_t kstep = (size_t)(BK * 2);
    const size_t hA = (size_t)HALF * lda * 2, hB = (size_t)HALF * K * 2;
    const unsigned ldsw = (unsigned)wid * 1024u;
    const int aoff = lds_byte(wr * 64 + fr, fq * 8), boff = lds_byte(wc * 32 + fr, fq * 8);
#define PG8_SA(b, h) (((b) * 2 + (h)) * HTB)
#define PG8_SB(b, h) ((4 + (b) * 2 + (h)) * HTB)
#define PG8_STAGE(bufoff, gbase, voff) do { _Pragma("unroll") for (int _i = 0; _i < 2; ++_i) \
        __builtin_amdgcn_global_load_lds((const unsigned*)((const char*)(gbase) + (voff)[_i]), (LAS unsigned*)(lds + (bufoff) + ldsw + _i * 8192), 16, 0, 0); } while (0)
#define PG8_LDA(dst, b, h) do { _Pragma("unroll") for (int m = 0; m < 4; ++m) _Pragma("unroll") for (int k = 0; k < 2; ++k) dst[m][k] = *(const LAS bf16x8*)(lds + PG8_SA(b, h) + aoff + m * 2048 + k * 1024); } while (0)
#define PG8_LDB(dst, b, h) do { _Pragma("unroll") for (int n = 0; n < 2; ++n) _Pragma("unroll") for (int k = 0; k < 2; ++k) dst[n][k] = *(const LAS bf16x8*)(lds + PG8_SB(b, h) + boff + n * 2048 + k * 1024); } while (0)
#define PG8_MMA(ai, bj, At, Bt) do { __builtin_amdgcn_s_setprio(1); _Pragma("unroll") for (int m = 0; m < 4; ++m) _Pragma("unroll") for (int n = 0; n < 2; ++n) _Pragma("unroll") for (int k = 0; k < 2; ++k) \
        acc[ai][bj][m][n] = __builtin_amdgcn_mfma_f32_16x16x32_bf16(Bt[n][k], At[m][k], acc[ai][bj][m][n], 0, 0, 0); __builtin_amdgcn_s_setprio(0); } while (0)
#define PG8_WAIT_V(n) asm volatile("s_waitcnt vmcnt(" #n ")" ::: "memory")
#define PG8_WAIT_L(n) asm volatile("s_waitcnt lgkmcnt(" #n ")" ::: "memory")
#define PG8_BAR __builtin_amdgcn_s_barrier()
#define PG8_SCHED __builtin_amdgcn_sched_barrier(0)
    Unit cur, nxt; int ui = 0;
    if (!S.next(0, cur)) return;
    f32x4 acc[2][2][4][2];
#pragma unroll
    for (int a = 0; a < 2; ++a)
#pragma unroll
        for (int b = 0; b < 2; ++b)
#pragma unroll
            for (int m = 0; m < 4; ++m)
#pragma unroll
                for (int n = 0; n < 2; ++n) acc[a][b][m][n] = (f32x4){0.f, 0.f, 0.f, 0.f};
    bf16x8 At[4][2], B0[2][2], B1[2][2];
    const char* cA = cur.a; const char* cB = cur.b;
    PG8_STAGE(PG8_SB(0, 0), cB, voffB); PG8_STAGE(PG8_SB(0, 1), cB + hB, voffB); PG8_STAGE(PG8_SA(0, 0), cA, voffA); PG8_STAGE(PG8_SA(0, 1), cA + hA, voffA);
    if (wr == 1) PG8_BAR;
    PG8_WAIT_V(2); PG8_BAR;
    PG8_STAGE(PG8_SB(1, 0), cB + kstep, voffB); PG8_STAGE(PG8_SA(1, 0), cA + kstep, voffA); PG8_STAGE(PG8_SB(1, 1), cB + hB + kstep, voffB);
    PG8_WAIT_V(6); PG8_BAR;
    for (;;) {
        const bool has_next = S.next(ui + 1, nxt);
        const char* nA = has_next ? nxt.a : cA; const char* nB = has_next ? nxt.b : cB;
        for (int t = 0; t < nt; t += 2) {
            const bool last = (t == nt - 2);
            const char* a1 = cA + (size_t)(t + 1) * kstep;
            const char* a2 = last ? nA : cA + (size_t)(t + 2) * kstep; const char* b2 = last ? nB : cB + (size_t)(t + 2) * kstep;
            const char* a3 = a2 + kstep; const char* b3 = b2 + kstep;
            PG8_LDB(B0, 0, 0); PG8_LDB(B1, 0, 1); PG8_SCHED; PG8_LDA(At, 0, 0); PG8_STAGE(PG8_SA(1, 1), a1 + hA, voffA);
            PG8_WAIT_V(8); PG8_WAIT_L(0); PG8_BAR; PG8_MMA(0, 0, At, B0); PG8_MMA(0, 1, At, B1); PG8_BAR; PG8_SCHED;
            PG8_LDA(At, 0, 1); PG8_STAGE(PG8_SB(0, 0), b2, voffB); PG8_STAGE(PG8_SB(0, 1), b2 + hB, voffB); PG8_STAGE(PG8_SA(0, 0), a2, voffA);
            PG8_WAIT_V(8); PG8_WAIT_L(0); PG8_BAR; PG8_MMA(1, 0, At, B0); PG8_MMA(1, 1, At, B1); PG8_BAR; PG8_SCHED;
            PG8_LDB(B0, 1, 0); PG8_LDB(B1, 1, 1); PG8_SCHED; PG8_LDA(At, 1, 0); PG8_STAGE(PG8_SA(0, 1), a2 + hA, voffA);
            PG8_WAIT_V(8); PG8_WAIT_L(0); PG8_BAR; PG8_MMA(0, 0, At, B0); PG8_MMA(0, 1, At, B1); PG8_BAR; PG8_SCHED;
            PG8_LDA(At, 1, 1); PG8_STAGE(PG8_SB(1, 0), b3, voffB); PG8_STAGE(PG8_SB(1, 1), b3 + hB, voffB); PG8_STAGE(PG8_SA(1, 0), a3, voffA);
            PG8_WAIT_V(8); PG8_WAIT_L(0); PG8_BAR; PG8_MMA(1, 0, At, B0); PG8_MMA(1, 1, At, B1); PG8_BAR; PG8_SCHED;
        }
        if (wr == 0) PG8_BAR;
        E(acc, cur, wr, wc, fr, fq);
        if (!has_next) break;
        if (!E.keep(cur)) {
#pragma unroll
        for (int a = 0; a < 2; ++a)
#pragma unroll
            for (int b = 0; b < 2; ++b)
#pragma unroll
                for (int m = 0; m < 4; ++m)
#pragma unroll
                    for (int n = 0; n < 2; ++n) acc[a][b][m][n] = (f32x4){0.f, 0.f, 0.f, 0.f};
        }
        cur = nxt; cA = nA; cB = nB; ++ui;
        if (wr == 1) PG8_BAR;
    }
    PG8_WAIT_V(0);
    PG8_BAR;
#undef PG8_SA
#undef PG8_SB
#undef PG8_STAGE
#undef PG8_LDA
#undef PG8_LDB
#undef PG8_MMA
#undef PG8_WAIT_V
#undef PG8_WAIT_L
#undef PG8_BAR
#undef PG8_SCHED
}
typedef f32x4 Acc[2][2][4][2];
#define EPI_ROW(u, ai, m) ((u).pm * 256 + (ai) * 128 + wr * 64 + (m) * 16 + fr)
#define EPI_COL(u, bj) ((u).pn * 256 + (bj) * 128 + wc * 32 + 8 * fq)

struct EpiIn {
    bf16_t* PA; float* SQP; float* SKP; bf16_t* KR; const float* ROPE;
    __device__ __forceinline__ bool keep(const Unit&) const { return false; }
    __device__ __forceinline__ void operator()(Acc& acc, const Unit& u, int wr, int wc, int fr, int fq) const {
        const int pn = u.pn; const bool act = (pn == 2 || pn == 3 || pn == 6 || pn == 7 || pn == 10 || pn == 11);
#pragma unroll
        for (int ai = 0; ai < 2; ++ai)
#pragma unroll
            for (int m = 0; m < 4; ++m) { const int row = EPI_ROW(u, ai, m); bf16_t* rowp = PA + (size_t)row * PAW + EPI_COL(u, 0);
#pragma unroll
                for (int bj = 0; bj < 2; ++bj) { f32x4 v0 = acc[ai][bj][m][0], v1 = acc[ai][bj][m][1];
                    if (act) {
#pragma unroll
                        for (int e = 0; e < 4; ++e) { v0[e] = siluf_(v0[e]); v1[e] = siluf_(v1[e]); } }
                    u32x4 w; w.x = cvtpk(v0[0], v0[1]); w.y = cvtpk(v0[2], v0[3]); w.z = cvtpk(v1[0], v1[1]); w.w = cvtpk(v1[2], v1[3]);
                    *(u32x4*)(rowp + bj * 128) = w; }
                if (pn == 4 || pn == 5) {
                    float s = 0.f;
#pragma unroll
                    for (int bj = 0; bj < 2; ++bj) if (pn == 4 || bj == 0) {
#pragma unroll
                        for (int n = 0; n < 2; ++n) { const f32x4 x = acc[ai][bj][m][n]; s += (x[0] * x[0] + x[1] * x[1]) + (x[2] * x[2] + x[3] * x[3]); } }
                    s += __shfl_xor(s, 16); s += __shfl_xor(s, 32);
                    if (fq == 0) (pn == 4 ? SQP : SKP)[(size_t)row * 4 + wc] = s;
                    if (pn == 5 && wc == 0) {
                        f32x4 o[2];
#pragma unroll
                        for (int n = 0; n < 2; ++n) { const f32x4 v = acc[ai][1][m][n]; const f32x4 cs = *(const f32x4*)(ROPE + (size_t)row * 32 + 2 * (4 * fq + 2 * n));
                            o[n][0] = v[0] * cs[0] - v[1] * cs[1]; o[n][1] = v[0] * cs[1] + v[1] * cs[0]; o[n][2] = v[2] * cs[2] - v[3] * cs[3]; o[n][3] = v[2] * cs[3] + v[3] * cs[2]; }
                        u32x4 w; w.x = cvtpk(o[0][0], o[0][1]); w.y = cvtpk(o[0][2], o[0][3]); w.z = cvtpk(o[1][0], o[1][1]); w.w = cvtpk(o[1][2], o[1][3]);
                        *(u32x4*)(KR + (size_t)row * 32 + 8 * fq) = w;
                    }
                }
                asm volatile("" ::: "memory");
            }
    }
};
struct EpiPlain {
    bf16_t* O; int ldc;
    __device__ __forceinline__ bool keep(const Unit&) const { return false; }
    __device__ __forceinline__ void operator()(Acc& acc, const Unit& u, int wr, int wc, int fr, int fq) const {
#pragma unroll
        for (int ai = 0; ai < 2; ++ai)
#pragma unroll
            for (int m = 0; m < 4; ++m) { bf16_t* rowp = O + (size_t)EPI_ROW(u, ai, m) * ldc + EPI_COL(u, 0);
#pragma unroll
                for (int bj = 0; bj < 2; ++bj) { const f32x4 v0 = acc[ai][bj][m][0], v1 = acc[ai][bj][m][1];
                    u32x4 w; w.x = cvtpk(v0[0], v0[1]); w.y = cvtpk(v0[2], v0[3]); w.z = cvtpk(v1[0], v1[1]); w.w = cvtpk(v1[2], v1[3]);
                    *(u32x4*)(rowp + bj * 128) = w; } }
    }
};
struct EpiGate {
    bf16_t* G; const float* bias;
    __device__ __forceinline__ bool keep(const Unit&) const { return false; }
    __device__ __forceinline__ void operator()(Acc& acc, const Unit& u, int wr, int wc, int fr, int fq) const {
        f32x4 bv[2][2];
#pragma unroll
        for (int bj = 0; bj < 2; ++bj)
#pragma unroll
            for (int n = 0; n < 2; ++n) bv[bj][n] = *(const f32x4*)(bias + EPI_COL(u, bj) + 4 * n);
#pragma unroll
        for (int ai = 0; ai < 2; ++ai)
#pragma unroll
            for (int m = 0; m < 4; ++m) { bf16_t* rowp = G + (size_t)EPI_ROW(u, ai, m) * PAW + EPI_COL(u, 0);
#pragma unroll
                for (int bj = 0; bj < 2; ++bj) { f32x4 v0 = acc[ai][bj][m][0] + bv[bj][0], v1 = acc[ai][bj][m][1] + bv[bj][1];
#pragma unroll
                    for (int e = 0; e < 4; ++e) { v0[e] = sigmoidf_(v0[e]); v1[e] = sigmoidf_(v1[e]); }
                    u32x4 w; w.x = cvtpk(v0[0], v0[1]); w.y = cvtpk(v0[2], v0[3]); w.z = cvtpk(v1[0], v1[1]); w.w = cvtpk(v1[2], v1[3]);
                    *(u32x4*)(rowp + bj * 128) = w; }
                asm volatile("" ::: "memory"); }
    }
};
struct EpiQ {
    bf16_t* Q; const float* SQP; const float* ROPE;
    __device__ __forceinline__ bool keep(const Unit&) const { return false; }
    __device__ __forceinline__ void operator()(Acc& acc, const Unit& u, int wr, int wc, int fr, int fq) const {
#pragma unroll
        for (int ai = 0; ai < 2; ++ai)
#pragma unroll
            for (int m = 0; m < 4; ++m) { const int row = EPI_ROW(u, ai, m); const f32x4 sq = *(const f32x4*)(SQP + (size_t)row * 4);
                const float sr = 1.0f / sqrtf(((sq[0] + sq[1]) + (sq[2] + sq[3])) * (1.0f / 256.0f) + LN_EPS);
#pragma unroll
                for (int bj = 0; bj < 2; ++bj) { const int col = EPI_COL(u, bj); f32x4 v[2];
#pragma unroll
                    for (int n = 0; n < 2; ++n) { v[n] = acc[ai][bj][m][n] * sr; const int d = (col + 4 * n) % 96;
                        if (d >= 64) { const f32x4 cs = *(const f32x4*)(ROPE + (size_t)row * 32 + (d - 64)); const f32x4 t = v[n];
                            v[n][0] = t[0] * cs[0] - t[1] * cs[1]; v[n][1] = t[0] * cs[1] + t[1] * cs[0]; v[n][2] = t[2] * cs[2] - t[3] * cs[3]; v[n][3] = t[2] * cs[3] + t[3] * cs[2]; } }
                    u32x4 w; w.x = cvtpk(v[0][0], v[0][1]); w.y = cvtpk(v[0][2], v[0][3]); w.z = cvtpk(v[1][0], v[1][1]); w.w = cvtpk(v[1][2], v[1][3]);
                    *(u32x4*)(Q + (size_t)row * 768 + col) = w; }
                asm volatile("" ::: "memory"); }
    }
};
struct EpiKV {
    bf16_t* KN; bf16_t* V; const float* SKP;
    __device__ __forceinline__ bool keep(const Unit&) const { return false; }
    __device__ __forceinline__ void operator()(Acc& acc, const Unit& u, int wr, int wc, int fr, int fq) const {
#pragma unroll
        for (int ai = 0; ai < 2; ++ai)
#pragma unroll
            for (int m = 0; m < 4; ++m) { const int row = EPI_ROW(u, ai, m); const f32x4 sq = *(const f32x4*)(SKP + (size_t)row * 4);
                const float sr = 1.0f / sqrtf(((sq[0] + sq[1]) + (sq[2] + sq[3])) * (1.0f / 128.0f) + LN_EPS);
#pragma unroll
                for (int bj = 0; bj < 2; ++bj) { const int head = 2 * u.pn + bj, local = wc * 32 + 8 * fq; const f32x4 v0 = acc[ai][bj][m][0] * sr, v1 = acc[ai][bj][m][1] * sr;
                    u32x4 w; w.x = cvtpk(v0[0], v0[1]); w.y = cvtpk(v0[2], v0[3]); w.z = cvtpk(v1[0], v1[1]); w.w = cvtpk(v1[2], v1[3]);
                    bf16_t* dst = (wc < 2) ? KN + (size_t)row * 512 + head * 64 + local : V + (size_t)row * 512 + head * 64 + (local - 64);
                    *(u32x4*)dst = w; }
                asm volatile("" ::: "memory"); }
    }
};
struct EpiGlu {
    bf16_t* PA; const float* bglu;
    __device__ __forceinline__ bool keep(const Unit&) const { return false; }
    __device__ __forceinline__ void operator()(Acc& acc, const Unit& u, int wr, int wc, int fr, int fq) const {
        const int j0 = 128 * u.pn + wc * 32 + 8 * fq;
        f32x4 ba[2], bb[2];
#pragma unroll
        for (int n = 0; n < 2; ++n) { ba[n] = *(const f32x4*)(bglu + j0 + 4 * n); bb[n] = *(const f32x4*)(bglu + 512 + j0 + 4 * n); }
#pragma unroll
        for (int ai = 0; ai < 2; ++ai)
#pragma unroll
            for (int m = 0; m < 4; ++m) { bf16_t* p = PA + (size_t)EPI_ROW(u, ai, m) * PAW + C_ZS + j0; const u32x4 z = *(const u32x4*)p; float y[8];
#pragma unroll
                for (int n = 0; n < 2; ++n) { const f32x4 a = acc[ai][0][m][n] + ba[n], b = acc[ai][1][m][n] + bb[n];
#pragma unroll
                    for (int e = 0; e < 4; ++e) y[4 * n + e] = a[e] * sigmoidf_(b[e]); }
                u32x4 w; w.x = cvtpk(y[0] * bflo(z.x), y[1] * bfhi(z.x)); w.y = cvtpk(y[2] * bflo(z.y), y[3] * bfhi(z.y)); w.z = cvtpk(y[4] * bflo(z.z), y[5] * bfhi(z.z)); w.w = cvtpk(y[6] * bflo(z.w), y[7] * bfhi(z.w));
                *(u32x4*)p = w; asm volatile("" ::: "memory"); }
    }
};
struct EpiMerge {
    bf16_t* G; bf16_t* O; int ldo;
    __device__ __forceinline__ bool keep(const Unit& u) const { return u.sub < 2; }
    __device__ __forceinline__ void operator()(Acc& acc, const Unit& u, int wr, int wc, int fr, int fq) const {
        const int sub = u.sub;
#pragma unroll
        for (int ai = 0; ai < 2; ++ai)
#pragma unroll
            for (int m = 0; m < 4; ++m) { bf16_t* rowp = G + (size_t)EPI_ROW(u, ai, m) * PAW + EPI_COL(u, 0);
#pragma unroll
                for (int bj = 0; bj < 2; ++bj) { const u32x4 ga = *(const u32x4*)(rowp + bj * 128 + sub * 1024);
                    float f[8] = {bflo(ga.x), bfhi(ga.x), bflo(ga.y), bfhi(ga.y), bflo(ga.z), bfhi(ga.z), bflo(ga.w), bfhi(ga.w)};
                    if (sub < 2) { const u32x4 gb = *(const u32x4*)(rowp + bj * 128 + (sub + 1) * 1024);
                        const float d[8] = {bflo(gb.x), bfhi(gb.x), bflo(gb.y), bfhi(gb.y), bflo(gb.z), bfhi(gb.z), bflo(gb.w), bfhi(gb.w)};
#pragma unroll
                        for (int e = 0; e < 8; ++e) f[e] = f[e] / fmaxf(d[e], 1e-30f); }
                    f32x4 v0 = acc[ai][bj][m][0], v1 = acc[ai][bj][m][1];
#pragma unroll
                    for (int e = 0; e < 4; ++e) { v0[e] *= f[e]; v1[e] *= f[4 + e]; }
                    acc[ai][bj][m][0] = v0; acc[ai][bj][m][1] = v1;
                    if (sub == 2) { u32x4 w; w.x = cvtpk(v0[0], v0[1]); w.y = cvtpk(v0[2], v0[3]); w.z = cvtpk(v1[0], v1[1]); w.w = cvtpk(v1[2], v1[3]); *(u32x4*)(O + (size_t)EPI_ROW(u, ai, m) * ldo + EPI_COL(u, bj)) = w; } } }
    }
};
struct MergeOrder {
    int G, c; const char* PA; const char* WP;
    __device__ bool next(int i, Unit& u) const {
        const int tile = (i / 3) * G + c; if (tile >= 512) return false;
        u.sub = i % 3; u.pm = tile >> 2; u.pn = tile & 3;
        const int colA = (u.sub == 0) ? C_ZS : (u.sub == 1) ? C_ZM : C_ZX;
        u.a = PA + ((size_t)u.pm * 256 * PAW + colA) * 2; u.b = WP + (size_t)u.sub * (1024 * 512 * 2) + (size_t)u.pn * (256 * 512 * 2); return true;
    }
};
struct EpiOut {
    const float* xres; float* out;
    __device__ __forceinline__ bool keep(const Unit&) const { return false; }
    __device__ __forceinline__ void operator()(Acc& acc, const Unit& u, int wr, int wc, int fr, int fq) const {
#pragma unroll
        for (int ai = 0; ai < 2; ++ai)
#pragma unroll
            for (int m = 0; m < 4; ++m) { const size_t off = (size_t)EPI_ROW(u, ai, m) * DM + EPI_COL(u, 0);
#pragma unroll
                for (int bj = 0; bj < 2; ++bj)
#pragma unroll
                    for (int n = 0; n < 2; ++n) { const f32x4 x = *(const f32x4*)(xres + off + bj * 128 + 4 * n); *(f32x4*)(out + off + bj * 128 + 4 * n) = x * ALPHA + acc[ai][bj][m][n]; } }
    }
};
}

#define MFMA32(a, b, c) __builtin_amdgcn_mfma_f32_32x32x16_bf16((a), (b), (c), 0, 0, 0)
template <int DQK, int DK1, int DV, bool CAUSAL>
__device__ __forceinline__ void attn_unit(LAS unsigned char* lds, const bf16_t* Q, int ldq, const bf16_t* K1, int ldk1, const bf16_t* K2, int ldk2,
                                          const bf16_t* V, int ldv, bf16_t* ZO, int ldo, int q0, int nt) {
    constexpr int KROW = (DQK + 8) * 2, VROW = 136, KBUF = 64 * KROW, VBUF = DV * VROW, BUF = KBUF + VBUF;
    constexpr int KCH = DQK / 8, VCH = DV / 8, NKL = (64 * KCH + 511) / 512, NVL = (64 * VCH) / 512, NS = DQK / 16, NDB = DV / 32;
    int tid = threadIdx.x; asm volatile("" : "+v"(tid));
    const int lane = tid & 63, r = lane & 31, h = lane >> 5, w = __builtin_amdgcn_readfirstlane(tid >> 6);
    bf16x8 qf[NS];
    { const bf16_t* qrow = Q + (size_t)(q0 + 32 * w + r) * ldq + 8 * h;
#pragma unroll
      for (int s = 0; s < NS; ++s) qf[s] = *(const bf16x8*)(qrow + 16 * s); }
    f32x16 o[NDB];
#pragma unroll
    for (int db = 0; db < NDB; ++db)
#pragma unroll
        for (int i = 0; i < 16; ++i) o[db][i] = 0.f;
    float mref = 0.f, lrun = 0.f;
    f32x16 negm;
#pragma unroll
    for (int i = 0; i < 16; ++i) negm[i] = 0.f;
    u32x4 kreg[NKL], vreg[NVL];
#define ATT_LOAD(t) do { \
    _Pragma("unroll") for (int i_ = 0; i_ < NKL; ++i_) { const int c_ = tid + 512 * i_; if (c_ < 64 * KCH) { const int row_ = c_ / KCH, col_ = 8 * (c_ % KCH); const size_t kv_ = (size_t)(64 * (t) + row_); \
        const bf16_t* src_ = (col_ < DK1) ? K1 + kv_ * ldk1 + col_ : K2 + kv_ * ldk2 + (col_ - DK1); kreg[i_] = *(const u32x4*)src_; } } \
    _Pragma("unroll") for (int i_ = 0; i_ < NVL; ++i_) { const int c_ = tid + 512 * i_; const int row_ = c_ / VCH, ch_ = c_ % VCH; vreg[i_] = *(const u32x4*)(V + (size_t)(64 * (t) + row_) * ldv + 8 * ch_); } } while (0)
#define ATT_STORE(buf) do { LAS unsigned char* kb_ = lds + (buf) * BUF; LAS unsigned char* vb_ = kb_ + KBUF; \
    _Pragma("unroll") for (int i_ = 0; i_ < NKL; ++i_) { const int c_ = tid + 512 * i_; if (c_ < 64 * KCH) { const int row_ = c_ / KCH, col_ = 8 * (c_ % KCH); *(LAS u32x4*)(kb_ + row_ * KROW + col_ * 2) = kreg[i_]; } } \
    _Pragma("unroll") for (int i_ = 0; i_ < NVL; ++i_) { const int c_ = tid + 512 * i_; const int row_ = c_ / VCH, ch_ = c_ % VCH; const u32x4 v_ = vreg[i_]; LAS unsigned char* p_ = vb_ + (8 * ch_) * VROW + row_ * 2; \
        *(LAS bf16_t*)(p_) = (bf16_t)(v_.x & 0xffff); *(LAS bf16_t*)(p_ + VROW) = (bf16_t)(v_.x >> 16); *(LAS bf16_t*)(p_ + 2 * VROW) = (bf16_t)(v_.y & 0xffff); *(LAS bf16_t*)(p_ + 3 * VROW) = (bf16_t)(v_.y >> 16); \
        *(LAS bf16_t*)(p_ + 4 * VROW) = (bf16_t)(v_.z & 0xffff); *(LAS bf16_t*)(p_ + 5 * VROW) = (bf16_t)(v_.z >> 16); *(LAS bf16_t*)(p_ + 6 * VROW) = (bf16_t)(v_.w & 0xffff); *(LAS bf16_t*)(p_ + 7 * VROW) = (bf16_t)(v_.w >> 16); } } while (0)
    ATT_LOAD(0); ATT_STORE(0); __syncthreads();
    const int qg = q0 + 32 * w + r;
    bool first = true;
    for (int t = 0; t < nt; ++t) {
        const int buf = t & 1;
        if (t + 1 < nt) ATT_LOAD(t + 1);
        const bool active = !CAUSAL || (64 * t <= q0 + 32 * w + 31);
        if (active) {
            LAS unsigned char* kb = lds + buf * BUF; LAS unsigned char* vb = kb + KBUF;
            f32x16 s0 = negm, s1 = negm;
#pragma unroll
            for (int s = 0; s < NS; ++s) { const bf16x8 k0 = *(const LAS bf16x8*)(kb + r * KROW + (16 * s + 8 * h) * 2); const bf16x8 k1 = *(const LAS bf16x8*)(kb + (32 + r) * KROW + (16 * s + 8 * h) * 2);
                s0 = MFMA32(k0, qf[s], s0); s1 = MFMA32(k1, qf[s], s1); }
            if (CAUSAL && (64 * t + 63 > q0 + 32 * w)) {
#pragma unroll
                for (int i = 0; i < 16; ++i) { const int kv = 64 * t + crow(i, h); if (kv > qg) s0[i] = -1e30f; if (kv + 32 > qg) s1[i] = -1e30f; } }
            float mx = fmaxf(fmaxf(s0[0], s1[0]), s0[1]);
#pragma unroll
            for (int i = 2; i < 16; i += 2) mx = fmaxf(fmaxf(mx, s0[i]), s0[i + 1]);
#pragma unroll
            for (int i = 1; i < 16; i += 2) mx = fmaxf(fmaxf(mx, s1[i]), s1[(i + 1) & 15]);
            mx = fmaxf(mx, __shfl_xor(mx, 32));
            if (first || __any(mx > 8.0f)) {
                const float dl = first ? mx : fmaxf(mx, 0.f); first = false; mref += dl;
                const float alpha = __builtin_amdgcn_exp2f(-dl); lrun *= alpha;
#pragma unroll
                for (int i = 0; i < 16; ++i) { s0[i] -= dl; s1[i] -= dl; negm[i] = -mref; }
#pragma unroll
                for (int db = 0; db < NDB; ++db)
#pragma unroll
                    for (int i = 0; i < 16; ++i) o[db][i] *= alpha;
            }
            float ps = 0.f;
#pragma unroll
            for (int i = 0; i < 16; ++i) { s0[i] = __builtin_amdgcn_exp2f(s0[i]); s1[i] = __builtin_amdgcn_exp2f(s1[i]); ps += s0[i] + s1[i]; }
            lrun += ps;
            bf16x8 pf[4];
#pragma unroll
            for (int s = 0; s < 2; ++s) { u32x4 a, b;
                a.x = cvtpk(s0[8 * s], s0[8 * s + 1]); a.y = cvtpk(s0[8 * s + 2], s0[8 * s + 3]); a.z = cvtpk(s0[8 * s + 4], s0[8 * s + 5]); a.w = cvtpk(s0[8 * s + 6], s0[8 * s + 7]);
                b.x = cvtpk(s1[8 * s], s1[8 * s + 1]); b.y = cvtpk(s1[8 * s + 2], s1[8 * s + 3]); b.z = cvtpk(s1[8 * s + 4], s1[8 * s + 5]); b.w = cvtpk(s1[8 * s + 6], s1[8 * s + 7]);
                pf[s] = __builtin_bit_cast(bf16x8, a); pf[2 + s] = __builtin_bit_cast(bf16x8, b); }
#pragma unroll
            for (int db = 0; db < NDB; ++db)
#pragma unroll
                for (int ks = 0; ks < 4; ++ks) {
                    const LAS unsigned char* vp = vb + (32 * db + r) * VROW + (16 * ks + 4 * h) * 2;
                    const u32x2 lo = *(const LAS u32x2*)vp, hi = *(const LAS u32x2*)(vp + 16);
                    u32x4 vv; vv.x = lo.x; vv.y = lo.y; vv.z = hi.x; vv.w = hi.y;
                    o[db] = MFMA32(__builtin_bit_cast(bf16x8, vv), pf[ks], o[db]); }
        }
        if (t + 1 < nt) ATT_STORE(buf ^ 1);
        __syncthreads();
    }
#undef ATT_LOAD
#undef ATT_STORE
    const float lt = lrun + __shfl_xor(lrun, 32), inv = 1.0f / lt;
#pragma unroll
    for (int db = 0; db < NDB; ++db)
#pragma unroll
        for (int g4 = 0; g4 < 4; ++g4) { bf16_t* zp = ZO + (size_t)qg * ldo + 32 * db + 8 * g4 + 4 * h; const u32x2 z = *(const u32x2*)zp;
            u32x2 wv; wv.x = cvtpk(o[db][4 * g4] * inv * bflo(z.x), o[db][4 * g4 + 1] * inv * bfhi(z.x)); wv.y = cvtpk(o[db][4 * g4 + 2] * inv * bflo(z.y), o[db][4 * g4 + 3] * inv * bfhi(z.y));
            *(u32x2*)zp = wv; }
}

template <bool OUT>
__device__ __forceinline__ void ssm_task(LAS unsigned char* wl, int task, bf16_t* PA, const unsigned char* tab, const float* dskip, f32x2* SS) {
    int lane = threadIdx.x & 63; asm volatile("" : "+v"(lane));
    const int r = lane & 31, h = lane >> 5, row16 = lane & 15, quad = lane >> 4;
    const int chunk = task & 7, g = (task >> 3) & 31, b = task >> 8;
    const bf16_t* BBt = (const bf16_t*)tab; const bf16_t* CMt = (const bf16_t*)(tab + 128 * 1024);
    const f32x2* LAM = (const f32x2*)(tab + 256 * 1024); const f32x2* LAML = (const f32x2*)(tab + 272 * 1024);
    bf16x8 bbf[4], cmf[4];
#pragma unroll
    for (int nb = 0; nb < 4; ++nb) bbf[nb] = *(const bf16x8*)(BBt + ((size_t)(g * 128 + 32 * nb + r)) * 16 + 8 * h);
    if (OUT) {
#pragma unroll
        for (int ks = 0; ks < 4; ++ks) cmf[ks] = *(const bf16x8*)(CMt + ((size_t)(g * 16 + row16)) * 128 + 32 * ks + 8 * quad);
    }
    const f32x2 lam = LAM[g * 64 + lane];
    const float dsk = OUT ? dskip[16 * g + row16] : 0.f;
    float hr = 0.f, hi = 0.f;
    f32x2* ssb = SS + ((size_t)(b * 32 + g) * SSM_NC) * 64 + lane;
    if (OUT) { const f32x2 lL = LAML[g * 64 + lane];
        for (int k = 0; k < chunk; ++k) { const f32x2 s = ssb[(size_t)k * 64]; const float nr = lL.x * hr - lL.y * hi + s.x, ni = lL.x * hi + lL.y * hr + s.y; hr = nr; hi = ni; } }
    LAS float* W = (LAS float*)wl;
    const size_t tokc = (size_t)b * SEQ + chunk * SSM_L;
    bf16x8 uf = *(const bf16x8*)(PA + (tokc + r) * PAW + C_U + 16 * g + 8 * h);
    for (int sub = 0; sub < SSM_L / 32; ++sub) {
        const size_t tok0 = tokc + sub * 32;
        bf16x8 ufn = uf;
        if (sub + 1 < SSM_L / 32) ufn = *(const bf16x8*)(PA + (tok0 + 32 + r) * PAW + C_U + 16 * g + 8 * h);
        bf16_t uv[2][4];
        if (OUT) {
#pragma unroll
            for (int mb = 0; mb < 2; ++mb)
#pragma unroll
                for (int j = 0; j < 4; ++j) uv[mb][j] = PA[(tok0 + 16 * mb + 4 * quad + j) * PAW + C_U + 16 * g + row16];
        }
#pragma unroll
        for (int nb = 0; nb < 4; ++nb) { f32x16 z;
#pragma unroll
            for (int i = 0; i < 16; ++i) z[i] = 0.f;
            const f32x16 bu = MFMA32(uf, bbf[nb], z);
#pragma unroll
            for (int i = 0; i < 16; ++i) W[crow(i, h) * 132 + 32 * nb + r] = bu[i]; }
        LDS_WAIT();
        f32x2 bq[32];
#pragma unroll
        for (int t = 0; t < 32; ++t) bq[t] = *(const LAS f32x2*)(W + t * 132 + 2 * lane);
        LDS_WAIT();
#pragma unroll
        for (int t = 0; t < 32; ++t) { const float nr = lam.x * hr - lam.y * hi + bq[t].x, ni = lam.x * hi + lam.y * hr + bq[t].y; hr = nr; hi = ni;
            if (OUT) *(LAS unsigned*)((LAS unsigned char*)W + t * 528 + 4 * lane) = cvtpk(hr, hi); }
        if (OUT) {
            LDS_WAIT();
#pragma unroll
            for (int mb = 0; mb < 2; ++mb) { f32x4 acc = (f32x4){0.f, 0.f, 0.f, 0.f};
#pragma unroll
                for (int ks = 0; ks < 4; ++ks) { const bf16x8 af = *(const LAS bf16x8*)((LAS unsigned char*)W + (16 * mb + row16) * 528 + (32 * ks + 8 * quad) * 2);
                    acc = __builtin_amdgcn_mfma_f32_16x16x32_bf16(af, cmf[ks], acc, 0, 0, 0); }
#pragma unroll
                for (int j = 0; j < 4; ++j) { bf16_t* p = PA + (tok0 + 16 * mb + 4 * quad + j) * PAW + C_U + 16 * g + row16; const float y = acc[j] + dsk * bf2f(uv[mb][j]); *p = f2bf(gelu_tanh(y)); } }
            LDS_WAIT();
        }
        uf = ufn;
    }
    if (!OUT) ssb[(size_t)chunk * 64] = (f32x2){hr, hi};
}

enum { MAT_PLAIN = 0, MAT_WIN = 1, MAT_WGLU = 2, MAT_WUQ = 3 };
__device__ __forceinline__ void cvt_item(const float* W, int ldw, int K, bf16_t* WT, int mat, int item, int nblk, LAS float* scr, int lane, const float* kscale) {
    const int kb = item / nblk, nb = item % nblk, k0 = 64 * kb, n0 = 32 * nb, n = n0 + (lane & 31);
    int src = n; float sc = 1.f;
    if (mat == MAT_WIN) {
        if (n < 1408) src = n; else if (n < 1440) { const int j = n - 1408; src = 1408 + ((j & 1) ? 16 + (j >> 1) : (j >> 1)); } else if (n < 1536) src = -1; else src = n - 96;
        if (n >= C_QX && n < C_ZX) sc = QMEM_SCALE;
    } else if (mat == MAT_WGLU) { const int pn = n >> 8, bj = (n >> 7) & 1, i = n & 127; src = bj * 512 + 128 * pn + i; }
    else if (mat == MAT_WUQ) { const int hd = n / 96; int d = n % 96; if (d >= 64) { const int j = d - 64; d = 64 + ((j & 1) ? 16 + (j >> 1) : (j >> 1)); } src = 96 * hd + d; sc = MLA_SCALE; }
#pragma unroll 8
    for (int i = 0; i < 32; ++i) { const int kk = 2 * i + (lane >> 5); float v = (src >= 0) ? W[(size_t)(k0 + kk) * ldw + src] : 0.f; v *= sc; if (kscale) v *= kscale[k0 + kk]; scr[kk * 33 + (lane & 31)] = v; }
    LDS_WAIT();
    const int c = lane & 7;
#pragma unroll
    for (int j = 0; j < 4; ++j) { const int nn = (lane >> 3) + 8 * j; const LAS float* s = scr + (8 * c) * 33 + nn;
        u32x4 o; o.x = cvtpk(s[0 * 33], s[1 * 33]); o.y = cvtpk(s[2 * 33], s[3 * 33]); o.z = cvtpk(s[4 * 33], s[5 * 33]); o.w = cvtpk(s[6 * 33], s[7 * 33]);
        *(u32x4*)(WT + (size_t)(n0 + nn) * K + k0 + 8 * c) = o; }
    LDS_WAIT();
}

struct Args { const void* in[26]; float* out; unsigned char* ws; int ph_lo, ph_hi; };

__device__ __forceinline__ void convert_layer(const Args& a, int l, LAS float* scr, int gw, int NGW, int lane) {
    unsigned char* wb = a.ws + WS_WB;
    constexpr int I_WIN = 16 * 192, I_GLU = 8 * 32, I_UQ = 4 * 24, I_UKV = 2 * 32, I_MEM = 16 * 32, I_P = 8 * 32, I_OUT = 16 * 32;
    constexpr int NIT = I_WIN + I_GLU + I_UQ + I_UKV + I_MEM + 3 * I_P + I_OUT;
    for (int it = gw; it < NIT; it += NGW) {
        int r = it;
        if (r < I_WIN) { cvt_item((const float*)a.in[3] + (size_t)l * DM * DIN, DIN, 1024, (bf16_t*)(wb + WB_WIN), MAT_WIN, r, 192, scr, lane, nullptr); continue; } r -= I_WIN;
        if (r < I_GLU) { cvt_item((const float*)a.in[13] + (size_t)l * 512 * 1024, 1024, 512, (bf16_t*)(wb + WB_WGLU), MAT_WGLU, r, 32, scr, lane, nullptr); continue; } r -= I_GLU;
        if (r < I_UQ) { cvt_item((const float*)a.in[16] + (size_t)l * 256 * 768, 768, 256, (bf16_t*)(wb + WB_WUQ), MAT_WUQ, r, 24, scr, lane, (const float*)a.in[15] + l * 256); continue; } r -= I_UQ;
        if (r < I_UKV) { cvt_item((const float*)a.in[18] + (size_t)l * 128 * 1024, 1024, 128, (bf16_t*)(wb + WB_WUKV), MAT_PLAIN, r, 32, scr, lane, (const float*)a.in[17] + l * 128); continue; } r -= I_UKV;
        if (r < I_MEM) { cvt_item((const float*)a.in[19] + (size_t)l * 1024 * 1024, 1024, 1024, (bf16_t*)(wb + WB_WMEM), MAT_PLAIN, r, 32, scr, lane, nullptr); continue; } r -= I_MEM;
        if (r < 3 * I_P) { const int which = r / I_P; cvt_item((const float*)a.in[20 + which] + (size_t)l * 512 * 1024, 1024, 512, (bf16_t*)(wb + WB_WP) + (size_t)which * 1024 * 512, MAT_PLAIN, r % I_P, 32, scr, lane, nullptr); continue; } r -= 3 * I_P;
        cvt_item((const float*)a.in[23] + (size_t)l * 1024 * 1024, 1024, 1024, (bf16_t*)(wb + WB_WOUT), MAT_PLAIN, r, 32, scr, lane, nullptr);
    }
}


typedef unsigned gu32_plain;
#define XB_TMO      128
#define XB_XCNT(j)  (256  + 64 * (j))
#define XB_XSUB(j)  (1280 + 64 * (j))
#define XB_XGEN(j)  (2304 + 64 * (j))
#define XB_TOP      3328
#define XB_TOPGEN   3392
#define XCD_BAR_WORDS 3456
#define XB_SPIN_CAP (1u << 18)

__device__ __forceinline__ unsigned xb_ld(unsigned* p)              { return __hip_atomic_load(p, __ATOMIC_RELAXED, __HIP_MEMORY_SCOPE_AGENT); }
__device__ __forceinline__ unsigned xb_add(unsigned* p, unsigned v) { return __hip_atomic_fetch_add(p, v, __ATOMIC_RELAXED, __HIP_MEMORY_SCOPE_AGENT); }
__device__ __forceinline__ unsigned xb_xcc_id() { return (unsigned)__builtin_amdgcn_s_getreg((3 << 11) | 20) & 0xFu; }
#define XB_SPIN(cond, bar) do { unsigned _sp = 0; while (cond) { __builtin_amdgcn_s_sleep(1); \
    if ((++_sp & 255u) == 0u) { if (xb_ld(&(bar)[XB_TMO])) break; if (_sp > XB_SPIN_CAP) { atomicAdd(&(bar)[XB_TMO], 1u); break; } } } } while (0)

struct XcdBarrier {
    unsigned* bar; unsigned x;
    volatile LAS unsigned* st;
};

__device__ __forceinline__ XcdBarrier xcd_barrier_post(unsigned* bar, volatile LAS unsigned* st) {
    XcdBarrier b; b.bar = bar; b.x = xb_xcc_id(); b.st = st;
    if (threadIdx.x == 0) (void)xb_add(&bar[XB_XCNT(b.x)], 1u);
    return b;
}
__device__ __forceinline__ void xcd_barrier_complete(unsigned* bar, unsigned x, unsigned& nloc, unsigned& nx) {
    const unsigned G = gridDim.x * gridDim.y * gridDim.z;
    unsigned sum, cnt, mine, sp = 0u;
    for (;;) {
        sum = 0u; cnt = 0u; mine = 0u;
#pragma unroll
        for (unsigned j = 0; j < 16; ++j) { const unsigned c = xb_ld(&bar[XB_XCNT(j)]); sum += c; cnt += (c > 0u) ? 1u : 0u; mine = (j == x) ? c : mine; }
        if (sum == G) break;
        __builtin_amdgcn_s_sleep(1);
        if ((++sp & 255u) == 0u) { if (xb_ld(&bar[XB_TMO])) break; if (sp > XB_SPIN_CAP) { atomicAdd(&bar[XB_TMO], 1u); break; } }
    }
    nloc = mine > 0u ? mine : 1u; nx = cnt > 0u ? cnt : 1u;
}

__device__ __forceinline__ void xcd_barrier(const XcdBarrier& b) {
    asm volatile("s_waitcnt vmcnt(0)" ::: "memory");
    __syncthreads();
    if (threadIdx.x == 0) {
        unsigned* bar = b.bar;
        __builtin_amdgcn_s_waitcnt(0);
        unsigned nloc = b.st[0], nx = b.st[1];
        if (nloc == 0u) { xcd_barrier_complete(bar, b.x, nloc, nx); b.st[0] = nloc; b.st[1] = nx; }
        const unsigned old = xb_add(&bar[XB_XSUB(b.x)], 1u);
        const unsigned gen = old / nloc;
        if (old + 1u == (gen + 1u) * nloc) {
            __builtin_amdgcn_fence(__ATOMIC_RELEASE, "agent");
            asm volatile("s_waitcnt vmcnt(0)" ::: "memory");
            const unsigned og = xb_add(&bar[XB_TOP], 1u);
            const unsigned tg = og / nx;
            if (og + 1u == (tg + 1u) * nx) xb_add(&bar[XB_TOPGEN], 1u);
            else XB_SPIN(xb_ld(&bar[XB_TOPGEN]) == tg, bar);
            __builtin_amdgcn_fence(__ATOMIC_ACQUIRE, "agent");
            xb_add(&bar[XB_XGEN(b.x)], 1u);
            asm volatile("s_waitcnt vmcnt(0)" ::: "memory");
        } else {
            XB_SPIN(xb_ld(&bar[XB_XGEN(b.x)]) == gen, bar);
            __builtin_amdgcn_fence(__ATOMIC_ACQUIRE, "agent");
            asm volatile("s_waitcnt vmcnt(0)" ::: "memory");
        }
    }
    __syncthreads();
}
constexpr int NWAVES = 8, LDS_BYTES = 147456, LDS_BARST = 147392;
constexpr size_t WS_CTL = 0, CTL_BYTES = 16384;
constexpr int N_PHASES = 1 + 7 * DEPTH;

__global__ void __launch_bounds__(NWAVES * 64, 2) mk_fwd(Args args) {
    extern __shared__ __attribute__((aligned(16))) unsigned char lds_raw[];
    LAS unsigned char* lds = (LAS unsigned char*)lds_raw;
    const int G = gridDim.x, cu = blockIdx.x, NGW = G * NWAVES;
    unsigned char* ws = args.ws;
#if !MK_MULTI
    if (threadIdx.x < 2) ((LAS unsigned*)(lds + LDS_BARST))[threadIdx.x] = 0u;
    __syncthreads();
    const XcdBarrier gbar = xcd_barrier_post((unsigned*)(ws + WS_CTL), (volatile LAS unsigned*)(lds + LDS_BARST));
#endif
    bf16_t* XB = (bf16_t*)(ws + WS_XB); bf16_t* PA = (bf16_t*)(ws + WS_PA); bf16_t* RG = (bf16_t*)(ws + WS_R);
    bf16_t* QB = (bf16_t*)(ws + WS_R + R_Q); bf16_t* KN = (bf16_t*)(ws + WS_R + R_KN); bf16_t* KR = (bf16_t*)(ws + WS_R + R_KR); bf16_t* VB = (bf16_t*)(ws + WS_R + R_V);
    bf16_t* MEMB = (bf16_t*)(ws + WS_MEMB); bf16_t* MEMKV = (bf16_t*)(ws + WS_MEMKV);
    float* SQP = (float*)(ws + WS_SQP); float* SKP = (float*)(ws + WS_SKP); float* ROPE = (float*)(ws + WS_ROPE); f32x2* SS = (f32x2*)(ws + WS_SS);
    unsigned char* wb = ws + WS_WB;
    bf16_t* DUMMY = (bf16_t*)(ws + WS_R + 120 * MiB);
    const float* xin = (const float*)args.in[0];
    float* out = args.out;

    if (args.ph_lo == 0 && (PHMASK & 1)) {
        int tid = threadIdx.x; asm volatile("" : "+v"(tid));
        const int lane = tid & 63, wave = __builtin_amdgcn_readfirstlane(tid >> 6), gw = cu * NWAVES + wave;

            convert_layer(args, 0, (LAS float*)(lds + wave * 16384), gw, NGW, lane);
            { const size_t n4 = (size_t)MTOK * DM / 4;
              for (size_t i = (size_t)cu * 512 + tid; i < n4; i += (size_t)G * 512) { const f32x4 v = ((const f32x4*)xin)[i]; u32x2 w; w.x = cvtpk(v[0], v[1]); w.y = cvtpk(v[2], v[3]); ((u32x2*)XB)[i] = w; } }
            { const size_t n4 = (size_t)NB * MEML * DM / 4; const float* mem = (const float*)args.in[1];
              for (size_t i = (size_t)cu * 512 + tid; i < n4; i += (size_t)G * 512) { const f32x4 v = ((const f32x4*)mem)[i]; u32x2 w; w.x = cvtpk(v[0], v[1]); w.y = cvtpk(v[2], v[3]); ((u32x2*)MEMB)[i] = w; } }
            { const int* pos = (const int*)args.in[2];
              for (int i = cu * 512 + tid; i < MTOK * 16; i += G * 512) { const int m = i >> 4, f = i & 15; const double invf = exp(-(double)f * (9.210340371976184 / 16.0)); double c, s; cossin_d((double)pos[m] * invf, c, s);
                  ROPE[(size_t)i * 2] = (float)c; ROPE[(size_t)i * 2 + 1] = (float)s; } }
            {
              for (int i = cu * 512 + tid; i < DEPTH * 32 * 64; i += G * 512) { const int p = i & 63, g = (i >> 6) & 31, l = i >> 11;
                  unsigned char* tab = ws + WS_TAB + (size_t)l * TAB_L; bf16_t* BBt = (bf16_t*)tab; bf16_t* CMt = (bf16_t*)(tab + 128 * 1024); f32x2* LAM = (f32x2*)(tab + 256 * 1024); f32x2* LAML = (f32x2*)(tab + 272 * 1024);
                  const double dt = exp((double)((const float*)args.in[7])[l * 32 + g]); const double lr = ((const float*)args.in[5])[(l * 32 + g) * 64 + p], li = ((const float*)args.in[6])[(l * 32 + g) * 64 + p];
                  const double mag = exp(lr * dt); double c, s; cossin_d(li * dt, c, s); const double lbr = mag * c, lbi = mag * s, nr = lbr - 1.0, ni = lbi, den = lr * lr + li * li;
                  const double fre = (nr * lr + ni * li) / den, fim = (ni * lr - nr * li) / den;
                  const float* bre = (const float*)args.in[8] + ((size_t)(l * 32 + g) * 64 + p) * 16; const float* bim = (const float*)args.in[9] + ((size_t)(l * 32 + g) * 64 + p) * 16;
                  for (int cc = 0; cc < 16; ++cc) { const double br = bre[cc], bi = bim[cc]; BBt[((size_t)g * 128 + 2 * p) * 16 + cc] = f2bf((float)(fre * br - fim * bi)); BBt[((size_t)g * 128 + 2 * p + 1) * 16 + cc] = f2bf((float)(fre * bi + fim * br)); }
                  const float* cre = (const float*)args.in[10] + (size_t)(l * 32 + g) * 16 * 64; const float* cim = (const float*)args.in[11] + (size_t)(l * 32 + g) * 16 * 64;
                  for (int cc = 0; cc < 16; ++cc) { CMt[((size_t)g * 16 + cc) * 128 + 2 * p] = f2bf(cre[cc * 64 + p]); CMt[((size_t)g * 16 + cc) * 128 + 2 * p + 1] = f2bf(-cim[cc * 64 + p]); }
                  LAM[g * 64 + p] = (f32x2){(float)lbr, (float)lbi};
                  const double magL = exp(lr * dt * (double)SSM_L); double cL, sL; cossin_d(li * dt * (double)SSM_L, cL, sL); LAML[g * 64 + p] = (f32x2){(float)(magL * cL), (float)(magL * sL)}; } }
#if !MK_MULTI
        if (args.ph_hi > 1) { __threadfence(); cg::this_grid().sync(); }
#endif
    }
    for (int ph = (args.ph_lo > 1 ? args.ph_lo : 1); ph < args.ph_hi; ++ph) {
        int tid = threadIdx.x; asm volatile("" : "+v"(tid));
        const int lane = tid & 63, wave = __builtin_amdgcn_readfirstlane(tid >> 6), gw = cu * NWAVES + wave;
        {
            const int l = (ph - 1) / 7, k = (ph - 1) % 7;
            const unsigned char* tab = ws + WS_TAB + (size_t)l * TAB_L;
            if (k == 0 && (PHMASK & 2)) {
#pragma unroll 1
                for (int rep = 0; rep < (PROBE_JOB == 1 ? 2 : 1); ++rep)
                { pg8::StaticOrder S; S.init(MTOK, PAW, G, cu, XB, DM, wb + WB_WIN, DM); pg8::EpiIn E{PA, SQP, SKP, KR, ROPE}; pg8::gemm_phase(lds, DM, DM, S, E); }
                { pg8::StaticOrder S; S.init(NB * MEML, 1024, G, cu, MEMB, DM, wb + WB_WMEM, DM); pg8::EpiPlain E{MEMKV, 1024}; pg8::gemm_phase(lds, DM, DM, S, E); }
            } else if (k == 1 && (PHMASK & 4)) {
                if (K1MASK & 1) { pg8::StaticOrder S; S.init(MTOK, 768, G, cu, PA + C_CQ, PAW, wb + WB_WUQ, 256); pg8::EpiQ E{QB, SQP, ROPE}; pg8::gemm_phase(lds, 256, PAW, S, E); }
                if (K1MASK & 2) { pg8::StaticOrder S; S.init(MTOK, 1024, G, cu, PA + C_CKV, PAW, wb + WB_WUKV, 128); pg8::EpiKV E{KN, VB, SKP}; pg8::gemm_phase(lds, 128, PAW, S, E); }
#pragma unroll 1
                for (int rep = 0; rep < (PROBE_JOB == 3 ? 2 : 1); ++rep)
                if (K1MASK & 4) for (int task = gw; task < NB * 32 * SSM_NC; task += NGW) ssm_task<false>(lds + wave * 16896, task, PA, tab, (const float*)args.in[12] + l * 512, SS);
                __syncthreads();
#pragma unroll 1
                for (int rep = 0; rep < (PROBE_JOB == 4 ? 2 : 1); ++rep)
                if (K1MASK & 8) for (int ui = cu; ui < NB * 4 * 16; ui += G) { const bool dummy = (PROBE_JOB == 4 && rep == 0); const int b = ui >> 6, hh = (ui >> 4) & 3, qb = ui & 15; const size_t t0 = (size_t)b * SEQ;
#pragma unroll 1
                    for (int e = 0; e < 2; ++e)
                    attn_unit<128, 128, 64, false>(lds, PA + t0 * PAW + C_QX + 128 * hh, PAW, MEMKV + (size_t)b * MEML * 1024 + 128 * hh, 1024, nullptr, 0,
                                                    MEMKV + (size_t)b * MEML * 1024 + 512 + 128 * hh + 64 * e, 1024, dummy ? DUMMY + t0 * 64 : PA + t0 * PAW + C_ZX + 128 * hh + 64 * e, dummy ? 64 : PAW, 256 * qb, MEML / 64); }
            } else if (k == 2 && (PHMASK & 8)) {
#pragma unroll 1
                for (int rep = 0; rep < (PROBE_JOB == 2 ? 2 : 1); ++rep)
                for (int pi = cu; pi < NB * 8 * 8; pi += G) { const bool dummy = (PROBE_JOB == 2 && rep == 0); const int bh = pi >> 3, j = pi & 7, b = bh >> 3, hh = bh & 7; const size_t t0 = (size_t)b * SEQ;
#pragma unroll 1
                    for (int e = 0; e < 2; ++e) { const int qb = e ? 15 - j : j;
                        attn_unit<96, 64, 64, true>(lds, QB + t0 * 768 + 96 * hh, 768, KN + t0 * 512 + 64 * hh, 512, KR + t0 * 32, 32, VB + t0 * 512 + 64 * hh, 512, dummy ? DUMMY + t0 * 64 : PA + t0 * PAW + C_ZM + 64 * hh, dummy ? 64 : PAW, 256 * qb, 4 * (qb + 1)); } }
                for (int task = gw; task < NB * 32 * SSM_NC; task += NGW) ssm_task<true>(lds + wave * 16896, task, PA, tab, (const float*)args.in[12] + l * 512, SS);
                __syncthreads();
            } else if (k == 3 && (PHMASK & 16)) {
#pragma unroll 1
                for (int rep = 0; rep < (PROBE_JOB == 5 ? 2 : 1); ++rep)
                { pg8::StaticOrder S; S.init(MTOK, PAW, G, cu, XB, DM, wb + WB_WIN + (size_t)PAW * DM * 2, DM); pg8::EpiGate E{RG, (const float*)args.in[4] + l * 3072}; pg8::gemm_phase(lds, DM, DM, S, E); }
                { pg8::StaticOrder S; S.init(MTOK, 1024, G, cu, PA + C_U, PAW, wb + WB_WGLU, 512); pg8::EpiGlu E{PA, (const float*)args.in[14] + l * 1024}; pg8::gemm_phase(lds, 512, PAW, S, E); }
            } else if (k == 4 && (PHMASK & 32)) {
#pragma unroll 1
                for (int rep = 0; rep < (PROBE_JOB == 9 ? 2 : 1); ++rep) { const bool dummy = (PROBE_JOB == 9 && rep == 0);
                pg8::MergeOrder S{G, cu, (const char*)PA, (const char*)(wb + WB_WP)}; pg8::EpiMerge E{RG, dummy ? XB : RG, dummy ? DM : PAW}; pg8::gemm_phase(lds, 512, PAW, S, E); }
            } else if (k == 5 && (PHMASK & 64)) {
#pragma unroll 1
                for (int rep = 0; rep < (PROBE_JOB == 8 ? 2 : 1); ++rep) { const bool dummy = (PROBE_JOB == 8 && rep == 0);
                pg8::StaticOrder S; S.init(MTOK, DM, G, cu, RG, PAW, wb + WB_WOUT, DM); pg8::EpiOut E{l == 0 ? xin : (const float*)out, dummy ? (float*)PA : out}; pg8::gemm_phase(lds, DM, PAW, S, E); }
            } else if (k == 6 && (PHMASK & 128)) {
                const float* lg = (const float*)args.in[24] + l * DM; const float* lb = (const float*)args.in[25] + l * DM;
                f32x4 gv[4], bv[4];
#pragma unroll
                for (int j = 0; j < 4; ++j) { gv[j] = ((const f32x4*)lg)[lane + 64 * j]; bv[j] = ((const f32x4*)lb)[lane + 64 * j]; }
#pragma unroll 1
                for (int rep = 0; rep < (PROBE_JOB == 7 ? 2 : 1); ++rep) { const bool dummy = (PROBE_JOB == 7 && rep == 0);
                for (int m = gw; m < MTOK; m += NGW) { f32x4* xr = (f32x4*)(out + (size_t)m * DM) + lane; f32x4* xw = dummy ? (f32x4*)((float*)PA + (size_t)m * DM) + lane : xr; f32x4 v[4]; float s = 0.f;
#pragma unroll
                    for (int j = 0; j < 4; ++j) { v[j] = xr[64 * j]; s += (v[j][0] + v[j][1]) + (v[j][2] + v[j][3]); }
                    const float mean = wave_sum(s) * (1.f / DM); float s2 = 0.f;
#pragma unroll
                    for (int j = 0; j < 4; ++j) { v[j] = v[j] - mean; s2 += (v[j][0] * v[j][0] + v[j][1] * v[j][1]) + (v[j][2] * v[j][2] + v[j][3] * v[j][3]); }
                    const float rstd = 1.f / sqrtf(wave_sum(s2) * (1.f / DM) + LN_EPS);
                    u32x2* xb = (u32x2*)((dummy ? RG : XB) + (size_t)m * DM) + lane;
#pragma unroll
                    for (int j = 0; j < 4; ++j) { const f32x4 y = v[j] * rstd * gv[j] + bv[j]; xw[64 * j] = y; u32x2 w; w.x = cvtpk(y[0], y[1]); w.y = cvtpk(y[2], y[3]); xb[64 * j] = w; } } }
                if (l + 1 < DEPTH) convert_layer(args, l + 1, (LAS float*)(lds + wave * 16384), gw, NGW, lane);
            }
        }
#if !MK_MULTI
        if (ph + 1 < args.ph_hi) { xcd_barrier(gbar); if (PROBE_JOB == 6) { xcd_barrier(gbar); xcd_barrier(gbar); } }
#endif
    }
}

extern "C" void kernel_launch(void* const* d_in, const int* in_sizes, int n_in, void* d_out, int out_size, void* d_ws, size_t ws_size, hipStream_t stream) {
    static int grid = 0;
    if (grid == 0) {
        if (n_in != 26 || out_size != MTOK * DM || ws_size < WS_END) { fprintf(stderr, "kernel_launch: unexpected sizes n_in %d out %d ws %zu\n", n_in, out_size, ws_size); grid = -1; return; }
        int dev = 0, cus = 0, per_cu = 0;
        hipGetDevice(&dev); hipDeviceGetAttribute(&cus, hipDeviceAttributeMultiprocessorCount, dev);
        hipFuncSetAttribute((const void*)mk_fwd, hipFuncAttributeMaxDynamicSharedMemorySize, LDS_BYTES);
        hipOccupancyMaxActiveBlocksPerMultiprocessor(&per_cu, (const void*)mk_fwd, NWAVES * 64, LDS_BYTES);
        if (per_cu < 1) { fprintf(stderr, "kernel_launch: occupancy query says %d blocks/CU\n", per_cu); per_cu = 1; }
        (void)hipGetLastError();
        grid = cus * 1;
    }
    if (grid < 0) return;
    Args a{};
    for (int i = 0; i < 26; ++i) a.in[i] = d_in[i];
    a.out = (float*)d_out; a.ws = (unsigned char*)d_ws;
#if MK_MULTI
    for (int ph = 0; ph < N_PHASES; ++ph) { a.ph_lo = ph; a.ph_hi = ph + 1; hipLaunchKernelGGL(mk_fwd, dim3(grid), dim3(NWAVES * 64), LDS_BYTES, stream, a); }
#else
    a.ph_lo = 0; a.ph_hi = N_PHASES;
    if (hipMemsetAsync((char*)d_ws + WS_CTL, 0, CTL_BYTES, stream) != hipSuccess) { fprintf(stderr, "kernel_launch: memset of barrier words failed\n"); return; }
    void* kargs[] = {&a};
    hipError_t e = hipLaunchCooperativeKernel((const void*)mk_fwd, dim3(grid), dim3(NWAVES * 64), kargs, LDS_BYTES, stream);
    if (e != hipSuccess) fprintf(stderr, "cooperative launch failed: %s (grid %d)\n", hipGetErrorString(e), grid);
#endif
}
```

```cpp
#include <hip/hip_runtime.h>
#include <hip/hip_cooperative_groups.h>
#include <cstdio>
#include <cstdint>
namespace cg = cooperative_groups;

#ifndef MK_MULTI
#define MK_MULTI 0
#endif

#ifndef PROBE_JOB
#define PROBE_JOB 0
#endif
#ifndef K1MASK
#define K1MASK 15
#endif
#ifndef PHMASK
#define PHMASK 255
#endif
#define LAS __attribute__((address_space(3)))
typedef unsigned short bf16_t;
typedef short bf16x8 __attribute__((ext_vector_type(8)));
typedef float f32x2 __attribute__((ext_vector_type(2)));
typedef float f32x4 __attribute__((ext_vector_type(4)));
typedef float f32x16 __attribute__((ext_vector_type(16)));
typedef unsigned u32x2 __attribute__((ext_vector_type(2)));
typedef unsigned u32x4 __attribute__((ext_vector_type(4)));
typedef __bf16 bf16x2_t __attribute__((ext_vector_type(2)));

constexpr int DM = 1024, NB = 8, SEQ = 4096, DEPTH = 4, MEML = 256;
constexpr int MTOK = NB * SEQ;
constexpr int DIN = 6048;
constexpr int PAW = 3072;
constexpr float LN_EPS = 1e-5f;
constexpr float ALPHA = 1.6817928305074292f;
constexpr float LOG2E = 1.4426950408889634f;
constexpr float MLA_SCALE = 0.10206207261596577f * LOG2E;
constexpr float QMEM_SCALE = 0.08838834764831845f * LOG2E;
constexpr int SSM_L = 512, SSM_NC = SEQ / SSM_L;

constexpr size_t MiB = 1u << 20;
constexpr size_t WS_TAB = 1 * MiB;
constexpr size_t TAB_L = 288 * 1024;
constexpr size_t WS_ROPE = 3 * MiB;
constexpr size_t WS_SS = 7 * MiB;
constexpr size_t WS_SQP = 8 * MiB;
constexpr size_t WS_SKP = WS_SQP + 512 * 1024;
constexpr size_t WS_MEMB = 9 * MiB;
constexpr size_t WS_MEMKV = 13 * MiB;
constexpr size_t WS_WB = 21 * MiB;
constexpr size_t WB_WIN = 0, WB_WGLU = 12 * MiB, WB_WUQ = 13 * MiB, WB_WUKV = WB_WUQ + 512 * 1024, WB_WMEM = 14 * MiB, WB_WP = 18 * MiB, WB_WOUT = 21 * MiB;
constexpr size_t WS_XB = 45 * MiB;
constexpr size_t WS_PA = 109 * MiB;
constexpr size_t WS_R = 301 * MiB;
constexpr size_t R_Q = 0, R_KN = 48 * MiB, R_KR = 80 * MiB, R_V = 82 * MiB;
constexpr size_t WS_END = 493 * MiB;

constexpr int C_U = 0, C_ZS = 512, C_CQ = 1024, C_CKV = 1280, C_KR = 1408, C_ZM = 1536, C_QX = 2048, C_ZX = 2560;

__device__ __forceinline__ unsigned cvtpk(float lo, float hi) { f32x2 v = {lo, hi}; bf16x2_t b = __builtin_convertvector(v, bf16x2_t); return __builtin_bit_cast(unsigned, b); }
__device__ __forceinline__ bf16_t f2bf(float f) { return (bf16_t)(cvtpk(f, 0.f) & 0xffffu); }
__device__ __forceinline__ float bflo(unsigned w) { return __uint_as_float(w << 16); }
__device__ __forceinline__ float bfhi(unsigned w) { return __uint_as_float(w & 0xffff0000u); }
__device__ __forceinline__ float bf2f(bf16_t b) { return __uint_as_float((unsigned)b << 16); }
__device__ __forceinline__ float sigmoidf_(float x) { return __builtin_amdgcn_rcpf(1.0f + __expf(-x)); }
__device__ __forceinline__ float siluf_(float x) { return x * sigmoidf_(x); }
__device__ __forceinline__ float gelu_tanh(float x) { const float z = 0.7978845608028654f * (x + 0.044715f * x * x * x); return x * sigmoidf_(2.0f * z); }
__device__ __forceinline__ float wave_sum(float v) {
#pragma unroll
    for (int o = 1; o < 64; o <<= 1) v += __shfl_xor(v, o);
    return v;
}
#define LDS_WAIT() asm volatile("s_waitcnt lgkmcnt(0)" ::: "memory")
__device__ __forceinline__ int crow(int i, int h) { return (i & 3) + 8 * (i >> 2) + 4 * h; }
__device__ __forceinline__ void cossin_d(double a, double& c, double& s) {
    const double q = rint(a * 0.63661977236758134308);
    const double y = a - q * 1.57079632679489661923;
    const double y2 = y * y;
    const double sp = y * (1.0 + y2 * (-1.0 / 6 + y2 * (1.0 / 120 + y2 * (-1.0 / 5040 + y2 * (1.0 / 362880 + y2 * (-1.0 / 39916800 + y2 * (1.0 / 6227020800.0)))))));
    const double cp = 1.0 + y2 * (-0.5 + y2 * (1.0 / 24 + y2 * (-1.0 / 720 + y2 * (1.0 / 40320 + y2 * (-1.0 / 3628800 + y2 * (1.0 / 479001600.0))))));
    const int qi = ((int)((long long)q)) & 3;
    c = (qi == 0) ? cp : (qi == 1) ? -sp : (qi == 2) ? -cp : sp;
    s = (qi == 0) ? sp : (qi == 1) ? cp : (qi == 2) ? -sp : -cp;
}

namespace pg8 {
constexpr int BM = 256, BK = 64, HALF = 128, HTB = HALF * BK * 2, STAGE_BYTES = 8 * HTB, NXCD = 8, WGM = 8;
__host__ __device__ __forceinline__ int lds_byte(int r, int c) { const int st = (r >> 4) * 2 + (c >> 5), rr = r & 15, cc = c & 31, ob = rr * 64 + cc * 2; return st * 1024 + (ob ^ (((ob >> 9) & 1) << 5)); }
__host__ __device__ __forceinline__ void stage_rc(int b, int& R, int& C) { const int st = b / 1024, sb = b % 1024, swz = sb ^ (((sb >> 9) & 1) << 5); R = (st >> 1) * 16 + swz / 64; C = (st & 1) * 32 + (swz % 64) / 2; }
__host__ __device__ __forceinline__ int perm32(int rho) { const int n = rho >> 4, i = rho & 15; return 8 * (i >> 2) + 4 * n + (i & 3); }

struct Unit { int pm, pn, sub; const char* a; const char* b; };

struct StaticOrder {
    int nM, nN, nwg, G, c; const char* A; const char* B; size_t tA, tB;
    __device__ void init(int M, int N, int G_, int c_, const void* A_, int lda, const void* B_, int K) { nM = M / BM; nN = N / BM; nwg = nM * nN; G = G_; c = c_; A = (const char*)A_; B = (const char*)B_; tA = (size_t)BM * lda * 2; tB = (size_t)BM * K * 2; }
    __device__ bool next(int i, Unit& u) const {
        const long L = (long)i * G + c; if (L >= nwg) return false;
        int wgid = (int)L; { const int q = nwg / NXCD, r = nwg % NXCD, xcd = wgid % NXCD, off = wgid / NXCD; wgid = (xcd < r ? xcd * (q + 1) : r * (q + 1) + (xcd - r) * q) + off; }
        const int nig = WGM * nN, gid = wgid / nig, fm = gid * WGM, gsz = (nM - fm) < WGM ? (nM - fm) : WGM;
        u.pm = fm + ((wgid % nig) % gsz); u.pn = (wgid % nig) / gsz; u.sub = 0; u.a = A + (size_t)u.pm * tA; u.b = B + (size_t)u.pn * tB; return true;
    }
};

template <class Epi, class Sched>
__device__ __forceinline__ void gemm_phase(LAS unsigned char* lds, const int K_, const int lda_, const Sched& S, const Epi& E) {
    int K = K_, lda = lda_, tid = threadIdx.x;
    asm volatile("" : "+s"(K), "+s"(lda), "+v"(tid));
    const int wid = __builtin_amdgcn_readfirstlane(tid >> 6), lane = tid & 63, wr = wid >> 2, wc = wid & 3, fr = lane & 15, fq = lane >> 4;
    const int nt = K / BK;
    unsigned voffA[2], voffB[2];
#pragma unroll
    for (int i = 0; i < 2; ++i) { int R, C; stage_rc(tid * 16 + i * 8192, R, C); const int Rb = (R & ~31) + perm32(R & 31);
        voffA[i] = (unsigned)(R * lda + C) * 2u; voffB[i] = (unsigned)(Rb * K + C) * 2u; }
    const size_t kstep = (size_t)(BK * 2);
    const size_t hA = (size_t)HALF * lda * 2, hB = (size_t)HALF * K * 2;
    const unsigned ldsw = (unsigned)wid * 1024u;
    const int aoff = lds_byte(wr * 64 + fr, fq * 8), boff = lds_byte(wc * 32 + fr, fq * 8);
#define PG8_SA(b, h) (((b) * 2 + (h)) * HTB)
#define PG8_SB(b, h) ((4 + (b) * 2 + (h)) * HTB)
#define PG8_STAGE(bufoff, gbase, voff) do { _Pragma("unroll") for (int _i = 0; _i < 2; ++_i) \
        __builtin_amdgcn_global_load_lds((const unsigned*)((const char*)(gbase) + (voff)[_i]), (LAS unsigned*)(lds + (bufoff) + ldsw + _i * 8192), 16, 0, 0); } while (0)
#define PG8_LDA(dst, b, h) do { _Pragma("unroll") for (int m = 0; m < 4; ++m) _Pragma("unroll") for (int k = 0; k < 2; ++k) dst[m][k] = *(const LAS bf16x8*)(lds + PG8_SA(b, h) + aoff + m * 2048 + k * 1024); } while (0)
#define PG8_LDB(dst, b, h) do { _Pragma("unroll") for (int n = 0; n < 2; ++n) _Pragma("unroll") for (int k = 0; k < 2; ++k) dst[n][k] = *(const LAS bf16x8*)(lds + PG8_SB(b, h) + boff + n * 2048 + k * 1024); } while (0)
#define PG8_MMA(ai, bj, At, Bt) do { __builtin_amdgcn_s_setprio(1); _Pragma("unroll") for (int m = 0; m < 4; ++m) _Pragma("unroll") for (int n = 0; n < 2; ++n) _Pragma("unroll") for (int k = 0; k < 2; ++k) \
        acc[ai][bj][m][n] = __builtin_amdgcn_mfma_f32_16x16x32_bf16(Bt[n][k], At[m][k], acc[ai][bj][m][n], 0, 0, 0); __builtin_amdgcn_s_setprio(0); } while (0)
#define PG8_WAIT_V(n) asm volatile("s_waitcnt vmcnt(" #n ")" ::: "memory")
#define PG8_WAIT_L(n) asm volatile("s_waitcnt lgkmcnt(" #n ")" ::: "memory")
#define PG8_BAR __builtin_amdgcn_s_barrier()
#define PG8_SCHED __builtin_amdgcn_sched_barrier(0)
    Unit cur, nxt; int ui = 0;
    if (!S.next(0, cur)) return;
    f32x4 acc[2][2][4][2];
#pragma unroll
    for (int a = 0; a < 2; ++a)
#pragma unroll
        for (int b = 0; b < 2; ++b)
#pragma unroll
            for (int m = 0; m < 4; ++m)
#pragma unroll
                for (int n = 0; n < 2; ++n) acc[a][b][m][n] = (f32x4){0.f, 0.f, 0.f, 0.f};
    bf16x8 At[4][2], B0[2][2], B1[2][2];
    const char* cA = cur.a; const char* cB = cur.b;
    PG8_STAGE(PG8_SB(0, 0), cB, voffB); PG8_STAGE(PG8_SB(0, 1), cB + hB, voffB); PG8_STAGE(PG8_SA(0, 0), cA, voffA); PG8_STAGE(PG8_SA(0, 1), cA + hA, voffA);
    if (wr == 1) PG8_BAR;
    PG8_WAIT_V(2); PG8_BAR;
    PG8_STAGE(PG8_SB(1, 0), cB + kstep, voffB); PG8_STAGE(PG8_SA(1, 0), cA + kstep, voffA); PG8_STAGE(PG8_SB(1, 1), cB + hB + kstep, voffB);
    PG8_WAIT_V(6); PG8_BAR;
    for (;;) {
        const bool has_next = S.next(ui + 1, nxt);
        const char* nA = has_next ? nxt.a : cA; const char* nB = has_next ? nxt.b : cB;
        for (int t = 0; t < nt; t += 2) {
            const bool last = (t == nt - 2);
            const char* a1 = cA + (size_t)(t + 1) * kstep;
            const char* a2 = last ? nA : cA + (size_t)(t + 2) * kstep; const char* b2 = last ? nB : cB + (size_t)(t + 2) * kstep;
            const char* a3 = a2 + kstep; const char* b3 = b2 + kstep;
            PG8_LDB(B0, 0, 0); PG8_LDB(B1, 0, 1); PG8_SCHED; PG8_LDA(At, 0, 0); PG8_STAGE(PG8_SA(1, 1), a1 + hA, voffA);
            PG8_WAIT_V(8); PG8_WAIT_L(0); PG8_BAR; PG8_MMA(0, 0, At, B0); PG8_MMA(0, 1, At, B1); PG8_BAR; PG8_SCHED;
            PG8_LDA(At, 0, 1); PG8_STAGE(PG8_SB(0, 0), b2, voffB); PG8_STAGE(PG8_SB(0, 1), b2 + hB, voffB); PG8_STAGE(PG8_SA(0, 0), a2, voffA);
            PG8_WAIT_V(8); PG8_WAIT_L(0); PG8_BAR; PG8_MMA(1, 0, At, B0); PG8_MMA(1, 1, At, B1); PG8_BAR; PG8_SCHED;
            PG8_LDB(B0, 1, 0); PG8_LDB(B1, 1, 1); PG8_SCHED; PG8_LDA(At, 1, 0); PG8_STAGE(PG8_SA(0, 1), a2 + hA, voffA);
            PG8_WAIT_V(8); PG8_WAIT_L(0); PG8_BAR; PG8_MMA(0, 0, At, B0); PG8_MMA(0, 1, At, B1); PG8_BAR; PG8_SCHED;
            PG8_LDA(At, 1, 1); PG8_STAGE(PG8_SB(1, 0), b3, voffB); PG8_STAGE(PG8_SB(1, 1), b3 + hB, voffB); PG8_STAGE(PG8_SA(1, 0), a3, voffA);
            PG8_WAIT_V(8); PG8_WAIT_L(0); PG8_BAR; PG8_MMA(1, 0, At, B0); PG8_MMA(1, 1, At, B1); PG8_BAR; PG8_SCHED;
        }
        if (wr == 0) PG8_BAR;
        E(acc, cur, wr, wc, fr, fq);
        if (!has_next) break;
        if (!E.keep(cur)) {
#pragma unroll
        for (int a = 0; a < 2; ++a)
#pragma unroll
            for (int b = 0; b < 2; ++b)
#pragma unroll
                for (int m = 0; m < 4; ++m)
#pragma unroll
                    for (int n = 0; n < 2; ++n) acc[a][b][m][n] = (f32x4){0.f, 0.f, 0.f, 0.f};
        }
        cur = nxt; cA = nA; cB = nB; ++ui;
        if (wr == 1) PG8_BAR;
    }
    PG8_WAIT_V(0);
    PG8_BAR;
#undef PG8_SA
#undef PG8_SB
#undef PG8_STAGE
#undef PG8_LDA
#undef PG8_LDB
#undef PG8_MMA
#undef PG8_WAIT_V
#undef PG8_WAIT_L
#undef PG8_BAR
#undef PG8_SCHED
}
typedef f32x4 Acc[2][2][4][2];
#define EPI_ROW(u, ai, m) ((u).pm * 256 + (ai) * 128 + wr * 64 + (m) * 16 + fr)
#define EPI_COL(u, bj) ((u).pn * 256 + (bj) * 128 + wc * 32 + 8 * fq)

struct EpiIn {
    bf16_t* PA; float* SQP; float* SKP; bf16_t* KR; const float* ROPE;
    __device__ __forceinline__ bool keep(const Unit&) const { return false; }
    __device__ __forceinline__ void operator()(Acc& acc, const Unit& u, int wr, int wc, int fr, int fq) const {
        const int pn = u.pn; const bool act = (pn == 2 || pn == 3 || pn == 6 || pn == 7 || pn == 10 || pn == 11);
#pragma unroll
        for (int ai = 0; ai < 2; ++ai)
#pragma unroll
            for (int m = 0; m < 4; ++m) { const int row = EPI_ROW(u, ai, m); bf16_t* rowp = PA + (size_t)row * PAW + EPI_COL(u, 0);
#pragma unroll
                for (int bj = 0; bj < 2; ++bj) { f32x4 v0 = acc[ai][bj][m][0], v1 = acc[ai][bj][m][1];
                    if (act) {
#pragma unroll
                        for (int e = 0; e < 4; ++e) { v0[e] = siluf_(v0[e]); v1[e] = siluf_(v1[e]); } }
                    u32x4 w; w.x = cvtpk(v0[0], v0[1]); w.y = cvtpk(v0[2], v0[3]); w.z = cvtpk(v1[0], v1[1]); w.w = cvtpk(v1[2], v1[3]);
                    *(u32x4*)(rowp + bj * 128) = w; }
                if (pn == 4 || pn == 5) {
                    float s = 0.f;
#pragma unroll
                    for (int bj = 0; bj < 2; ++bj) if (pn == 4 || bj == 0) {
#pragma unroll
                        for (int n = 0; n < 2; ++n) { const f32x4 x = acc[ai][bj][m][n]; s += (x[0] * x[0] + x[1] * x[1]) + (x[2] * x[2] + x[3] * x[3]); } }
                    s += __shfl_xor(s, 16); s += __shfl_xor(s, 32);
                    if (fq == 0) (pn == 4 ? SQP : SKP)[(size_t)row * 4 + wc] = s;
                    if (pn == 5 && wc == 0) {
                        f32x4 o[2];
#pragma unroll
                        for (int n = 0; n < 2; ++n) { const f32x4 v = acc[ai][1][m][n]; const f32x4 cs = *(const f32x4*)(ROPE + (size_t)row * 32 + 2 * (4 * fq + 2 * n));
                            o[n][0] = v[0] * cs[0] - v[1] * cs[1]; o[n][1] = v[0] * cs[1] + v[1] * cs[0]; o[n][2] = v[2] * cs[2] - v[3] * cs[3]; o[n][3] = v[2] * cs[3] + v[3] * cs[2]; }
                        u32x4 w; w.x = cvtpk(o[0][0], o[0][1]); w.y = cvtpk(o[0][2], o[0][3]); w.z = cvtpk(o[1][0], o[1][1]); w.w = cvtpk(o[1][2], o[1][3]);
                        *(u32x4*)(KR + (size_t)row * 32 + 8 * fq) = w;
                    }
                }
                asm volatile("" ::: "memory");
            }
    }
};
struct EpiPlain {
    bf16_t* O; int ldc;
    __device__ __forceinline__ bool keep(const Unit&) const { return false; }
    __device__ __forceinline__ void operator()(Acc& acc, const Unit& u, int wr, int wc, int fr, int fq) const {
#pragma unroll
        for (int ai = 0; ai < 2; ++ai)
#pragma unroll
            for (int m = 0; m < 4; ++m) { bf16_t* rowp = O + (size_t)EPI_ROW(u, ai, m) * ldc + EPI_COL(u, 0);
#pragma unroll
                for (int bj = 0; bj < 2; ++bj) { const f32x4 v0 = acc[ai][bj][m][0], v1 = acc[ai][bj][m][1];
                    u32x4 w; w.x = cvtpk(v0[0], v0[1]); w.y = cvtpk(v0[2], v0[3]); w.z = cvtpk(v1[0], v1[1]); w.w = cvtpk(v1[2], v1[3]);
                    *(u32x4*)(rowp + bj * 128) = w; } }
    }
};
struct EpiGate {
    bf16_t* G; const float* bias;
    __device__ __forceinline__ bool keep(const Unit&) const { return false; }
    __device__ __forceinline__ void operator()(Acc& acc, const Unit& u, int wr, int wc, int fr, int fq) const {
        f32x4 bv[2][2];
#pragma unroll
        for (int bj = 0; bj < 2; ++bj)
#pragma unroll
            for (int n = 0; n < 2; ++n) bv[bj][n] = *(const f32x4*)(bias + EPI_COL(u, bj) + 4 * n);
#pragma unroll
        for (int ai = 0; ai < 2; ++ai)
#pragma unroll
            for (int m = 0; m < 4; ++m) { bf16_t* rowp = G + (size_t)EPI_ROW(u, ai, m) * PAW + EPI_COL(u, 0);
#pragma unroll
                for (int bj = 0; bj < 2; ++bj) { f32x4 v0 = acc[ai][bj][m][0] + bv[bj][0], v1 = acc[ai][bj][m][1] + bv[bj][1];
#pragma unroll
                    for (int e = 0; e < 4; ++e) { v0[e] = sigmoidf_(v0[e]); v1[e] = sigmoidf_(v1[e]); }
                    u32x4 w; w.x = cvtpk(v0[0], v0[1]); w.y = cvtpk(v0[2], v0[3]); w.z = cvtpk(v1[0], v1[1]); w.w = cvtpk(v1[2], v1[3]);
                    *(u32x4*)(rowp + bj * 128) = w; }
                asm volatile("" ::: "memory"); }
    }
};
struct EpiQ {
    bf16_t* Q; const float* SQP; const float* ROPE;
    __device__ __forceinline__ bool keep(const Unit&) const { return false; }
    __device__ __forceinline__ void operator()(Acc& acc, const Unit& u, int wr, int wc, int fr, int fq) const {
#pragma unroll
        for (int ai = 0; ai < 2; ++ai)
#pragma unroll
            for (int m = 0; m < 4; ++m) { const int row = EPI_ROW(u, ai, m); const f32x4 sq = *(const f32x4*)(SQP + (size_t)row * 4);
                const float sr = 1.0f / sqrtf(((sq[0] + sq[1]) + (sq[2] + sq[3])) * (1.0f / 256.0f) + LN_EPS);
#pragma unroll
                for (int bj = 0; bj < 2; ++bj) { const int col = EPI_COL(u, bj); f32x4 v[2];
#pragma unroll
                    for (int n = 0; n < 2; ++n) { v[n] = acc[ai][bj][m][n] * sr; const int d = (col + 4 * n) % 96;
                        if (d >= 64) { const f32x4 cs = *(const f32x4*)(ROPE + (size_t)row * 32 + (d - 64)); const f32x4 t = v[n];
                            v[n][0] = t[0] * cs[0] - t[1] * cs[1]; v[n][1] = t[0] * cs[1] + t[1] * cs[0]; v[n][2] = t[2] * cs[2] - t[3] * cs[3]; v[n][3] = t[2] * cs[3] + t[3] * cs[2]; } }
                    u32x4 w; w.x = cvtpk(v[0][0], v[0][1]); w.y = cvtpk(v[0][2], v[0][3]); w.z = cvtpk(v[1][0], v[1][1]); w.w = cvtpk(v[1][2], v[1][3]);
                    *(u32x4*)(Q + (size_t)row * 768 + col) = w; }
                asm volatile("" ::: "memory"); }
    }
};
struct EpiKV {
    bf16_t* KN; bf16_t* V; const float* SKP;
    __device__ __forceinline__ bool keep(const Unit&) const { return false; }
    __device__ __forceinline__ void operator()(Acc& acc, const Unit& u, int wr, int wc, int fr, int fq) const {
#pragma unroll
        for (int ai = 0; ai < 2; ++ai)
#pragma unroll
            for (int m = 0; m < 4; ++m) { const int row = EPI_ROW(u, ai, m); const f32x4 sq = *(const f32x4*)(SKP + (size_t)row * 4);
                const float sr = 1.0f / sqrtf(((sq[0] + sq[1]) + (sq[2] + sq[3])) * (1.0f / 128.0f) + LN_EPS);
#pragma unroll
                for (int bj = 0; bj < 2; ++bj) { const int head = 2 * u.pn + bj, local = wc * 32 + 8 * fq; const f32x4 v0 = acc[ai][bj][m][0] * sr, v1 = acc[ai][bj][m][1] * sr;
                    u32x4 w; w.x = cvtpk(v0[0], v0[1]); w.y = cvtpk(v0[2], v0[3]); w.z = cvtpk(v1[0], v1[1]); w.w = cvtpk(v1[2], v1[3]);
                    bf16_t* dst = (wc < 2) ? KN + (size_t)row * 512 + head * 64 + local : V + (size_t)row * 512 + head * 64 + (local - 64);
                    *(u32x4*)dst = w; }
                asm volatile("" ::: "memory"); }
    }
};
struct EpiGlu {
    bf16_t* PA; const float* bglu;
    __device__ __forceinline__ bool keep(const Unit&) const { return false; }
    __device__ __forceinline__ void operator()(Acc& acc, const Unit& u, int wr, int wc, int fr, int fq) const {
        const int j0 = 128 * u.pn + wc * 32 + 8 * fq;
        f32x4 ba[2], bb[2];
#pragma unroll
        for (int n = 0; n < 2; ++n) { ba[n] = *(const f32x4*)(bglu + j0 + 4 * n); bb[n] = *(const f32x4*)(bglu + 512 + j0 + 4 * n); }
#pragma unroll
        for (int ai = 0; ai < 2; ++ai)
#pragma unroll
            for (int m = 0; m < 4; ++m) { bf16_t* p = PA + (size_t)EPI_ROW(u, ai, m) * PAW + C_ZS + j0; const u32x4 z = *(const u32x4*)p; float y[8];
#pragma unroll
                for (int n = 0; n < 2; ++n) { const f32x4 a = acc[ai][0][m][n] + ba[n], b = acc[ai][1][m][n] + bb[n];
#pragma unroll
                    for (int e = 0; e < 4; ++e) y[4 * n + e] = a[e] * sigmoidf_(b[e]); }
                u32x4 w; w.x = cvtpk(y[0] * bflo(z.x), y[1] * bfhi(z.x)); w.y = cvtpk(y[2] * bflo(z.y), y[3] * bfhi(z.y)); w.z = cvtpk(y[4] * bflo(z.z), y[5] * bfhi(z.z)); w.w = cvtpk(y[6] * bflo(z.w), y[7] * bfhi(z.w));
                *(u32x4*)p = w; asm volatile("" ::: "memory"); }
    }
};
struct EpiMerge {
    bf16_t* G; bf16_t* O; int ldo;
    __device__ __forceinline__ bool keep(const Unit& u) const { return u.sub < 2; }
    __device__ __forceinline__ void operator()(Acc& acc, const Unit& u, int wr, int wc, int fr, int fq) const {
        const int sub = u.sub;
#pragma unroll
        for (int ai = 0; ai < 2; ++ai)
#pragma unroll
            for (int m = 0; m < 4; ++m) { bf16_t* rowp = G + (size_t)EPI_ROW(u, ai, m) * PAW + EPI_COL(u, 0);
#pragma unroll
                for (int bj = 0; bj < 2; ++bj) { const u32x4 ga = *(const u32x4*)(rowp + bj * 128 + sub * 1024);
                    float f[8] = {bflo(ga.x), bfhi(ga.x), bflo(ga.y), bfhi(ga.y), bflo(ga.z), bfhi(ga.z), bflo(ga.w), bfhi(ga.w)};
                    if (sub < 2) { const u32x4 gb = *(const u32x4*)(rowp + bj * 128 + (sub + 1) * 1024);
                        const float d[8] = {bflo(gb.x), bfhi(gb.x), bflo(gb.y), bfhi(gb.y), bflo(gb.z), bfhi(gb.z), bflo(gb.w), bfhi(gb.w)};
#pragma unroll
                        for (int e = 0; e < 8; ++e) f[e] = f[e] / fmaxf(d[e], 1e-30f); }
                    f32x4 v0 = acc[ai][bj][m][0], v1 = acc[ai][bj][m][1];
#pragma unroll
                    for (int e = 0; e < 4; ++e) { v0[e] *= f[e]; v1[e] *= f[4 + e]; }
                    acc[ai][bj][m][0] = v0; acc[ai][bj][m][1] = v1;
                    if (sub == 2) { u32x4 w; w.x = cvtpk(v0[0], v0[1]); w.y = cvtpk(v0[2], v0[3]); w.z = cvtpk(v1[0], v1[1]); w.w = cvtpk(v1[2], v1[3]); *(u32x4*)(O + (size_t)EPI_ROW(u, ai, m) * ldo + EPI_COL(u, bj)) = w; } } }
    }
};
struct MergeOrder {
    int G, c; const char* PA; const char* WP;
    __device__ bool next(int i, Unit& u) const {
        const int tile = (i / 3) * G + c; if (tile >= 512) return false;
        u.sub = i % 3; u.pm = tile >> 2; u.pn = tile & 3;
        const int colA = (u.sub == 0) ? C_ZS : (u.sub == 1) ? C_ZM : C_ZX;
        u.a = PA + ((size_t)u.pm * 256 * PAW + colA) * 2; u.b = WP + (size_t)u.sub * (1024 * 512 * 2) + (size_t)u.pn * (256 * 512 * 2); return true;
    }
};
struct EpiOut {
    const float* xres; float* out;
    __device__ __forceinline__ bool keep(const Unit&) const { return false; }
    __device__ __forceinline__ void operator()(Acc& acc, const Unit& u, int wr, int wc, int fr, int fq) const {
#pragma unroll
        for (int ai = 0; ai < 2; ++ai)
#pragma unroll
            for (int m = 0; m < 4; ++m) { const size_t off = (size_t)EPI_ROW(u, ai, m) * DM + EPI_COL(u, 0);
#pragma unroll
                for (int bj = 0; bj < 2; ++bj)
#pragma unroll
                    for (int n = 0; n < 2; ++n) { const f32x4 x = *(const f32x4*)(xres + off + bj * 128 + 4 * n); *(f32x4*)(out + off + bj * 128 + 4 * n) = x * ALPHA + acc[ai][bj][m][n]; } }
    }
};
}

#define MFMA32(a, b, c) __builtin_amdgcn_mfma_f32_32x32x16_bf16((a), (b), (c), 0, 0, 0)
template <int DQK, int DK1, int DV, bool CAUSAL>
__device__ __forceinline__ void attn_unit(LAS unsigned char* lds, const bf16_t* Q, int ldq, const bf16_t* K1, int ldk1, const bf16_t* K2, int ldk2,
                                          const bf16_t* V, int ldv, bf16_t* ZO, int ldo, int q0, int nt) {
    constexpr int KROW = (DQK + 8) * 2, VROW = 136, KBUF = 64 * KROW, VBUF = DV * VROW, BUF = KBUF + VBUF;
    constexpr int KCH = DQK / 8, VCH = DV / 8, NKL = (64 * KCH + 511) / 512, NVL = (64 * VCH) / 512, NS = DQK / 16, NDB = DV / 32;
    int tid = threadIdx.x; asm volatile("" : "+v"(tid));
    const int lane = tid & 63, r = lane & 31, h = lane >> 5, w = __builtin_amdgcn_readfirstlane(tid >> 6);
    bf16x8 qf[NS];
    { const bf16_t* qrow = Q + (size_t)(q0 + 32 * w + r) * ldq + 8 * h;
#pragma unroll
      for (int s = 0; s < NS; ++s) qf[s] = *(const bf16x8*)(qrow + 16 * s); }
    f32x16 o[NDB];
#pragma unroll
    for (int db = 0; db < NDB; ++db)
#pragma unroll
        for (int i = 0; i < 16; ++i) o[db][i] = 0.f;
    float mref = 0.f, lrun = 0.f;
    f32x16 negm;
#pragma unroll
    for (int i = 0; i < 16; ++i) negm[i] = 0.f;
    u32x4 kA[NKL], vA[NVL], kB[NKL], vB[NVL];
#define ATT_LOAD(t, kreg, vreg) do { \
    _Pragma("unroll") for (int i_ = 0; i_ < NKL; ++i_) { const int c_ = tid + 512 * i_; if (c_ < 64 * KCH) { const int row_ = c_ / KCH, col_ = 8 * (c_ % KCH); const size_t kv_ = (size_t)(64 * (t) + row_); \
        const bf16_t* src_ = (col_ < DK1) ? K1 + kv_ * ldk1 + col_ : K2 + kv_ * ldk2 + (col_ - DK1); kreg[i_] = *(const u32x4*)src_; } } \
    _Pragma("unroll") for (int i_ = 0; i_ < NVL; ++i_) { const int c_ = tid + 512 * i_; const int row_ = c_ / VCH, ch_ = c_ % VCH; vreg[i_] = *(const u32x4*)(V + (size_t)(64 * (t) + row_) * ldv + 8 * ch_); } } while (0)
#define ATT_STORE(buf, kreg, vreg) do { LAS unsigned char* kb_ = lds + (buf) * BUF; LAS unsigned char* vb_ = kb_ + KBUF; \
    _Pragma("unroll") for (int i_ = 0; i_ < NKL; ++i_) { const int c_ = tid + 512 * i_; if (c_ < 64 * KCH) { const int row_ = c_ / KCH, col_ = 8 * (c_ % KCH); *(LAS u32x4*)(kb_ + row_ * KROW + col_ * 2) = kreg[i_]; } } \
    _Pragma("unroll") for (int i_ = 0; i_ < NVL; ++i_) { const int c_ = tid + 512 * i_; const int row_ = c_ / VCH, ch_ = c_ % VCH; const u32x4 v_ = vreg[i_]; LAS unsigned char* p_ = vb_ + (8 * ch_) * VROW + row_ * 2; \
        *(LAS bf16_t*)(p_) = (bf16_t)(v_.x & 0xffff); *(LAS bf16_t*)(p_ + VROW) = (bf16_t)(v_.x >> 16); *(LAS bf16_t*)(p_ + 2 * VROW) = (bf16_t)(v_.y & 0xffff); *(LAS bf16_t*)(p_ + 3 * VROW) = (bf16_t)(v_.y >> 16); \
        *(LAS bf16_t*)(p_ + 4 * VROW) = (bf16_t)(v_.z & 0xffff); *(LAS bf16_t*)(p_ + 5 * VROW) = (bf16_t)(v_.z >> 16); *(LAS bf16_t*)(p_ + 6 * VROW) = (bf16_t)(v_.w & 0xffff); *(LAS bf16_t*)(p_ + 7 * VROW) = (bf16_t)(v_.w >> 16); } } while (0)
#define ATT_BAR() asm volatile("s_waitcnt lgkmcnt(0)\n\ts_barrier" ::: "memory")
    ATT_LOAD(0, kA, vA); ATT_STORE(0, kA, vA); ATT_LOAD(1, kA, vA); ATT_BAR();
    const int qg = q0 + 32 * w + r;
    bool first = true;
    for (int t2 = 0; t2 < nt; t2 += 2) {
#pragma unroll
      for (int u = 0; u < 2; ++u) {
        const int t = t2 + u, buf = u;
        if (u == 0) { if (t + 2 < nt) ATT_LOAD(t + 2, kB, vB); } else { if (t + 2 < nt) ATT_LOAD(t + 2, kA, vA); }
        const bool active = !CAUSAL || (64 * t <= q0 + 32 * w + 31);
        if (active) {
            LAS unsigned char* kb = lds + buf * BUF; LAS unsigned char* vb = kb + KBUF;
            f32x16 s0 = negm, s1 = negm;
            bf16x8 kf[2 * NS];
#pragma unroll
            for (int s = 0; s < NS; ++s) { kf[2 * s] = *(const LAS bf16x8*)(kb + r * KROW + (16 * s + 8 * h) * 2); kf[2 * s + 1] = *(const LAS bf16x8*)(kb + (32 + r) * KROW + (16 * s + 8 * h) * 2); }
            __builtin_amdgcn_sched_barrier(0);
#pragma unroll
            for (int s = 0; s < NS; ++s) { s0 = MFMA32(kf[2 * s], qf[s], s0); s1 = MFMA32(kf[2 * s + 1], qf[s], s1); }
            u32x2 vlo[NDB * 4], vhi[NDB * 4];
#pragma unroll
            for (int db = 0; db < NDB; ++db)
#pragma unroll
                for (int ks = 0; ks < 4; ++ks) { const LAS unsigned char* vp = vb + (32 * db + r) * VROW + (16 * ks + 4 * h) * 2; vlo[db * 4 + ks] = *(const LAS u32x2*)vp; vhi[db * 4 + ks] = *(const LAS u32x2*)(vp + 16); }
            __builtin_amdgcn_sched_barrier(0);
            if (CAUSAL && (64 * t + 63 > q0 + 32 * w)) {
#pragma unroll
                for (int i = 0; i < 16; ++i) { const int kv = 64 * t + crow(i, h); if (kv > qg) s0[i] = -1e30f; if (kv + 32 > qg) s1[i] = -1e30f; } }
            float mx = fmaxf(fmaxf(s0[0], s1[0]), s0[1]);
#pragma unroll
            for (int i = 2; i < 16; i += 2) mx = fmaxf(fmaxf(mx, s0[i]), s0[i + 1]);
#pragma unroll
            for (int i = 1; i < 16; i += 2) mx = fmaxf(fmaxf(mx, s1[i]), s1[(i + 1) & 15]);
            { const auto rr = __builtin_amdgcn_permlane32_swap(__float_as_uint(mx), __float_as_uint(mx), false, false); mx = fmaxf(__uint_as_float(rr[0]), __uint_as_float(rr[1])); }
            if (first || __any(mx > 8.0f)) {
                const float dl = first ? mx : fmaxf(mx, 0.f); first = false; mref += dl;
                const float alpha = __builtin_amdgcn_exp2f(-dl); lrun *= alpha;
#pragma unroll
                for (int i = 0; i < 16; ++i) { s0[i] -= dl; s1[i] -= dl; negm[i] = -mref; }
#pragma unroll
                for (int db = 0; db < NDB; ++db)
#pragma unroll
                    for (int i = 0; i < 16; ++i) o[db][i] *= alpha;
            }
            float ps = 0.f;
#pragma unroll
            for (int i = 0; i < 16; ++i) { s0[i] = __builtin_amdgcn_exp2f(s0[i]); s1[i] = __builtin_amdgcn_exp2f(s1[i]); ps += s0[i] + s1[i]; }
            lrun += ps;
            bf16x8 pf[4];
#pragma unroll
            for (int s = 0; s < 2; ++s) { u32x4 a, b;
                a.x = cvtpk(s0[8 * s], s0[8 * s + 1]); a.y = cvtpk(s0[8 * s + 2], s0[8 * s + 3]); a.z = cvtpk(s0[8 * s + 4], s0[8 * s + 5]); a.w = cvtpk(s0[8 * s + 6], s0[8 * s + 7]);
                b.x = cvtpk(s1[8 * s], s1[8 * s + 1]); b.y = cvtpk(s1[8 * s + 2], s1[8 * s + 3]); b.z = cvtpk(s1[8 * s + 4], s1[8 * s + 5]); b.w = cvtpk(s1[8 * s + 6], s1[8 * s + 7]);
                pf[s] = __builtin_bit_cast(bf16x8, a); pf[2 + s] = __builtin_bit_cast(bf16x8, b); }
#pragma unroll
            for (int db = 0; db < NDB; ++db)
#pragma unroll
                for (int ks = 0; ks < 4; ++ks) {
                    u32x4 vv; vv.x = vlo[db * 4 + ks].x; vv.y = vlo[db * 4 + ks].y; vv.z = vhi[db * 4 + ks].x; vv.w = vhi[db * 4 + ks].y;
                    o[db] = MFMA32(__builtin_bit_cast(bf16x8, vv), pf[ks], o[db]); }
        }
        if (u == 0) ATT_STORE(1, kA, vA); else { if (t + 1 < nt) ATT_STORE(0, kB, vB); }
        ATT_BAR();
      }
    }
#undef ATT_LOAD
#undef ATT_STORE
#undef ATT_BAR
    const float lt = lrun + __shfl_xor(lrun, 32), inv = 1.0f / lt;
#pragma unroll
    for (int db = 0; db < NDB; ++db)
#pragma unroll
        for (int g4 = 0; g4 < 4; ++g4) { bf16_t* zp = ZO + (size_t)qg * ldo + 32 * db + 8 * g4 + 4 * h; const u32x2 z = *(const u32x2*)zp;
            u32x2 wv; wv.x = cvtpk(o[db][4 * g4] * inv * bflo(z.x), o[db][4 * g4 + 1] * inv * bfhi(z.x)); wv.y = cvtpk(o[db][4 * g4 + 2] * inv * bflo(z.y), o[db][4 * g4 + 3] * inv * bfhi(z.y));
            *(u32x2*)zp = wv; }
}

template <bool OUT>
__device__ __forceinline__ void ssm_task(LAS unsigned char* wl, int task, bf16_t* PA, const unsigned char* tab, const float* dskip, f32x2* SS) {
    int lane = threadIdx.x & 63; asm volatile("" : "+v"(lane));
    const int r = lane & 31, h = lane >> 5, row16 = lane & 15, quad = lane >> 4;
    const int chunk = task & 7, g = (task >> 3) & 31, b = task >> 8;
    const bf16_t* BBt = (const bf16_t*)tab; const bf16_t* CMt = (const bf16_t*)(tab + 128 * 1024);
    const f32x2* LAM = (const f32x2*)(tab + 256 * 1024); const f32x2* LAML = (const f32x2*)(tab + 272 * 1024);
    bf16x8 bbf[4], cmf[4];
#pragma unroll
    for (int nb = 0; nb < 4; ++nb) bbf[nb] = *(const bf16x8*)(BBt + ((size_t)(g * 128 + 32 * nb + r)) * 16 + 8 * h);
    if (OUT) {
#pragma unroll
        for (int ks = 0; ks < 4; ++ks) cmf[ks] = *(const bf16x8*)(CMt + ((size_t)(g * 16 + row16)) * 128 + 32 * ks + 8 * quad);
    }
    const f32x2 lam = LAM[g * 64 + lane];
    const float dsk = OUT ? dskip[16 * g + row16] : 0.f;
    float hr = 0.f, hi = 0.f;
    f32x2* ssb = SS + ((size_t)(b * 32 + g) * SSM_NC) * 64 + lane;
    if (OUT) { const f32x2 lL = LAML[g * 64 + lane];
        for (int k = 0; k < chunk; ++k) { const f32x2 s = ssb[(size_t)k * 64]; const float nr = lL.x * hr - lL.y * hi + s.x, ni = lL.x * hi + lL.y * hr + s.y; hr = nr; hi = ni; } }
    LAS float* W = (LAS float*)wl;
    const size_t tokc = (size_t)b * SEQ + chunk * SSM_L;
    bf16x8 uf = *(const bf16x8*)(PA + (tokc + r) * PAW + C_U + 16 * g + 8 * h);
    for (int sub = 0; sub < SSM_L / 32; ++sub) {
        const size_t tok0 = tokc + sub * 32;
        bf16x8 ufn = uf;
        if (sub + 1 < SSM_L / 32) ufn = *(const bf16x8*)(PA + (tok0 + 32 + r) * PAW + C_U + 16 * g + 8 * h);
        bf16_t uv[2][4];
        if (OUT) {
#pragma unroll
            for (int mb = 0; mb < 2; ++mb)
#pragma unroll
                for (int j = 0; j < 4; ++j) uv[mb][j] = PA[(tok0 + 16 * mb + 4 * quad + j) * PAW + C_U + 16 * g + row16];
        }
#pragma unroll
        for (int nb = 0; nb < 4; ++nb) { f32x16 z;
#pragma unroll
            for (int i = 0; i < 16; ++i) z[i] = 0.f;
            const f32x16 bu = MFMA32(uf, bbf[nb], z);
#pragma unroll
            for (int i = 0; i < 16; ++i) W[crow(i, h) * 132 + 32 * nb + r] = bu[i]; }
        LDS_WAIT();
        f32x2 bq[32];
#pragma unroll
        for (int t = 0; t < 32; ++t) bq[t] = *(const LAS f32x2*)(W + t * 132 + 2 * lane);
        LDS_WAIT();
#pragma unroll
        for (int t = 0; t < 32; ++t) { const float nr = lam.x * hr - lam.y * hi + bq[t].x, ni = lam.x * hi + lam.y * hr + bq[t].y; hr = nr; hi = ni;
            if (OUT) *(LAS unsigned*)((LAS unsigned char*)W + t * 528 + 4 * lane) = cvtpk(hr, hi); }
        if (OUT) {
            LDS_WAIT();
#pragma unroll
            for (int mb = 0; mb < 2; ++mb) { f32x4 acc = (f32x4){0.f, 0.f, 0.f, 0.f};
#pragma unroll
                for (int ks = 0; ks < 4; ++ks) { const bf16x8 af = *(const LAS bf16x8*)((LAS unsigned char*)W + (16 * mb + row16) * 528 + (32 * ks + 8 * quad) * 2);
                    acc = __builtin_amdgcn_mfma_f32_16x16x32_bf16(af, cmf[ks], acc, 0, 0, 0); }
#pragma unroll
                for (int j = 0; j < 4; ++j) { bf16_t* p = PA + (tok0 + 16 * mb + 4 * quad + j) * PAW + C_U + 16 * g + row16; const float y = acc[j] + dsk * bf2f(uv[mb][j]); *p = f2bf(gelu_tanh(y)); } }
            LDS_WAIT();
        }
        uf = ufn;
    }
    if (!OUT) ssb[(size_t)chunk * 64] = (f32x2){hr, hi};
}

enum { MAT_PLAIN = 0, MAT_WIN = 1, MAT_WGLU = 2, MAT_WUQ = 3 };
__device__ __forceinline__ void cvt_item(const float* W, int ldw, int K, bf16_t* WT, int mat, int item, int nblk, LAS float* scr, int lane, const float* kscale) {
    const int kb = item / nblk, nb = item % nblk, k0 = 64 * kb, n0 = 32 * nb, n = n0 + (lane & 31);
    int src = n; float sc = 1.f;
    if (mat == MAT_WIN) {
        if (n < 1408) src = n; else if (n < 1440) { const int j = n - 1408; src = 1408 + ((j & 1) ? 16 + (j >> 1) : (j >> 1)); } else if (n < 1536) src = -1; else src = n - 96;
        if (n >= C_QX && n < C_ZX) sc = QMEM_SCALE;
    } else if (mat == MAT_WGLU) { const int pn = n >> 8, bj = (n >> 7) & 1, i = n & 127; src = bj * 512 + 128 * pn + i; }
    else if (mat == MAT_WUQ) { const int hd = n / 96; int d = n % 96; if (d >= 64) { const int j = d - 64; d = 64 + ((j & 1) ? 16 + (j >> 1) : (j >> 1)); } src = 96 * hd + d; sc = MLA_SCALE; }
#pragma unroll 8
    for (int i = 0; i < 32; ++i) { const int kk = 2 * i + (lane >> 5); float v = (src >= 0) ? W[(size_t)(k0 + kk) * ldw + src] : 0.f; v *= sc; if (kscale) v *= kscale[k0 + kk]; scr[kk * 33 + (lane & 31)] = v; }
    LDS_WAIT();
    const int c = lane & 7;
#pragma unroll
    for (int j = 0; j < 4; ++j) { const int nn = (lane >> 3) + 8 * j; const LAS float* s = scr + (8 * c) * 33 + nn;
        u32x4 o; o.x = cvtpk(s[0 * 33], s[1 * 33]); o.y = cvtpk(s[2 * 33], s[3 * 33]); o.z = cvtpk(s[4 * 33], s[5 * 33]); o.w = cvtpk(s[6 * 33], s[7 * 33]);
        *(u32x4*)(WT + (size_t)(n0 + nn) * K + k0 + 8 * c) = o; }
    LDS_WAIT();
}

struct Args { const void* in[26]; float* out; unsigned char* ws; int ph_lo, ph_hi; };

__device__ __forceinline__ void convert_layer(const Args& a, int l, LAS float* scr, int gw, int NGW, int lane) {
    unsigned char* wb = a.ws + WS_WB;
    constexpr int I_WIN = 16 * 192, I_GLU = 8 * 32, I_UQ = 4 * 24, I_UKV = 2 * 32, I_MEM = 16 * 32, I_P = 8 * 32, I_OUT = 16 * 32;
    constexpr int NIT = I_WIN + I_GLU + I_UQ + I_UKV + I_MEM + 3 * I_P + I_OUT;
    for (int it = gw; it < NIT; it += NGW) {
        int r = it;
        if (r < I_WIN) { cvt_item((const float*)a.in[3] + (size_t)l * DM * DIN, DIN, 1024, (bf16_t*)(wb + WB_WIN), MAT_WIN, r, 192, scr, lane, nullptr); continue; } r -= I_WIN;
        if (r < I_GLU) { cvt_item((const float*)a.in[13] + (size_t)l * 512 * 1024, 1024, 512, (bf16_t*)(wb + WB_WGLU), MAT_WGLU, r, 32, scr, lane, nullptr); continue; } r -= I_GLU;
        if (r < I_UQ) { cvt_item((const float*)a.in[16] + (size_t)l * 256 * 768, 768, 256, (bf16_t*)(wb + WB_WUQ), MAT_WUQ, r, 24, scr, lane, (const float*)a.in[15] + l * 256); continue; } r -= I_UQ;
        if (r < I_UKV) { cvt_item((const float*)a.in[18] + (size_t)l * 128 * 1024, 1024, 128, (bf16_t*)(wb + WB_WUKV), MAT_PLAIN, r, 32, scr, lane, (const float*)a.in[17] + l * 128); continue; } r -= I_UKV;
        if (r < I_MEM) { cvt_item((const float*)a.in[19] + (size_t)l * 1024 * 1024, 1024, 1024, (bf16_t*)(wb + WB_WMEM), MAT_PLAIN, r, 32, scr, lane, nullptr); continue; } r -= I_MEM;
        if (r < 3 * I_P) { const int which = r / I_P; cvt_item((const float*)a.in[20 + which] + (size_t)l * 512 * 1024, 1024, 512, (bf16_t*)(wb + WB_WP) + (size_t)which * 1024 * 512, MAT_PLAIN, r % I_P, 32, scr, lane, nullptr); continue; } r -= 3 * I_P;
        cvt_item((const float*)a.in[23] + (size_t)l * 1024 * 1024, 1024, 1024, (bf16_t*)(wb + WB_WOUT), MAT_PLAIN, r, 32, scr, lane, nullptr);
    }
}


typedef unsigned gu32_plain;
#define XB_TMO      128
#define XB_XCNT(j)  (256  + 64 * (j))
#define XB_XSUB(j)  (1280 + 64 * (j))
#define XB_XGEN(j)  (2304 + 64 * (j))
#define XB_TOP      3328
#define XB_TOPGEN   3392
#define XCD_BAR_WORDS 3456
#define XB_SPIN_CAP (1u << 18)

__device__ __forceinline__ unsigned xb_ld(unsigned* p)              { return __hip_atomic_load(p, __ATOMIC_RELAXED, __HIP_MEMORY_SCOPE_AGENT); }
__device__ __forceinline__ unsigned xb_add(unsigned* p, unsigned v) { return __hip_atomic_fetch_add(p, v, __ATOMIC_RELAXED, __HIP_MEMORY_SCOPE_AGENT); }
__device__ __forceinline__ unsigned xb_xcc_id() { return (unsigned)__builtin_amdgcn_s_getreg((3 << 11) | 20) & 0xFu; }
#define XB_SPIN(cond, bar) do { unsigned _sp = 0; while (cond) { __builtin_amdgcn_s_sleep(1); \
    if ((++_sp & 255u) == 0u) { if (xb_ld(&(bar)[XB_TMO])) break; if (_sp > XB_SPIN_CAP) { atomicAdd(&(bar)[XB_TMO], 1u); break; } } } } while (0)

struct XcdBarrier {
    unsigned* bar; unsigned x;
    volatile LAS unsigned* st;
};

__device__ __forceinline__ XcdBarrier xcd_barrier_post(unsigned* bar, volatile LAS unsigned* st) {
    XcdBarrier b; b.bar = bar; b.x = xb_xcc_id(); b.st = st;
    if (threadIdx.x == 0) (void)xb_add(&bar[XB_XCNT(b.x)], 1u);
    return b;
}
__device__ __forceinline__ void xcd_barrier_complete(unsigned* bar, unsigned x, unsigned& nloc, unsigned& nx) {
    const unsigned G = gridDim.x * gridDim.y * gridDim.z;
    unsigned sum, cnt, mine, sp = 0u;
    for (;;) {
        sum = 0u; cnt = 0u; mine = 0u;
#pragma unroll
        for (unsigned j = 0; j < 16; ++j) { const unsigned c = xb_ld(&bar[XB_XCNT(j)]); sum += c; cnt += (c > 0u) ? 1u : 0u; mine = (j == x) ? c : mine; }
        if (sum == G) break;
        __builtin_amdgcn_s_sleep(1);
        if ((++sp & 255u) == 0u) { if (xb_ld(&bar[XB_TMO])) break; if (sp > XB_SPIN_CAP) { atomicAdd(&bar[XB_TMO], 1u); break; } }
    }
    nloc = mine > 0u ? mine : 1u; nx = cnt > 0u ? cnt : 1u;
}

__device__ __forceinline__ void xcd_barrier(const XcdBarrier& b) {
    asm volatile("s_waitcnt vmcnt(0)" ::: "memory");
    __syncthreads();
    if (threadIdx.x == 0) {
        unsigned* bar = b.bar;
        __builtin_amdgcn_s_waitcnt(0);
        unsigned nloc = b.st[0], nx = b.st[1];
        if (nloc == 0u) { xcd_barrier_complete(bar, b.x, nloc, nx); b.st[0] = nloc; b.st[1] = nx; }
        const unsigned old = xb_add(&bar[XB_XSUB(b.x)], 1u);
        const unsigned gen = old / nloc;
        if (old + 1u == (gen + 1u) * nloc) {
            __builtin_amdgcn_fence(__ATOMIC_RELEASE, "agent");
            asm volatile("s_waitcnt vmcnt(0)" ::: "memory");
            const unsigned og = xb_add(&bar[XB_TOP], 1u);
            const unsigned tg = og / nx;
            if (og + 1u == (tg + 1u) * nx) xb_add(&bar[XB_TOPGEN], 1u);
            else XB_SPIN(xb_ld(&bar[XB_TOPGEN]) == tg, bar);
            __builtin_amdgcn_fence(__ATOMIC_ACQUIRE, "agent");
            xb_add(&bar[XB_XGEN(b.x)], 1u);
            asm volatile("s_waitcnt vmcnt(0)" ::: "memory");
        } else {
            XB_SPIN(xb_ld(&bar[XB_XGEN(b.x)]) == gen, bar);
            __builtin_amdgcn_fence(__ATOMIC_ACQUIRE, "agent");
            asm volatile("s_waitcnt vmcnt(0)" ::: "memory");
        }
    }
    __syncthreads();
}
constexpr int NWAVES = 8, LDS_BYTES = 147456, LDS_BARST = 147392;
constexpr size_t WS_CTL = 0, CTL_BYTES = 16384;
constexpr int N_PHASES = 1 + 7 * DEPTH;

__global__ void __launch_bounds__(NWAVES * 64, 2) mk_fwd(Args args) {
    extern __shared__ __attribute__((aligned(16))) unsigned char lds_raw[];
    LAS unsigned char* lds = (LAS unsigned char*)lds_raw;
    const int G = gridDim.x, cu = blockIdx.x, NGW = G * NWAVES;
    unsigned char* ws = args.ws;
#if !MK_MULTI
    if (threadIdx.x < 2) ((LAS unsigned*)(lds + LDS_BARST))[threadIdx.x] = 0u;
    __syncthreads();
    const XcdBarrier gbar = xcd_barrier_post((unsigned*)(ws + WS_CTL), (volatile LAS unsigned*)(lds + LDS_BARST));
#endif
    bf16_t* XB = (bf16_t*)(ws + WS_XB); bf16_t* PA = (bf16_t*)(ws + WS_PA); bf16_t* RG = (bf16_t*)(ws + WS_R);
    bf16_t* QB = (bf16_t*)(ws + WS_R + R_Q); bf16_t* KN = (bf16_t*)(ws + WS_R + R_KN); bf16_t* KR = (bf16_t*)(ws + WS_R + R_KR); bf16_t* VB = (bf16_t*)(ws + WS_R + R_V);
    bf16_t* MEMB = (bf16_t*)(ws + WS_MEMB); bf16_t* MEMKV = (bf16_t*)(ws + WS_MEMKV);
    float* SQP = (float*)(ws + WS_SQP); float* SKP = (float*)(ws + WS_SKP); float* ROPE = (float*)(ws + WS_ROPE); f32x2* SS = (f32x2*)(ws + WS_SS);
    unsigned char* wb = ws + WS_WB;
    bf16_t* DUMMY = (bf16_t*)(ws + WS_R + 120 * MiB);
    const float* xin = (const float*)args.in[0];
    float* out = args.out;

    if (args.ph_lo == 0 && (PHMASK & 1)) {
        int tid = threadIdx.x; asm volatile("" : "+v"(tid));
        const int lane = tid & 63, wave = __builtin_amdgcn_readfirstlane(tid >> 6), gw = cu * NWAVES + wave;

            convert_layer(args, 0, (LAS float*)(lds + wave * 16384), gw, NGW, lane);
            { const size_t n4 = (size_t)MTOK * DM / 4;
              for (size_t i = (size_t)cu * 512 + tid; i < n4; i += (size_t)G * 512) { const f32x4 v = ((const f32x4*)xin)[i]; u32x2 w; w.x = cvtpk(v[0], v[1]); w.y = cvtpk(v[2], v[3]); ((u32x2*)XB)[i] = w; } }
            { const size_t n4 = (size_t)NB * MEML * DM / 4; const float* mem = (const float*)args.in[1];
              for (size_t i = (size_t)cu * 512 + tid; i < n4; i += (size_t)G * 512) { const f32x4 v = ((const f32x4*)mem)[i]; u32x2 w; w.x = cvtpk(v[0], v[1]); w.y = cvtpk(v[2], v[3]); ((u32x2*)MEMB)[i] = w; } }
            { const int* pos = (const int*)args.in[2];
              for (int i = cu * 512 + tid; i < MTOK * 16; i += G * 512) { const int m = i >> 4, f = i & 15; const double invf = exp(-(double)f * (9.210340371976184 / 16.0)); double c, s; cossin_d((double)pos[m] * invf, c, s);
                  ROPE[(size_t)i * 2] = (float)c; ROPE[(size_t)i * 2 + 1] = (float)s; } }
            {
              for (int i = cu * 512 + tid; i < DEPTH * 32 * 64; i += G * 512) { const int p = i & 63, g = (i >> 6) & 31, l = i >> 11;
                  unsigned char* tab = ws + WS_TAB + (size_t)l * TAB_L; bf16_t* BBt = (bf16_t*)tab; bf16_t* CMt = (bf16_t*)(tab + 128 * 1024); f32x2* LAM = (f32x2*)(tab + 256 * 1024); f32x2* LAML = (f32x2*)(tab + 272 * 1024);
                  const double dt = exp((double)((const float*)args.in[7])[l * 32 + g]); const double lr = ((const float*)args.in[5])[(l * 32 + g) * 64 + p], li = ((const float*)args.in[6])[(l * 32 + g) * 64 + p];
                  const double mag = exp(lr * dt); double c, s; cossin_d(li * dt, c, s); const double lbr = mag * c, lbi = mag * s, nr = lbr - 1.0, ni = lbi, den = lr * lr + li * li;
                  const double fre = (nr * lr + ni * li) / den, fim = (ni * lr - nr * li) / den;
                  const float* bre = (const float*)args.in[8] + ((size_t)(l * 32 + g) * 64 + p) * 16; const float* bim = (const float*)args.in[9] + ((size_t)(l * 32 + g) * 64 + p) * 16;
                  for (int cc = 0; cc < 16; ++cc) { const double br = bre[cc], bi = bim[cc]; BBt[((size_t)g * 128 + 2 * p) * 16 + cc] = f2bf((float)(fre * br - fim * bi)); BBt[((size_t)g * 128 + 2 * p + 1) * 16 + cc] = f2bf((float)(fre * bi + fim * br)); }
                  const float* cre = (const float*)args.in[10] + (size_t)(l * 32 + g) * 16 * 64; const float* cim = (const float*)args.in[11] + (size_t)(l * 32 + g) * 16 * 64;
                  for (int cc = 0; cc < 16; ++cc) { CMt[((size_t)g * 16 + cc) * 128 + 2 * p] = f2bf(cre[cc * 64 + p]); CMt[((size_t)g * 16 + cc) * 128 + 2 * p + 1] = f2bf(-cim[cc * 64 + p]); }
                  LAM[g * 64 + p] = (f32x2){(float)lbr, (float)lbi};
                  const double magL = exp(lr * dt * (double)SSM_L); double cL, sL; cossin_d(li * dt * (double)SSM_L, cL, sL); LAML[g * 64 + p] = (f32x2){(float)(magL * cL), (float)(magL * sL)}; } }
#if !MK_MULTI
        if (args.ph_hi > 1) { __threadfence(); cg::this_grid().sync(); }
#endif
    }
    for (int ph = (args.ph_lo > 1 ? args.ph_lo : 1); ph < args.ph_hi; ++ph) {
        int tid = threadIdx.x; asm volatile("" : "+v"(tid));
        const int lane = tid & 63, wave = __builtin_amdgcn_readfirstlane(tid >> 6), gw = cu * NWAVES + wave;
        {
            const int l = (ph - 1) / 7, k = (ph - 1) % 7;
            const unsigned char* tab = ws + WS_TAB + (size_t)l * TAB_L;
            if (k == 0 && (PHMASK & 2)) {
#pragma unroll 1
                for (int rep = 0; rep < (PROBE_JOB == 1 ? 2 : 1); ++rep)
                { pg8::StaticOrder S; S.init(MTOK, PAW, G, cu, XB, DM, wb + WB_WIN, DM); pg8::EpiIn E{PA, SQP, SKP, KR, ROPE}; pg8::gemm_phase(lds, DM, DM, S, E); }
            } else if (k == 1 && (PHMASK & 4)) {
                { pg8::StaticOrder S; S.init(NB * MEML, 1024, G, (G == 256) ? (cu >= 128 ? cu - 128 : 1 << 20) : cu, MEMB, DM, wb + WB_WMEM, DM); pg8::EpiPlain E{MEMKV, 1024}; pg8::gemm_phase(lds, DM, DM, S, E); }
                if (K1MASK & 1) { pg8::StaticOrder S; S.init(MTOK, 768, G, cu, PA + C_CQ, PAW, wb + WB_WUQ, 256); pg8::EpiQ E{QB, SQP, ROPE}; pg8::gemm_phase(lds, 256, PAW, S, E); }
                if (K1MASK & 2) { pg8::StaticOrder S; S.init(MTOK, 1024, G, cu, PA + C_CKV, PAW, wb + WB_WUKV, 128); pg8::EpiKV E{KN, VB, SKP}; pg8::gemm_phase(lds, 128, PAW, S, E); }
#pragma unroll 1
                for (int rep = 0; rep < (PROBE_JOB == 3 ? 2 : 1); ++rep)
                if (K1MASK & 4) for (int task = gw; task < NB * 32 * SSM_NC; task += NGW) ssm_task<false>(lds + wave * 16896, task, PA, tab, (const float*)args.in[12] + l * 512, SS);
                __syncthreads();
            } else if (k == 2 && (PHMASK & 8)) {
#pragma unroll 1
                for (int rep = 0; rep < (PROBE_JOB == 4 ? 2 : 1); ++rep)
                if (K1MASK & 8) for (int ui = cu; ui < NB * 4 * 16; ui += G) { const bool dummy = (PROBE_JOB == 4 && rep == 0); const int b = ui >> 6, hh = (ui >> 4) & 3, qb = ui & 15; const size_t t0 = (size_t)b * SEQ;
#pragma unroll 1
                    for (int e = 0; e < 2; ++e)
                    attn_unit<128, 128, 64, false>(lds, PA + t0 * PAW + C_QX + 128 * hh, PAW, MEMKV + (size_t)b * MEML * 1024 + 128 * hh, 1024, nullptr, 0,
                                                    MEMKV + (size_t)b * MEML * 1024 + 512 + 128 * hh + 64 * e, 1024, dummy ? DUMMY + t0 * 64 : PA + t0 * PAW + C_ZX + 128 * hh + 64 * e, dummy ? 64 : PAW, 256 * qb, MEML / 64); }
#pragma unroll 1
                for (int rep = 0; rep < (PROBE_JOB == 2 ? 2 : 1); ++rep)
                for (int pi = cu; pi < NB * 8 * 8; pi += G) { const bool dummy = (PROBE_JOB == 2 && rep == 0); const int bh = pi >> 3, j = pi & 7, b = bh >> 3, hh = bh & 7; const size_t t0 = (size_t)b * SEQ;
#pragma unroll 1
                    for (int e = 0; e < 2; ++e) { const int qb = e ? 15 - j : j;
                        attn_unit<96, 64, 64, true>(lds, QB + t0 * 768 + 96 * hh, 768, KN + t0 * 512 + 64 * hh, 512, KR + t0 * 32, 32, VB + t0 * 512 + 64 * hh, 512, dummy ? DUMMY + t0 * 64 : PA + t0 * PAW + C_ZM + 64 * hh, dummy ? 64 : PAW, 256 * qb, 4 * (qb + 1)); } }
                for (int task = gw; task < NB * 32 * SSM_NC; task += NGW) ssm_task<true>(lds + wave * 16896, task, PA, tab, (const float*)args.in[12] + l * 512, SS);
                __syncthreads();
            } else if (k == 3 && (PHMASK & 16)) {
#pragma unroll 1
                for (int rep = 0; rep < (PROBE_JOB == 5 ? 2 : 1); ++rep)
                { pg8::StaticOrder S; S.init(MTOK, PAW, G, cu, XB, DM, wb + WB_WIN + (size_t)PAW * DM * 2, DM); pg8::EpiGate E{RG, (const float*)args.in[4] + l * 3072}; pg8::gemm_phase(lds, DM, DM, S, E); }
                { pg8::StaticOrder S; S.init(MTOK, 1024, G, cu, PA + C_U, PAW, wb + WB_WGLU, 512); pg8::EpiGlu E{PA, (const float*)args.in[14] + l * 1024}; pg8::gemm_phase(lds, 512, PAW, S, E); }
            } else if (k == 4 && (PHMASK & 32)) {
#pragma unroll 1
                for (int rep = 0; rep < (PROBE_JOB == 9 ? 2 : 1); ++rep) { const bool dummy = (PROBE_JOB == 9 && rep == 0);
                pg8::MergeOrder S{G, cu, (const char*)PA, (const char*)(wb + WB_WP)}; pg8::EpiMerge E{RG, dummy ? XB : RG, dummy ? DM : PAW}; pg8::gemm_phase(lds, 512, PAW, S, E); }
            } else if (k == 5 && (PHMASK & 64)) {
#pragma unroll 1
                for (int rep = 0; rep < (PROBE_JOB == 8 ? 2 : 1); ++rep) { const bool dummy = (PROBE_JOB == 8 && rep == 0);
                pg8::StaticOrder S; S.init(MTOK, DM, G, cu, RG, PAW, wb + WB_WOUT, DM); pg8::EpiOut E{l == 0 ? xin : (const float*)out, dummy ? (float*)PA : out}; pg8::gemm_phase(lds, DM, PAW, S, E); }
            } else if (k == 6 && (PHMASK & 128)) {
                const float* lg = (const float*)args.in[24] + l * DM; const float* lb = (const float*)args.in[25] + l * DM;
                f32x4 gv[4], bv[4];
#pragma unroll
                for (int j = 0; j < 4; ++j) { gv[j] = ((const f32x4*)lg)[lane + 64 * j]; bv[j] = ((const f32x4*)lb)[lane + 64 * j]; }
#pragma unroll 1
                for (int rep = 0; rep < (PROBE_JOB == 7 ? 2 : 1); ++rep) { const bool dummy = (PROBE_JOB == 7 && rep == 0);
                for (int m = gw; m < MTOK; m += NGW) { f32x4* xr = (f32x4*)(out + (size_t)m * DM) + lane; f32x4* xw = dummy ? (f32x4*)((float*)PA + (size_t)m * DM) + lane : xr; f32x4 v[4]; float s = 0.f;
#pragma unroll
                    for (int j = 0; j < 4; ++j) { v[j] = xr[64 * j]; s += (v[j][0] + v[j][1]) + (v[j][2] + v[j][3]); }
                    const float mean = wave_sum(s) * (1.f / DM); float s2 = 0.f;
#pragma unroll
                    for (int j = 0; j < 4; ++j) { v[j] = v[j] - mean; s2 += (v[j][0] * v[j][0] + v[j][1] * v[j][1]) + (v[j][2] * v[j][2] + v[j][3] * v[j][3]); }
                    const float rstd = 1.f / sqrtf(wave_sum(s2) * (1.f / DM) + LN_EPS);
                    u32x2* xb = (u32x2*)((dummy ? RG : XB) + (size_t)m * DM) + lane;
#pragma unroll
                    for (int j = 0; j < 4; ++j) { const f32x4 y = v[j] * rstd * gv[j] + bv[j]; xw[64 * j] = y; u32x2 w; w.x = cvtpk(y[0], y[1]); w.y = cvtpk(y[2], y[3]); xb[64 * j] = w; } } }
                if (l + 1 < DEPTH) convert_layer(args, l + 1, (LAS float*)(lds + wave * 16384), gw, NGW, lane);
            }
        }
#if !MK_MULTI
        if (ph + 1 < args.ph_hi) { xcd_barrier(gbar); if (PROBE_JOB == 6) { xcd_barrier(gbar); xcd_barrier(gbar); } }
#endif
    }
}

extern "C" void kernel_launch(void* const* d_in, const int* in_sizes, int n_in, void* d_out, int out_size, void* d_ws, size_t ws_size, hipStream_t stream) {
    static int grid = 0;
    if (grid == 0) {
        if (n_in != 26 || out_size != MTOK * DM || ws_size < WS_END) { fprintf(stderr, "kernel_launch: unexpected sizes n_in %d out %d ws %zu\n", n_in, out_size, ws_size); grid = -1; return; }
        int dev = 0, cus = 0, per_cu = 0;
        hipGetDevice(&dev); hipDeviceGetAttribute(&cus, hipDeviceAttributeMultiprocessorCount, dev);
        hipFuncSetAttribute((const void*)mk_fwd, hipFuncAttributeMaxDynamicSharedMemorySize, LDS_BYTES);
        hipOccupancyMaxActiveBlocksPerMultiprocessor(&per_cu, (const void*)mk_fwd, NWAVES * 64, LDS_BYTES);
        if (per_cu < 1) { fprintf(stderr, "kernel_launch: occupancy query says %d blocks/CU\n", per_cu); per_cu = 1; }
        (void)hipGetLastError();
        grid = cus * 1;
    }
    if (grid < 0) return;
    Args a{};
    for (int i = 0; i < 26; ++i) a.in[i] = d_in[i];
    a.out = (float*)d_out; a.ws = (unsigned char*)d_ws;
#if MK_MULTI
    for (int ph = 0; ph < N_PHASES; ++ph) { a.ph_lo = ph; a.ph_hi = ph + 1; hipLaunchKernelGGL(mk_fwd, dim3(grid), dim3(NWAVES * 64), LDS_BYTES, stream, a); }
#else
    a.ph_lo = 0; a.ph_hi = N_PHASES;
    if (hipMemsetAsync((char*)d_ws + WS_CTL, 0, CTL_BYTES, stream) != hipSuccess) { fprintf(stderr, "kernel_launch: memset of barrier words failed\n"); return; }
    void* kargs[] = {&a};
    hipError_t e = hipLaunchCooperativeKernel((const void*)mk_fwd, dim3(grid), dim3(NWAVES * 64), kargs, LDS_BYTES, stream);
    if (e != hipSuccess) fprintf(stderr, "cooperative launch failed: %s (grid %d)\n", hipGetErrorString(e), grid);
#endif
}
```

```cpp
#include <hip/hip_runtime.h>
#include <hip/hip_cooperative_groups.h>
#include <cstdio>
#include <cstdint>
namespace cg = cooperative_groups;

#ifndef MK_MULTI
#define MK_MULTI 0
#endif

#ifndef PROBE_JOB
#define PROBE_JOB 0
#endif
#ifndef K1MASK
#define K1MASK 15
#endif
#ifndef PHMASK
#define PHMASK 255
#endif
#define LAS __attribute__((address_space(3)))
typedef unsigned short bf16_t;
typedef short bf16x8 __attribute__((ext_vector_type(8)));
typedef float f32x2 __attribute__((ext_vector_type(2)));
typedef float f32x4 __attribute__((ext_vector_type(4)));
typedef float f32x16 __attribute__((ext_vector_type(16)));
typedef unsigned u32x2 __attribute__((ext_vector_type(2)));
typedef unsigned u32x4 __attribute__((ext_vector_type(4)));
typedef __bf16 bf16x2_t __attribute__((ext_vector_type(2)));

constexpr int DM = 1024, NB = 8, SEQ = 4096, DEPTH = 4, MEML = 256;
constexpr int MTOK = NB * SEQ;
constexpr int DIN = 6048;
constexpr int PAW = 3072;
constexpr float LN_EPS = 1e-5f;
constexpr float ALPHA = 1.6817928305074292f;
constexpr float LOG2E = 1.4426950408889634f;
constexpr float MLA_SCALE = 0.10206207261596577f * LOG2E;
constexpr float QMEM_SCALE = 0.08838834764831845f * LOG2E;
constexpr int SSM_L = 512, SSM_NC = SEQ / SSM_L;

constexpr size_t MiB = 1u << 20;
constexpr size_t WS_TAB = 1 * MiB;
constexpr size_t TAB_L = 288 * 1024;
constexpr size_t WS_ROPE = 3 * MiB;
constexpr size_t WS_SS = 7 * MiB;
constexpr size_t WS_SQP = 8 * MiB;
constexpr size_t WS_SKP = WS_SQP + 512 * 1024;
constexpr size_t WS_MEMB = 9 * MiB;
constexpr size_t WS_MEMKV = 13 * MiB;
constexpr size_t WS_WB = 21 * MiB;
constexpr size_t WB_WIN = 0, WB_WGLU = 12 * MiB, WB_WUQ = 13 * MiB, WB_WUKV = WB_WUQ + 512 * 1024, WB_WMEM = 14 * MiB, WB_WP = 18 * MiB, WB_WOUT = 21 * MiB;
constexpr size_t WS_XB = 45 * MiB;
constexpr size_t WS_PA = 109 * MiB;
constexpr size_t WS_R = 301 * MiB;
constexpr size_t R_Q = 0, R_KN = 48 * MiB, R_KR = 80 * MiB, R_V = 82 * MiB;
constexpr size_t WS_END = 493 * MiB;

constexpr int C_U = 0, C_ZS = 512, C_CQ = 1024, C_CKV = 1280, C_KR = 1408, C_ZM = 1536, C_QX = 2048, C_ZX = 2560;

__device__ __forceinline__ unsigned cvtpk(float lo, float hi) { f32x2 v = {lo, hi}; bf16x2_t b = __builtin_convertvector(v, bf16x2_t); return __builtin_bit_cast(unsigned, b); }
__device__ __forceinline__ bf16_t f2bf(float f) { return (bf16_t)(cvtpk(f, 0.f) & 0xffffu); }
__device__ __forceinline__ float bflo(unsigned w) { return __uint_as_float(w << 16); }
__device__ __forceinline__ float bfhi(unsigned w) { return __uint_as_float(w & 0xffff0000u); }
__device__ __forceinline__ float bf2f(bf16_t b) { return __uint_as_float((unsigned)b << 16); }
__device__ __forceinline__ float sigmoidf_(float x) { return __builtin_amdgcn_rcpf(1.0f + __expf(-x)); }
__device__ __forceinline__ float siluf_(float x) { return x * sigmoidf_(x); }
__device__ __forceinline__ float gelu_tanh(float x) { const float z = 0.7978845608028654f * (x + 0.044715f * x * x * x); return x * sigmoidf_(2.0f * z); }
__device__ __forceinline__ float wave_sum(float v) {
#pragma unroll
    for (int o = 1; o < 64; o <<= 1) v += __shfl_xor(v, o);
    return v;
}
#define LDS_WAIT() asm volatile("s_waitcnt lgkmcnt(0)" ::: "memory")
__device__ __forceinline__ int crow(int i, int h) { return (i & 3) + 8 * (i >> 2) + 4 * h; }
__device__ __forceinline__ void cossin_d(double a, double& c, double& s) {
    const double q = rint(a * 0.63661977236758134308);
    const double y = a - q * 1.57079632679489661923;
    const double y2 = y * y;
    const double sp = y * (1.0 + y2 * (-1.0 / 6 + y2 * (1.0 / 120 + y2 * (-1.0 / 5040 + y2 * (1.0 / 362880 + y2 * (-1.0 / 39916800 + y2 * (1.0 / 6227020800.0)))))));
    const double cp = 1.0 + y2 * (-0.5 + y2 * (1.0 / 24 + y2 * (-1.0 / 720 + y2 * (1.0 / 40320 + y2 * (-1.0 / 3628800 + y2 * (1.0 / 479001600.0))))));
    const int qi = ((int)((long long)q)) & 3;
    c = (qi == 0) ? cp : (qi == 1) ? -sp : (qi == 2) ? -cp : sp;
    s = (qi == 0) ? sp : (qi == 1) ? cp : (qi == 2) ? -sp : -cp;
}

namespace pg8 {
constexpr int BM = 256, BK = 64, HALF = 128, HTB = HALF * BK * 2, STAGE_BYTES = 8 * HTB, NXCD = 8, WGM = 8;
__host__ __device__ __forceinline__ int lds_byte(int r, int c) { const int st = (r >> 4) * 2 + (c >> 5), rr = r & 15, cc = c & 31, ob = rr * 64 + cc * 2; return st * 1024 + (ob ^ (((ob >> 9) & 1) << 5)); }
__host__ __device__ __forceinline__ void stage_rc(int b, int& R, int& C) { const int st = b / 1024, sb = b % 1024, swz = sb ^ (((sb >> 9) & 1) << 5); R = (st >> 1) * 16 + swz / 64; C = (st & 1) * 32 + (swz % 64) / 2; }
__host__ __device__ __forceinline__ int perm32(int rho) { const int n = rho >> 4, i = rho & 15; return 8 * (i >> 2) + 4 * n + (i & 3); }

struct Unit { int pm, pn, sub; const char* a; const char* b; };

struct StaticOrder {
    int nM, nN, nwg, G, c; const char* A; const char* B; size_t tA, tB;
    __device__ void init(int M, int N, int G_, int c_, const void* A_, int lda, const void* B_, int K) { nM = M / BM; nN = N / BM; nwg = nM * nN; G = G_; c = c_; A = (const char*)A_; B = (const char*)B_; tA = (size_t)BM * lda * 2; tB = (size_t)BM * K * 2; }
    __device__ bool next(int i, Unit& u) const {
        const long L = (long)i * G + c; if (L >= nwg) return false;
        int wgid = (int)L; { const int q = nwg / NXCD, r = nwg % NXCD, xcd = wgid % NXCD, off = wgid / NXCD; wgid = (xcd < r ? xcd * (q + 1) : r * (q + 1) + (xcd - r) * q) + off; }
        const int nig = WGM * nN, gid = wgid / nig, fm = gid * WGM, gsz = (nM - fm) < WGM ? (nM - fm) : WGM;
        u.pm = fm + ((wgid % nig) % gsz); u.pn = (wgid % nig) / gsz; u.sub = 0; u.a = A + (size_t)u.pm * tA; u.b = B + (size_t)u.pn * tB; return true;
    }
};

template <class Epi, class Sched>
__device__ __forceinline__ void gemm_phase(LAS unsigned char* lds, const int K_, const int lda_, const Sched& S, const Epi& E) {
    int K = K_, lda = lda_, tid = threadIdx.x;
    asm volatile("" : "+s"(K), "+s"(lda), "+v"(tid));
    const int wid = __builtin_amdgcn_readfirstlane(tid >> 6), lane = tid & 63, wr = wid >> 2, wc = wid & 3, fr = lane & 15, fq = lane >> 4;
    const int nt = K / BK;
    unsigned voffA[2], voffB[2];
#pragma unroll
    for (int i = 0; i < 2; ++i) { int R, C; stage_rc(tid * 16 + i * 8192, R, C); const int Rb = (R & ~31) + perm32(R & 31);
        voffA[i] = (unsigned)(R * lda + C) * 2u; voffB[i] = (unsigned)(Rb * K + C) * 2u; }
    const size_t kstep = (size_t)(BK * 2);
    const size_t hA = (size_t)HALF * lda * 2, hB = (size_t)HALF * K * 2;
    const unsigned ldsw = (unsigned)wid * 1024u;
    const int aoff = lds_byte(wr * 64 + fr, fq * 8), boff = lds_byte(wc * 32 + fr, fq * 8);
#define PG8_SA(b, h) (((b) * 2 + (h)) * HTB)
#define PG8_SB(b, h) ((4 + (b) * 2 + (h)) * HTB)
#define PG8_STAGE(bufoff, gbase, voff) do { _Pragma("unroll") for (int _i = 0; _i < 2; ++_i) \
        __builtin_amdgcn_global_load_lds((const unsigned*)((const char*)(gbase) + (voff)[_i]), (LAS unsigned*)(lds + (bufoff) + ldsw + _i * 8192), 16, 0, 0); } while (0)
#define PG8_LDA(dst, b, h) do { _Pragma("unroll") for (int m = 0; m < 4; ++m) _Pragma("unroll") for (int k = 0; k < 2; ++k) dst[m][k] = *(const LAS bf16x8*)(lds + PG8_SA(b, h) + aoff + m * 2048 + k * 1024); } while (0)
#define PG8_LDB(dst, b, h) do { _Pragma("unroll") for (int n = 0; n < 2; ++n) _Pragma("unroll") for (int k = 0; k < 2; ++k) dst[n][k] = *(const LAS bf16x8*)(lds + PG8_SB(b, h) + boff + n * 2048 + k * 1024); } while (0)
#define PG8_MMA(ai, bj, At, Bt) do { __builtin_amdgcn_s_setprio(1); _Pragma("unroll") for (int m = 0; m < 4; ++m) _Pragma("unroll") for (int n = 0; n < 2; ++n) _Pragma("unroll") for (int k = 0; k < 2; ++k) \
        acc[ai][bj][m][n] = __builtin_amdgcn_mfma_f32_16x16x32_bf16(Bt[n][k], At[m][k], acc[ai][bj][m][n], 0, 0, 0); __builtin_amdgcn_s_setprio(0); } while (0)
#define PG8_WAIT_V(n) asm volatile("s_waitcnt vmcnt(" #n ")" ::: "memory")
#define PG8_WAIT_L(n) asm volatile("s_waitcnt lgkmcnt(" #n ")" ::: "memory")
#define PG8_BAR __builtin_amdgcn_s_barrier()
#define PG8_SCHED __builtin_amdgcn_sched_barrier(0)
    Unit cur, nxt; int ui = 0;
    if (!S.next(0, cur)) return;
    f32x4 acc[2][2][4][2];
#pragma unroll
    for (int a = 0; a < 2; ++a)
#pragma unroll
        for (int b = 0; b < 2; ++b)
#pragma unroll
            for (int m = 0; m < 4; ++m)
#pragma unroll
                for (int n = 0; n < 2; ++n) acc[a][b][m][n] = (f32x4){0.f, 0.f, 0.f, 0.f};
    bf16x8 At[4][2], B0[2][2], B1[2][2];
    const char* cA = cur.a; const char* cB = cur.b;
    PG8_STAGE(PG8_SB(0, 0), cB, voffB); PG8_STAGE(PG8_SB(0, 1), cB + hB, voffB); PG8_STAGE(PG8_SA(0, 0), cA, voffA); PG8_STAGE(PG8_SA(0, 1), cA + hA, voffA);
    if (wr == 1) PG8_BAR;
    PG8_WAIT_V(2); PG8_BAR;
    PG8_STAGE(PG8_SB(1, 0), cB + kstep, voffB); PG8_STAGE(PG8_SA(1, 0), cA + kstep, voffA); PG8_STAGE(PG8_SB(1, 1), cB + hB + kstep, voffB);
    PG8_WAIT_V(6); PG8_BAR;
    for (;;) {
        const bool has_next = S.next(ui + 1, nxt);
        const char* nA = has_next ? nxt.a : cA; const char* nB = has_next ? nxt.b : cB;
        for (int t = 0; t < nt; t += 2) {
            const bool last = (t == nt - 2);
            const char* a1 = cA + (size_t)(t + 1) * kstep;
            const char* a2 = last ? nA : cA + (size_t)(t + 2) * kstep; const char* b2 = last ? nB : cB + (size_t)(t + 2) * kstep;
            const char* a3 = a2 + kstep; const char* b3 = b2 + kstep;
            PG8_LDB(B0, 0, 0); PG8_LDB(B1, 0, 1); PG8_SCHED; PG8_LDA(At, 0, 0); PG8_STAGE(PG8_SA(1, 1), a1 + hA, voffA);
            PG8_WAIT_V(8); PG8_WAIT_L(0); PG8_BAR; PG8_MMA(0, 0, At, B0); PG8_MMA(0, 1, At, B1); PG8_BAR; PG8_SCHED;
            PG8_LDA(At, 0, 1); PG8_STAGE(PG8_SB(0, 0), b2, voffB); PG8_STAGE(PG8_SB(0, 1), b2 + hB, voffB); PG8_STAGE(PG8_SA(0, 0), a2, voffA);
            PG8_WAIT_V(8); PG8_WAIT_L(0); PG8_BAR; PG8_MMA(1, 0, At, B0); PG8_MMA(1, 1, At, B1); PG8_BAR; PG8_SCHED;
            PG8_LDB(B0, 1, 0); PG8_LDB(B1, 1, 1); PG8_SCHED; PG8_LDA(At, 1, 0); PG8_STAGE(PG8_SA(0, 1), a2 + hA, voffA);
            PG8_WAIT_V(8); PG8_WAIT_L(0); PG8_BAR; PG8_MMA(0, 0, At, B0); PG8_MMA(0, 1, At, B1); PG8_BAR; PG8_SCHED;
            PG8_LDA(At, 1, 1); PG8_STAGE(PG8_SB(1, 0), b3, voffB); PG8_STAGE(PG8_SB(1, 1), b3 + hB, voffB); PG8_STAGE(PG8_SA(1, 0), a3, voffA);
            PG8_WAIT_V(8); PG8_WAIT_L(0); PG8_BAR; PG8_MMA(1, 0, At, B0); PG8_MMA(1, 1, At, B1); PG8_BAR; PG8_SCHED;
        }
        if (wr == 0) PG8_BAR;
        E(acc, cur, wr, wc, fr, fq);
        if (!has_next) break;
        if (!E.keep(cur)) {
#pragma unroll
        for (int a = 0; a < 2; ++a)
#pragma unroll
            for (int b = 0; b < 2; ++b)
#pragma unroll
                for (int m = 0; m < 4; ++m)
#pragma unroll
                    for (int n = 0; n < 2; ++n) acc[a][b][m][n] = (f32x4){0.f, 0.f, 0.f, 0.f};
        }
        cur = nxt; cA = nA; cB = nB; ++ui;
        if (wr == 1) PG8_BAR;
    }
    PG8_WAIT_V(0);
    PG8_BAR;
#undef PG8_SA
#undef PG8_SB
#undef PG8_STAGE
#undef PG8_LDA
#undef PG8_LDB
#undef PG8_MMA
#undef PG8_WAIT_V
#undef PG8_WAIT_L
#undef PG8_BAR
#undef PG8_SCHED
}
typedef f32x4 Acc[2][2][4][2];
#define EPI_ROW(u, ai, m) ((u).pm * 256 + (ai) * 128 + wr * 64 + (m) * 16 + fr)
#define EPI_COL(u, bj) ((u).pn * 256 + (bj) * 128 + wc * 32 + 8 * fq)

struct EpiIn {
    bf16_t* PA; float* SQP; float* SKP; bf16_t* KR; const float* ROPE;
    __device__ __forceinline__ bool keep(const Unit&) const { return false; }
    __device__ __forceinline__ void operator()(Acc& acc, const Unit& u, int wr, int wc, int fr, int fq) const {
        const int pn = u.pn; const bool act = (pn == 2 || pn == 3 || pn == 6 || pn == 7 || pn == 10 || pn == 11);
#pragma unroll
        for (int ai = 0; ai < 2; ++ai)
#pragma unroll
            for (int m = 0; m < 4; ++m) { const int row = EPI_ROW(u, ai, m); bf16_t* rowp = PA + (size_t)row * PAW + EPI_COL(u, 0);
#pragma unroll
                for (int bj = 0; bj < 2; ++bj) { f32x4 v0 = acc[ai][bj][m][0], v1 = acc[ai][bj][m][1];
                    if (act) {
#pragma unroll
                        for (int e = 0; e < 4; ++e) { v0[e] = siluf_(v0[e]); v1[e] = siluf_(v1[e]); } }
                    u32x4 w; w.x = cvtpk(v0[0], v0[1]); w.y = cvtpk(v0[2], v0[3]); w.z = cvtpk(v1[0], v1[1]); w.w = cvtpk(v1[2], v1[3]);
                    *(u32x4*)(rowp + bj * 128) = w; }
                if (pn == 4 || pn == 5) {
                    float s = 0.f;
#pragma unroll
                    for (int bj = 0; bj < 2; ++bj) if (pn == 4 || bj == 0) {
#pragma unroll
                        for (int n = 0; n < 2; ++n) { const f32x4 x = acc[ai][bj][m][n]; s += (x[0] * x[0] + x[1] * x[1]) + (x[2] * x[2] + x[3] * x[3]); } }
                    s += __shfl_xor(s, 16); s += __shfl_xor(s, 32);
                    if (fq == 0) (pn == 4 ? SQP : SKP)[(size_t)row * 4 + wc] = s;
                    if (pn == 5 && wc == 0) {
                        f32x4 o[2];
#pragma unroll
                        for (int n = 0; n < 2; ++n) { const f32x4 v = acc[ai][1][m][n]; const f32x4 cs = *(const f32x4*)(ROPE + (size_t)row * 32 + 2 * (4 * fq + 2 * n));
                            o[n][0] = v[0] * cs[0] - v[1] * cs[1]; o[n][1] = v[0] * cs[1] + v[1] * cs[0]; o[n][2] = v[2] * cs[2] - v[3] * cs[3]; o[n][3] = v[2] * cs[3] + v[3] * cs[2]; }
                        u32x4 w; w.x = cvtpk(o[0][0], o[0][1]); w.y = cvtpk(o[0][2], o[0][3]); w.z = cvtpk(o[1][0], o[1][1]); w.w = cvtpk(o[1][2], o[1][3]);
                        *(u32x4*)(KR + (size_t)row * 32 + 8 * fq) = w;
                    }
                }
                asm volatile("" ::: "memory");
            }
    }
};
struct EpiPlain {
    bf16_t* O; int ldc;
    __device__ __forceinline__ bool keep(const Unit&) const { return false; }
    __device__ __forceinline__ void operator()(Acc& acc, const Unit& u, int wr, int wc, int fr, int fq) const {
#pragma unroll
        for (int ai = 0; ai < 2; ++ai)
#pragma unroll
            for (int m = 0; m < 4; ++m) { bf16_t* rowp = O + (size_t)EPI_ROW(u, ai, m) * ldc + EPI_COL(u, 0);
#pragma unroll
                for (int bj = 0; bj < 2; ++bj) { const f32x4 v0 = acc[ai][bj][m][0], v1 = acc[ai][bj][m][1];
                    u32x4 w; w.x = cvtpk(v0[0], v0[1]); w.y = cvtpk(v0[2], v0[3]); w.z = cvtpk(v1[0], v1[1]); w.w = cvtpk(v1[2], v1[3]);
                    *(u32x4*)(rowp + bj * 128) = w; } }
    }
};
__device__ __forceinline__ unsigned q8f(float g) { const float q = fminf(fmaxf(g * 255.0f + 0.5f, 1.0f), 255.0f); return (unsigned)q; }
struct EpiGate {
    unsigned char* G8; const float* bias;
    __device__ __forceinline__ bool keep(const Unit&) const { return false; }
    __device__ __forceinline__ void operator()(Acc& acc, const Unit& u, int wr, int wc, int fr, int fq) const {
        f32x4 bv[2][2];
#pragma unroll
        for (int bj = 0; bj < 2; ++bj)
#pragma unroll
            for (int n = 0; n < 2; ++n) bv[bj][n] = *(const f32x4*)(bias + EPI_COL(u, bj) + 4 * n);
#pragma unroll
        for (int ai = 0; ai < 2; ++ai)
#pragma unroll
            for (int m = 0; m < 4; ++m) { unsigned char* rowp = G8 + (size_t)EPI_ROW(u, ai, m) * PAW + EPI_COL(u, 0);
#pragma unroll
                for (int bj = 0; bj < 2; ++bj) { f32x4 v0 = acc[ai][bj][m][0] + bv[bj][0], v1 = acc[ai][bj][m][1] + bv[bj][1];
#pragma unroll
                    for (int e = 0; e < 4; ++e) { v0[e] = sigmoidf_(v0[e]); v1[e] = sigmoidf_(v1[e]); }
                    u32x2 w; w.x = q8f(v0[0]) | (q8f(v0[1]) << 8) | (q8f(v0[2]) << 16) | (q8f(v0[3]) << 24); w.y = q8f(v1[0]) | (q8f(v1[1]) << 8) | (q8f(v1[2]) << 16) | (q8f(v1[3]) << 24);
                    *(u32x2*)(rowp + bj * 128) = w; }
                asm volatile("" ::: "memory"); }
    }
};
struct EpiQ {
    bf16_t* Q; const float* SQP; const float* ROPE;
    __device__ __forceinline__ bool keep(const Unit&) const { return false; }
    __device__ __forceinline__ void operator()(Acc& acc, const Unit& u, int wr, int wc, int fr, int fq) const {
#pragma unroll
        for (int ai = 0; ai < 2; ++ai)
#pragma unroll
            for (int m = 0; m < 4; ++m) { const int row = EPI_ROW(u, ai, m); const f32x4 sq = *(const f32x4*)(SQP + (size_t)row * 4);
                const float sr = 1.0f / sqrtf(((sq[0] + sq[1]) + (sq[2] + sq[3])) * (1.0f / 256.0f) + LN_EPS);
#pragma unroll
                for (int bj = 0; bj < 2; ++bj) { const int col = EPI_COL(u, bj); f32x4 v[2];
#pragma unroll
                    for (int n = 0; n < 2; ++n) { v[n] = acc[ai][bj][m][n] * sr; const int d = (col + 4 * n) % 96;
                        if (d >= 64) { const f32x4 cs = *(const f32x4*)(ROPE + (size_t)row * 32 + (d - 64)); const f32x4 t = v[n];
                            v[n][0] = t[0] * cs[0] - t[1] * cs[1]; v[n][1] = t[0] * cs[1] + t[1] * cs[0]; v[n][2] = t[2] * cs[2] - t[3] * cs[3]; v[n][3] = t[2] * cs[3] + t[3] * cs[2]; } }
                    u32x4 w; w.x = cvtpk(v[0][0], v[0][1]); w.y = cvtpk(v[0][2], v[0][3]); w.z = cvtpk(v[1][0], v[1][1]); w.w = cvtpk(v[1][2], v[1][3]);
                    *(u32x4*)(Q + (size_t)row * 768 + col) = w; }
                asm volatile("" ::: "memory"); }
    }
};
struct EpiKV {
    bf16_t* KN; bf16_t* V; const float* SKP;
    __device__ __forceinline__ bool keep(const Unit&) const { return false; }
    __device__ __forceinline__ void operator()(Acc& acc, const Unit& u, int wr, int wc, int fr, int fq) const {
#pragma unroll
        for (int ai = 0; ai < 2; ++ai)
#pragma unroll
            for (int m = 0; m < 4; ++m) { const int row = EPI_ROW(u, ai, m); const f32x4 sq = *(const f32x4*)(SKP + (size_t)row * 4);
                const float sr = 1.0f / sqrtf(((sq[0] + sq[1]) + (sq[2] + sq[3])) * (1.0f / 128.0f) + LN_EPS);
#pragma unroll
                for (int bj = 0; bj < 2; ++bj) { const int head = 2 * u.pn + bj, local = wc * 32 + 8 * fq; const f32x4 v0 = acc[ai][bj][m][0] * sr, v1 = acc[ai][bj][m][1] * sr;
                    u32x4 w; w.x = cvtpk(v0[0], v0[1]); w.y = cvtpk(v0[2], v0[3]); w.z = cvtpk(v1[0], v1[1]); w.w = cvtpk(v1[2], v1[3]);
                    bf16_t* dst = (wc < 2) ? KN + (size_t)row * 512 + head * 64 + local : V + (size_t)row * 512 + head * 64 + (local - 64);
                    *(u32x4*)dst = w; }
                asm volatile("" ::: "memory"); }
    }
};
struct EpiGlu {
    bf16_t* PA; const float* bglu;
    __device__ __forceinline__ bool keep(const Unit&) const { return false; }
    __device__ __forceinline__ void operator()(Acc& acc, const Unit& u, int wr, int wc, int fr, int fq) const {
        const int j0 = 128 * u.pn + wc * 32 + 8 * fq;
        f32x4 ba[2], bb[2];
#pragma unroll
        for (int n = 0; n < 2; ++n) { ba[n] = *(const f32x4*)(bglu + j0 + 4 * n); bb[n] = *(const f32x4*)(bglu + 512 + j0 + 4 * n); }
#pragma unroll
        for (int ai = 0; ai < 2; ++ai)
#pragma unroll
            for (int m = 0; m < 4; ++m) { bf16_t* p = PA + (size_t)EPI_ROW(u, ai, m) * PAW + C_ZS + j0; const u32x4 z = *(const u32x4*)p; float y[8];
#pragma unroll
                for (int n = 0; n < 2; ++n) { const f32x4 a = acc[ai][0][m][n] + ba[n], b = acc[ai][1][m][n] + bb[n];
#pragma unroll
                    for (int e = 0; e < 4; ++e) y[4 * n + e] = a[e] * sigmoidf_(b[e]); }
                u32x4 w; w.x = cvtpk(y[0] * bflo(z.x), y[1] * bfhi(z.x)); w.y = cvtpk(y[2] * bflo(z.y), y[3] * bfhi(z.y)); w.z = cvtpk(y[4] * bflo(z.z), y[5] * bfhi(z.z)); w.w = cvtpk(y[6] * bflo(z.w), y[7] * bfhi(z.w));
                *(u32x4*)p = w; asm volatile("" ::: "memory"); }
    }
};
#define UB(w, k) ((float)(((w) >> (8 * (k))) & 0xffu))
struct EpiMerge {
    const unsigned char* G8; bf16_t* MG;
    __device__ __forceinline__ bool keep(const Unit& u) const { return u.sub < 2; }
    __device__ __forceinline__ void operator()(Acc& acc, const Unit& u, int wr, int wc, int fr, int fq) const {
        const int sub = u.sub;
#pragma unroll
        for (int ai = 0; ai < 2; ++ai)
#pragma unroll
            for (int m = 0; m < 4; ++m) { const int row = EPI_ROW(u, ai, m); const unsigned char* rowp = G8 + (size_t)row * PAW + EPI_COL(u, 0);
#pragma unroll
                for (int bj = 0; bj < 2; ++bj) { const u32x2 ga = *(const u32x2*)(rowp + bj * 128 + sub * 1024);
                    float f[8] = {UB(ga.x, 0), UB(ga.x, 1), UB(ga.x, 2), UB(ga.x, 3), UB(ga.y, 0), UB(ga.y, 1), UB(ga.y, 2), UB(ga.y, 3)};
                    if (sub < 2) { const u32x2 gb = *(const u32x2*)(rowp + bj * 128 + (sub + 1) * 1024);
                        const float d[8] = {UB(gb.x, 0), UB(gb.x, 1), UB(gb.x, 2), UB(gb.x, 3), UB(gb.y, 0), UB(gb.y, 1), UB(gb.y, 2), UB(gb.y, 3)};
#pragma unroll
                        for (int e = 0; e < 8; ++e) f[e] = f[e] * __builtin_amdgcn_rcpf(d[e]); }
                    else {
#pragma unroll
                        for (int e = 0; e < 8; ++e) f[e] *= (1.0f / 255.0f); }
                    f32x4 v0 = acc[ai][bj][m][0], v1 = acc[ai][bj][m][1];
#pragma unroll
                    for (int e = 0; e < 4; ++e) { v0[e] *= f[e]; v1[e] *= f[4 + e]; }
                    acc[ai][bj][m][0] = v0; acc[ai][bj][m][1] = v1;
                    if (sub == 2) { u32x4 w; w.x = cvtpk(v0[0], v0[1]); w.y = cvtpk(v0[2], v0[3]); w.z = cvtpk(v1[0], v1[1]); w.w = cvtpk(v1[2], v1[3]); *(u32x4*)(MG + (size_t)row * DM + EPI_COL(u, bj)) = w; } } }
    }
};
struct MergeOrder {
    int G, c; const char* PA; const char* WP;
    __device__ bool next(int i, Unit& u) const {
        const int tile = (i / 3) * G + c; if (tile >= 512) return false;
        u.sub = i % 3; u.pm = tile >> 2; u.pn = tile & 3;
        const int colA = (u.sub == 0) ? C_ZS : (u.sub == 1) ? C_ZM : C_ZX;
        u.a = PA + ((size_t)u.pm * 256 * PAW + colA) * 2; u.b = WP + (size_t)u.sub * (1024 * 512 * 2) + (size_t)u.pn * (256 * 512 * 2); return true;
    }
};
struct EpiOut {
    const float* xres; float* out;
    __device__ __forceinline__ bool keep(const Unit&) const { return false; }
    __device__ __forceinline__ void operator()(Acc& acc, const Unit& u, int wr, int wc, int fr, int fq) const {
#pragma unroll
        for (int ai = 0; ai < 2; ++ai)
#pragma unroll
            for (int m = 0; m < 4; ++m) { const size_t off = (size_t)EPI_ROW(u, ai, m) * DM + EPI_COL(u, 0);
#pragma unroll
                for (int bj = 0; bj < 2; ++bj)
#pragma unroll
                    for (int n = 0; n < 2; ++n) { const f32x4 x = *(const f32x4*)(xres + off + bj * 128 + 4 * n); *(f32x4*)(out + off + bj * 128 + 4 * n) = x * ALPHA + acc[ai][bj][m][n]; } }
    }
};
}

#define MFMA32(a, b, c) __builtin_amdgcn_mfma_f32_32x32x16_bf16((a), (b), (c), 0, 0, 0)
template <int DQK, int DK1, int DV, bool CAUSAL>
__device__ __forceinline__ void attn_unit(LAS unsigned char* lds, const bf16_t* Q, int ldq, const bf16_t* K1, int ldk1, const bf16_t* K2, int ldk2,
                                          const bf16_t* V, int ldv, bf16_t* ZO, int ldo, int q0, int nt) {
    constexpr int KROW = (DQK + 8) * 2, VROW = 136, KBUF = 64 * KROW, VBUF = DV * VROW, BUF = KBUF + VBUF;
    constexpr int KCH = DQK / 8, VCH = DV / 8, NKL = (64 * KCH + 511) / 512, NVL = (64 * VCH) / 512, NS = DQK / 16, NDB = DV / 32;
    int tid = threadIdx.x; asm volatile("" : "+v"(tid));
    const int lane = tid & 63, r = lane & 31, h = lane >> 5, w = __builtin_amdgcn_readfirstlane(tid >> 6);
    bf16x8 qf[NS];
    { const bf16_t* qrow = Q + (size_t)(q0 + 32 * w + r) * ldq + 8 * h;
#pragma unroll
      for (int s = 0; s < NS; ++s) qf[s] = *(const bf16x8*)(qrow + 16 * s); }
    f32x16 o[NDB];
#pragma unroll
    for (int db = 0; db < NDB; ++db)
#pragma unroll
        for (int i = 0; i < 16; ++i) o[db][i] = 0.f;
    float mref = 0.f, lrun = 0.f;
    f32x16 negm;
#pragma unroll
    for (int i = 0; i < 16; ++i) negm[i] = 0.f;
    u32x4 kA[NKL], vA[NVL], kB[NKL], vB[NVL];
#define ATT_LOAD(t, kreg, vreg) do { \
    _Pragma("unroll") for (int i_ = 0; i_ < NKL; ++i_) { const int c_ = tid + 512 * i_; if (c_ < 64 * KCH) { const int row_ = c_ / KCH, col_ = 8 * (c_ % KCH); const size_t kv_ = (size_t)(64 * (t) + row_); \
        const bf16_t* src_ = (col_ < DK1) ? K1 + kv_ * ldk1 + col_ : K2 + kv_ * ldk2 + (col_ - DK1); kreg[i_] = *(const u32x4*)src_; } } \
    _Pragma("unroll") for (int i_ = 0; i_ < NVL; ++i_) { const int c_ = tid + 512 * i_; const int row_ = c_ / VCH, ch_ = c_ % VCH; vreg[i_] = *(const u32x4*)(V + (size_t)(64 * (t) + row_) * ldv + 8 * ch_); } } while (0)
#define ATT_STORE(buf, kreg, vreg) do { LAS unsigned char* kb_ = lds + (buf) * BUF; LAS unsigned char* vb_ = kb_ + KBUF; \
    _Pragma("unroll") for (int i_ = 0; i_ < NKL; ++i_) { const int c_ = tid + 512 * i_; if (c_ < 64 * KCH) { const int row_ = c_ / KCH, col_ = 8 * (c_ % KCH); *(LAS u32x4*)(kb_ + row_ * KROW + col_ * 2) = kreg[i_]; } } \
    _Pragma("unroll") for (int i_ = 0; i_ < NVL; ++i_) { const int c_ = tid + 512 * i_; const int row_ = c_ / VCH, ch_ = c_ % VCH; const u32x4 v_ = vreg[i_]; LAS unsigned char* p_ = vb_ + (8 * ch_) * VROW + row_ * 2; \
        *(LAS bf16_t*)(p_) = (bf16_t)(v_.x & 0xffff); *(LAS bf16_t*)(p_ + VROW) = (bf16_t)(v_.x >> 16); *(LAS bf16_t*)(p_ + 2 * VROW) = (bf16_t)(v_.y & 0xffff); *(LAS bf16_t*)(p_ + 3 * VROW) = (bf16_t)(v_.y >> 16); \
        *(LAS bf16_t*)(p_ + 4 * VROW) = (bf16_t)(v_.z & 0xffff); *(LAS bf16_t*)(p_ + 5 * VROW) = (bf16_t)(v_.z >> 16); *(LAS bf16_t*)(p_ + 6 * VROW) = (bf16_t)(v_.w & 0xffff); *(LAS bf16_t*)(p_ + 7 * VROW) = (bf16_t)(v_.w >> 16); } } while (0)
#define ATT_BAR() asm volatile("s_waitcnt lgkmcnt(0)\n\ts_barrier" ::: "memory")
    ATT_LOAD(0, kA, vA); ATT_STORE(0, kA, vA); ATT_LOAD(1, kA, vA); ATT_BAR();
    const int qg = q0 + 32 * w + r;
    bool first = true;
    for (int t2 = 0; t2 < nt; t2 += 2) {
#pragma unroll
      for (int u = 0; u < 2; ++u) {
        const int t = t2 + u, buf = u;
        if (u == 0) { if (t + 2 < nt) ATT_LOAD(t + 2, kB, vB); } else { if (t + 2 < nt) ATT_LOAD(t + 2, kA, vA); }
        const bool active = !CAUSAL || (64 * t <= q0 + 32 * w + 31);
        if (active) {
            LAS unsigned char* kb = lds + buf * BUF; LAS unsigned char* vb = kb + KBUF;
            f32x16 s0 = negm, s1 = negm;
            bf16x8 kf[2 * NS];
#pragma unroll
            for (int s = 0; s < NS; ++s) { kf[2 * s] = *(const LAS bf16x8*)(kb + r * KROW + (16 * s + 8 * h) * 2); kf[2 * s + 1] = *(const LAS bf16x8*)(kb + (32 + r) * KROW + (16 * s + 8 * h) * 2); }
            __builtin_amdgcn_sched_barrier(0);
#pragma unroll
            for (int s = 0; s < NS; ++s) { s0 = MFMA32(kf[2 * s], qf[s], s0); s1 = MFMA32(kf[2 * s + 1], qf[s], s1); }
            u32x2 vlo[NDB * 4], vhi[NDB * 4];
#pragma unroll
            for (int db = 0; db < NDB; ++db)
#pragma unroll
                for (int ks = 0; ks < 4; ++ks) { const LAS unsigned char* vp = vb + (32 * db + r) * VROW + (16 * ks + 4 * h) * 2; vlo[db * 4 + ks] = *(const LAS u32x2*)vp; vhi[db * 4 + ks] = *(const LAS u32x2*)(vp + 16); }
            __builtin_amdgcn_sched_barrier(0);
            if (CAUSAL && (64 * t + 63 > q0 + 32 * w)) {
#pragma unroll
                for (int i = 0; i < 16; ++i) { const int kv = 64 * t + crow(i, h); if (kv > qg) s0[i] = -1e30f; if (kv + 32 > qg) s1[i] = -1e30f; } }
            float mx = fmaxf(fmaxf(s0[0], s1[0]), s0[1]);
#pragma unroll
            for (int i = 2; i < 16; i += 2) mx = fmaxf(fmaxf(mx, s0[i]), s0[i + 1]);
#pragma unroll
            for (int i = 1; i < 16; i += 2) mx = fmaxf(fmaxf(mx, s1[i]), s1[(i + 1) & 15]);
            { const auto rr = __builtin_amdgcn_permlane32_swap(__float_as_uint(mx), __float_as_uint(mx), false, false); mx = fmaxf(__uint_as_float(rr[0]), __uint_as_float(rr[1])); }
            if (first || __any(mx > 8.0f)) {
                const float dl = first ? mx : fmaxf(mx, 0.f); first = false; mref += dl;
                const float alpha = __builtin_amdgcn_exp2f(-dl); lrun *= alpha;
#pragma unroll
                for (int i = 0; i < 16; ++i) { s0[i] -= dl; s1[i] -= dl; negm[i] = -mref; }
#pragma unroll
                for (int db = 0; db < NDB; ++db)
#pragma unroll
                    for (int i = 0; i < 16; ++i) o[db][i] *= alpha;
            }
            float ps = 0.f;
#pragma unroll
            for (int i = 0; i < 16; ++i) { s0[i] = __builtin_amdgcn_exp2f(s0[i]); s1[i] = __builtin_amdgcn_exp2f(s1[i]); ps += s0[i] + s1[i]; }
            lrun += ps;
            bf16x8 pf[4];
#pragma unroll
            for (int s = 0; s < 2; ++s) { u32x4 a, b;
                a.x = cvtpk(s0[8 * s], s0[8 * s + 1]); a.y = cvtpk(s0[8 * s + 2], s0[8 * s + 3]); a.z = cvtpk(s0[8 * s + 4], s0[8 * s + 5]); a.w = cvtpk(s0[8 * s + 6], s0[8 * s + 7]);
                b.x = cvtpk(s1[8 * s], s1[8 * s + 1]); b.y = cvtpk(s1[8 * s + 2], s1[8 * s + 3]); b.z = cvtpk(s1[8 * s + 4], s1[8 * s + 5]); b.w = cvtpk(s1[8 * s + 6], s1[8 * s + 7]);
                pf[s] = __builtin_bit_cast(bf16x8, a); pf[2 + s] = __builtin_bit_cast(bf16x8, b); }
#pragma unroll
            for (int db = 0; db < NDB; ++db)
#pragma unroll
                for (int ks = 0; ks < 4; ++ks) {
                    u32x4 vv; vv.x = vlo[db * 4 + ks].x; vv.y = vlo[db * 4 + ks].y; vv.z = vhi[db * 4 + ks].x; vv.w = vhi[db * 4 + ks].y;
                    o[db] = MFMA32(__builtin_bit_cast(bf16x8, vv), pf[ks], o[db]); }
        }
        if (u == 0) ATT_STORE(1, kA, vA); else { if (t + 1 < nt) ATT_STORE(0, kB, vB); }
        ATT_BAR();
      }
    }
#undef ATT_LOAD
#undef ATT_STORE
#undef ATT_BAR
    const float lt = lrun + __shfl_xor(lrun, 32), inv = 1.0f / lt;
#pragma unroll
    for (int db = 0; db < NDB; ++db)
#pragma unroll
        for (int g4 = 0; g4 < 4; ++g4) { bf16_t* zp = ZO + (size_t)qg * ldo + 32 * db + 8 * g4 + 4 * h; const u32x2 z = *(const u32x2*)zp;
            u32x2 wv; wv.x = cvtpk(o[db][4 * g4] * inv * bflo(z.x), o[db][4 * g4 + 1] * inv * bfhi(z.x)); wv.y = cvtpk(o[db][4 * g4 + 2] * inv * bflo(z.y), o[db][4 * g4 + 3] * inv * bfhi(z.y));
            *(u32x2*)zp = wv; }
}

template <bool OUT>
__device__ __forceinline__ void ssm_task(LAS unsigned char* wl, int task, bf16_t* PA, const unsigned char* tab, const float* dskip, f32x2* SS) {
    int lane = threadIdx.x & 63; asm volatile("" : "+v"(lane));
    const int r = lane & 31, h = lane >> 5, row16 = lane & 15, quad = lane >> 4;
    const int chunk = task & 7, g = (task >> 3) & 31, b = task >> 8;
    const bf16_t* BBt = (const bf16_t*)tab; const bf16_t* CMt = (const bf16_t*)(tab + 128 * 1024);
    const f32x2* LAM = (const f32x2*)(tab + 256 * 1024); const f32x2* LAML = (const f32x2*)(tab + 272 * 1024);
    bf16x8 bbf[4], cmf[4];
#pragma unroll
    for (int nb = 0; nb < 4; ++nb) bbf[nb] = *(const bf16x8*)(BBt + ((size_t)(g * 128 + 32 * nb + r)) * 16 + 8 * h);
    if (OUT) {
#pragma unroll
        for (int ks = 0; ks < 4; ++ks) cmf[ks] = *(const bf16x8*)(CMt + ((size_t)(g * 16 + row16)) * 128 + 32 * ks + 8 * quad);
    }
    const f32x2 lam = LAM[g * 64 + lane];
    const float dsk = OUT ? dskip[16 * g + row16] : 0.f;
    float hr = 0.f, hi = 0.f;
    f32x2* ssb = SS + ((size_t)(b * 32 + g) * SSM_NC) * 64 + lane;
    if (OUT) { const f32x2 lL = LAML[g * 64 + lane];
        for (int k = 0; k < chunk; ++k) { const f32x2 s = ssb[(size_t)k * 64]; const float nr = lL.x * hr - lL.y * hi + s.x, ni = lL.x * hi + lL.y * hr + s.y; hr = nr; hi = ni; } }
    LAS float* W = (LAS float*)wl;
    const size_t tokc = (size_t)b * SEQ + chunk * SSM_L;
    bf16x8 uf = *(const bf16x8*)(PA + (tokc + r) * PAW + C_U + 16 * g + 8 * h);
    for (int sub = 0; sub < SSM_L / 32; ++sub) {
        const size_t tok0 = tokc + sub * 32;
        bf16x8 ufn = uf;
        if (sub + 1 < SSM_L / 32) ufn = *(const bf16x8*)(PA + (tok0 + 32 + r) * PAW + C_U + 16 * g + 8 * h);
        bf16_t uv[2][4];
        if (OUT) {
#pragma unroll
            for (int mb = 0; mb < 2; ++mb)
#pragma unroll
                for (int j = 0; j < 4; ++j) uv[mb][j] = PA[(tok0 + 16 * mb + 4 * quad + j) * PAW + C_U + 16 * g + row16];
        }
#pragma unroll
        for (int nb = 0; nb < 4; ++nb) { f32x16 z;
#pragma unroll
            for (int i = 0; i < 16; ++i) z[i] = 0.f;
            const f32x16 bu = MFMA32(uf, bbf[nb], z);
#pragma unroll
            for (int i = 0; i < 16; ++i) W[crow(i, h) * 132 + 32 * nb + r] = bu[i]; }
        LDS_WAIT();
        f32x2 bq[32];
#pragma unroll
        for (int t = 0; t < 32; ++t) bq[t] = *(const LAS f32x2*)(W + t * 132 + 2 * lane);
        LDS_WAIT();
#pragma unroll
        for (int t = 0; t < 32; ++t) { const float nr = lam.x * hr - lam.y * hi + bq[t].x, ni = lam.x * hi + lam.y * hr + bq[t].y; hr = nr; hi = ni;
            if (OUT) *(LAS unsigned*)((LAS unsigned char*)W + t * 528 + 4 * lane) = cvtpk(hr, hi); }
        if (OUT) {
            LDS_WAIT();
#pragma unroll
            for (int mb = 0; mb < 2; ++mb) { f32x4 acc = (f32x4){0.f, 0.f, 0.f, 0.f};
#pragma unroll
                for (int ks = 0; ks < 4; ++ks) { const bf16x8 af = *(const LAS bf16x8*)((LAS unsigned char*)W + (16 * mb + row16) * 528 + (32 * ks + 8 * quad) * 2);
                    acc = __builtin_amdgcn_mfma_f32_16x16x32_bf16(af, cmf[ks], acc, 0, 0, 0); }
#pragma unroll
                for (int j = 0; j < 4; ++j) { bf16_t* p = PA + (tok0 + 16 * mb + 4 * quad + j) * PAW + C_U + 16 * g + row16; const float y = acc[j] + dsk * bf2f(uv[mb][j]); *p = f2bf(gelu_tanh(y)); } }
            LDS_WAIT();
        }
        uf = ufn;
    }
    if (!OUT) ssb[(size_t)chunk * 64] = (f32x2){hr, hi};
}

enum { MAT_PLAIN = 0, MAT_WIN = 1, MAT_WGLU = 2, MAT_WUQ = 3 };
__device__ __forceinline__ void cvt_item(const float* W, int ldw, int K, bf16_t* WT, int mat, int item, int nblk, LAS float* scr, int lane, const float* kscale) {
    const int kb = item / nblk, nb = item % nblk, k0 = 64 * kb, n0 = 32 * nb, n = n0 + (lane & 31);
    int src = n; float sc = 1.f;
    if (mat == MAT_WIN) {
        if (n < 1408) src = n; else if (n < 1440) { const int j = n - 1408; src = 1408 + ((j & 1) ? 16 + (j >> 1) : (j >> 1)); } else if (n < 1536) src = -1; else src = n - 96;
        if (n >= C_QX && n < C_ZX) sc = QMEM_SCALE;
    } else if (mat == MAT_WGLU) { const int pn = n >> 8, bj = (n >> 7) & 1, i = n & 127; src = bj * 512 + 128 * pn + i; }
    else if (mat == MAT_WUQ) { const int hd = n / 96; int d = n % 96; if (d >= 64) { const int j = d - 64; d = 64 + ((j & 1) ? 16 + (j >> 1) : (j >> 1)); } src = 96 * hd + d; sc = MLA_SCALE; }
#pragma unroll 8
    for (int i = 0; i < 32; ++i) { const int kk = 2 * i + (lane >> 5); float v = (src >= 0) ? W[(size_t)(k0 + kk) * ldw + src] : 0.f; v *= sc; if (kscale) v *= kscale[k0 + kk]; scr[kk * 33 + (lane & 31)] = v; }
    LDS_WAIT();
    const int c = lane & 7;
#pragma unroll
    for (int j = 0; j < 4; ++j) { const int nn = (lane >> 3) + 8 * j; const LAS float* s = scr + (8 * c) * 33 + nn;
        u32x4 o; o.x = cvtpk(s[0 * 33], s[1 * 33]); o.y = cvtpk(s[2 * 33], s[3 * 33]); o.z = cvtpk(s[4 * 33], s[5 * 33]); o.w = cvtpk(s[6 * 33], s[7 * 33]);
        *(u32x4*)(WT + (size_t)(n0 + nn) * K + k0 + 8 * c) = o; }
    LDS_WAIT();
}

struct Args { const void* in[26]; float* out; unsigned char* ws; int ph_lo, ph_hi; };

__device__ __forceinline__ void convert_layer(const Args& a, int l, LAS float* scr, int gw, int NGW, int lane) {
    unsigned char* wb = a.ws + WS_WB;
    constexpr int I_WIN = 16 * 192, I_GLU = 8 * 32, I_UQ = 4 * 24, I_UKV = 2 * 32, I_MEM = 16 * 32, I_P = 8 * 32, I_OUT = 16 * 32;
    constexpr int NIT = I_WIN + I_GLU + I_UQ + I_UKV + I_MEM + 3 * I_P + I_OUT;
    for (int it = gw; it < NIT; it += NGW) {
        int r = it;
        if (r < I_WIN) { cvt_item((const float*)a.in[3] + (size_t)l * DM * DIN, DIN, 1024, (bf16_t*)(wb + WB_WIN), MAT_WIN, r, 192, scr, lane, nullptr); continue; } r -= I_WIN;
        if (r < I_GLU) { cvt_item((const float*)a.in[13] + (size_t)l * 512 * 1024, 1024, 512, (bf16_t*)(wb + WB_WGLU), MAT_WGLU, r, 32, scr, lane, nullptr); continue; } r -= I_GLU;
        if (r < I_UQ) { cvt_item((const float*)a.in[16] + (size_t)l * 256 * 768, 768, 256, (bf16_t*)(wb + WB_WUQ), MAT_WUQ, r, 24, scr, lane, (const float*)a.in[15] + l * 256); continue; } r -= I_UQ;
        if (r < I_UKV) { cvt_item((const float*)a.in[18] + (size_t)l * 128 * 1024, 1024, 128, (bf16_t*)(wb + WB_WUKV), MAT_PLAIN, r, 32, scr, lane, (const float*)a.in[17] + l * 128); continue; } r -= I_UKV;
        if (r < I_MEM) { cvt_item((const float*)a.in[19] + (size_t)l * 1024 * 1024, 1024, 1024, (bf16_t*)(wb + WB_WMEM), MAT_PLAIN, r, 32, scr, lane, nullptr); continue; } r -= I_MEM;
        if (r < 3 * I_P) { const int which = r / I_P; cvt_item((const float*)a.in[20 + which] + (size_t)l * 512 * 1024, 1024, 512, (bf16_t*)(wb + WB_WP) + (size_t)which * 1024 * 512, MAT_PLAIN, r % I_P, 32, scr, lane, nullptr); continue; } r -= 3 * I_P;
        cvt_item((const float*)a.in[23] + (size_t)l * 1024 * 1024, 1024, 1024, (bf16_t*)(wb + WB_WOUT), MAT_PLAIN, r, 32, scr, lane, nullptr);
    }
}


typedef unsigned gu32_plain;
#define XB_TMO      128
#define XB_XCNT(j)  (256  + 64 * (j))
#define XB_XSUB(j)  (1280 + 64 * (j))
#define XB_XGEN(j)  (2304 + 64 * (j))
#define XB_TOP      3328
#define XB_TOPGEN   3392
#define XCD_BAR_WORDS 3456
#define XB_SPIN_CAP (1u << 18)

__device__ __forceinline__ unsigned xb_ld(unsigned* p)              { return __hip_atomic_load(p, __ATOMIC_RELAXED, __HIP_MEMORY_SCOPE_AGENT); }
__device__ __forceinline__ unsigned xb_add(unsigned* p, unsigned v) { return __hip_atomic_fetch_add(p, v, __ATOMIC_RELAXED, __HIP_MEMORY_SCOPE_AGENT); }
__device__ __forceinline__ unsigned xb_xcc_id() { return (unsigned)__builtin_amdgcn_s_getreg((3 << 11) | 20) & 0xFu; }
#define XB_SPIN(cond, bar) do { unsigned _sp = 0; while (cond) { __builtin_amdgcn_s_sleep(1); \
    if ((++_sp & 255u) == 0u) { if (xb_ld(&(bar)[XB_TMO])) break; if (_sp > XB_SPIN_CAP) { atomicAdd(&(bar)[XB_TMO], 1u); break; } } } } while (0)

struct XcdBarrier {
    unsigned* bar; unsigned x;
    volatile LAS unsigned* st;
};

__device__ __forceinline__ XcdBarrier xcd_barrier_post(unsigned* bar, volatile LAS unsigned* st) {
    XcdBarrier b; b.bar = bar; b.x = xb_xcc_id(); b.st = st;
    if (threadIdx.x == 0) (void)xb_add(&bar[XB_XCNT(b.x)], 1u);
    return b;
}
__device__ __forceinline__ void xcd_barrier_complete(unsigned* bar, unsigned x, unsigned& nloc, unsigned& nx) {
    const unsigned G = gridDim.x * gridDim.y * gridDim.z;
    unsigned sum, cnt, mine, sp = 0u;
    for (;;) {
        sum = 0u; cnt = 0u; mine = 0u;
#pragma unroll
        for (unsigned j = 0; j < 16; ++j) { const unsigned c = xb_ld(&bar[XB_XCNT(j)]); sum += c; cnt += (c > 0u) ? 1u : 0u; mine = (j == x) ? c : mine; }
        if (sum == G) break;
        __builtin_amdgcn_s_sleep(1);
        if ((++sp & 255u) == 0u) { if (xb_ld(&bar[XB_TMO])) break; if (sp > XB_SPIN_CAP) { atomicAdd(&bar[XB_TMO], 1u); break; } }
    }
    nloc = mine > 0u ? mine : 1u; nx = cnt > 0u ? cnt : 1u;
}

__device__ __forceinline__ void xcd_barrier(const XcdBarrier& b) {
    asm volatile("s_waitcnt vmcnt(0)" ::: "memory");
    __syncthreads();
    if (threadIdx.x == 0) {
        unsigned* bar = b.bar;
        __builtin_amdgcn_s_waitcnt(0);
        unsigned nloc = b.st[0], nx = b.st[1];
        if (nloc == 0u) { xcd_barrier_complete(bar, b.x, nloc, nx); b.st[0] = nloc; b.st[1] = nx; }
        const unsigned old = xb_add(&bar[XB_XSUB(b.x)], 1u);
        const unsigned gen = old / nloc;
        if (old + 1u == (gen + 1u) * nloc) {
            __builtin_amdgcn_fence(__ATOMIC_RELEASE, "agent");
            asm volatile("s_waitcnt vmcnt(0)" ::: "memory");
            const unsigned og = xb_add(&bar[XB_TOP], 1u);
            const unsigned tg = og / nx;
            if (og + 1u == (tg + 1u) * nx) xb_add(&bar[XB_TOPGEN], 1u);
            else XB_SPIN(xb_ld(&bar[XB_TOPGEN]) == tg, bar);
            __builtin_amdgcn_fence(__ATOMIC_ACQUIRE, "agent");
            xb_add(&bar[XB_XGEN(b.x)], 1u);
            asm volatile("s_waitcnt vmcnt(0)" ::: "memory");
        } else {
            XB_SPIN(xb_ld(&bar[XB_XGEN(b.x)]) == gen, bar);
            __builtin_amdgcn_fence(__ATOMIC_ACQUIRE, "agent");
            asm volatile("s_waitcnt vmcnt(0)" ::: "memory");
        }
    }
    __syncthreads();
}
constexpr int NWAVES = 8, LDS_BYTES = 147456, LDS_BARST = 147392;
constexpr size_t WS_CTL = 0, CTL_BYTES = 16384;
constexpr int N_PHASES = 1 + 7 * DEPTH;

__global__ void __launch_bounds__(NWAVES * 64, 2) mk_fwd(Args args) {
    extern __shared__ __attribute__((aligned(16))) unsigned char lds_raw[];
    LAS unsigned char* lds = (LAS unsigned char*)lds_raw;
    const int G = gridDim.x, cu = blockIdx.x, NGW = G * NWAVES;
    const int vcu = (G % 8 == 0) ? (cu % 8) * (G / 8) + cu / 8 : cu;
    unsigned char* ws = args.ws;
#if !MK_MULTI
    if (threadIdx.x < 2) ((LAS unsigned*)(lds + LDS_BARST))[threadIdx.x] = 0u;
    __syncthreads();
    const XcdBarrier gbar = xcd_barrier_post((unsigned*)(ws + WS_CTL), (volatile LAS unsigned*)(lds + LDS_BARST));
#endif
    bf16_t* XB = (bf16_t*)(ws + WS_XB); bf16_t* PA = (bf16_t*)(ws + WS_PA); bf16_t* RG = (bf16_t*)(ws + WS_R);
    bf16_t* QB = (bf16_t*)(ws + WS_R + R_Q); bf16_t* KN = (bf16_t*)(ws + WS_R + R_KN); bf16_t* KR = (bf16_t*)(ws + WS_R + R_KR); bf16_t* VB = (bf16_t*)(ws + WS_R + R_V);
    bf16_t* MEMB = (bf16_t*)(ws + WS_MEMB); bf16_t* MEMKV = (bf16_t*)(ws + WS_MEMKV);
    float* SQP = (float*)(ws + WS_SQP); float* SKP = (float*)(ws + WS_SKP); float* ROPE = (float*)(ws + WS_ROPE); f32x2* SS = (f32x2*)(ws + WS_SS);
    unsigned char* wb = ws + WS_WB;
    unsigned char* G8 = ws + WS_R; bf16_t* MG = (bf16_t*)(ws + WS_R + 96 * MiB);
    bf16_t* DUMMY = (bf16_t*)(ws + WS_R + 120 * MiB);
    const float* xin = (const float*)args.in[0];
    float* out = args.out;

    if (args.ph_lo == 0 && (PHMASK & 1)) {
        int tid = threadIdx.x; asm volatile("" : "+v"(tid));
        const int lane = tid & 63, wave = __builtin_amdgcn_readfirstlane(tid >> 6), gw = cu * NWAVES + wave;

            convert_layer(args, 0, (LAS float*)(lds + wave * 16384), gw, NGW, lane);
            { const size_t n4 = (size_t)MTOK * DM / 4;
              for (size_t i = (size_t)cu * 512 + tid; i < n4; i += (size_t)G * 512) { const f32x4 v = ((const f32x4*)xin)[i]; u32x2 w; w.x = cvtpk(v[0], v[1]); w.y = cvtpk(v[2], v[3]); ((u32x2*)XB)[i] = w; } }
            { const size_t n4 = (size_t)NB * MEML * DM / 4; const float* mem = (const float*)args.in[1];
              for (size_t i = (size_t)cu * 512 + tid; i < n4; i += (size_t)G * 512) { const f32x4 v = ((const f32x4*)mem)[i]; u32x2 w; w.x = cvtpk(v[0], v[1]); w.y = cvtpk(v[2], v[3]); ((u32x2*)MEMB)[i] = w; } }
            { const int* pos = (const int*)args.in[2];
              for (int i = cu * 512 + tid; i < MTOK * 16; i += G * 512) { const int m = i >> 4, f = i & 15; const double invf = exp(-(double)f * (9.210340371976184 / 16.0)); double c, s; cossin_d((double)pos[m] * invf, c, s);
                  ROPE[(size_t)i * 2] = (float)c; ROPE[(size_t)i * 2 + 1] = (float)s; } }
            {
              for (int i = cu * 512 + tid; i < DEPTH * 32 * 64; i += G * 512) { const int p = i & 63, g = (i >> 6) & 31, l = i >> 11;
                  unsigned char* tab = ws + WS_TAB + (size_t)l * TAB_L; bf16_t* BBt = (bf16_t*)tab; bf16_t* CMt = (bf16_t*)(tab + 128 * 1024); f32x2* LAM = (f32x2*)(tab + 256 * 1024); f32x2* LAML = (f32x2*)(tab + 272 * 1024);
                  const double dt = exp((double)((const float*)args.in[7])[l * 32 + g]); const double lr = ((const float*)args.in[5])[(l * 32 + g) * 64 + p], li = ((const float*)args.in[6])[(l * 32 + g) * 64 + p];
                  const double mag = exp(lr * dt); double c, s; cossin_d(li * dt, c, s); const double lbr = mag * c, lbi = mag * s, nr = lbr - 1.0, ni = lbi, den = lr * lr + li * li;
                  const double fre = (nr * lr + ni * li) / den, fim = (ni * lr - nr * li) / den;
                  const float* bre = (const float*)args.in[8] + ((size_t)(l * 32 + g) * 64 + p) * 16; const float* bim = (const float*)args.in[9] + ((size_t)(l * 32 + g) * 64 + p) * 16;
                  for (int cc = 0; cc < 16; ++cc) { const double br = bre[cc], bi = bim[cc]; BBt[((size_t)g * 128 + 2 * p) * 16 + cc] = f2bf((float)(fre * br - fim * bi)); BBt[((size_t)g * 128 + 2 * p + 1) * 16 + cc] = f2bf((float)(fre * bi + fim * br)); }
                  const float* cre = (const float*)args.in[10] + (size_t)(l * 32 + g) * 16 * 64; const float* cim = (const float*)args.in[11] + (size_t)(l * 32 + g) * 16 * 64;
                  for (int cc = 0; cc < 16; ++cc) { CMt[((size_t)g * 16 + cc) * 128 + 2 * p] = f2bf(cre[cc * 64 + p]); CMt[((size_t)g * 16 + cc) * 128 + 2 * p + 1] = f2bf(-cim[cc * 64 + p]); }
                  LAM[g * 64 + p] = (f32x2){(float)lbr, (float)lbi};
                  const double magL = exp(lr * dt * (double)SSM_L); double cL, sL; cossin_d(li * dt * (double)SSM_L, cL, sL); LAML[g * 64 + p] = (f32x2){(float)(magL * cL), (float)(magL * sL)}; } }
#if !MK_MULTI
        if (args.ph_hi > 1) { __threadfence(); cg::this_grid().sync(); }
#endif
    }
    for (int ph = (args.ph_lo > 1 ? args.ph_lo : 1); ph < args.ph_hi; ++ph) {
        int tid = threadIdx.x; asm volatile("" : "+v"(tid));
        const int lane = tid & 63, wave = __builtin_amdgcn_readfirstlane(tid >> 6), gw = cu * NWAVES + wave;
        {
            const int l = (ph - 1) / 7, k = (ph - 1) % 7;
            const unsigned char* tab = ws + WS_TAB + (size_t)l * TAB_L;
            if (k == 0 && (PHMASK & 2)) {
#pragma unroll 1
                for (int rep = 0; rep < (PROBE_JOB == 1 ? 2 : 1); ++rep)
                { pg8::StaticOrder S; S.init(MTOK, PAW, G, cu, XB, DM, wb + WB_WIN, DM); pg8::EpiIn E{PA, SQP, SKP, KR, ROPE}; pg8::gemm_phase(lds, DM, DM, S, E); }
            } else if (k == 1 && (PHMASK & 4)) {
                { pg8::StaticOrder S; S.init(NB * MEML, 1024, G, (G == 256) ? (cu >= 128 ? cu - 128 : 1 << 20) : cu, MEMB, DM, wb + WB_WMEM, DM); pg8::EpiPlain E{MEMKV, 1024}; pg8::gemm_phase(lds, DM, DM, S, E); }
                if (K1MASK & 1) { pg8::StaticOrder S; S.init(MTOK, 768, G, cu, PA + C_CQ, PAW, wb + WB_WUQ, 256); pg8::EpiQ E{QB, SQP, ROPE}; pg8::gemm_phase(lds, 256, PAW, S, E); }
                if (K1MASK & 2) { pg8::StaticOrder S; S.init(MTOK, 1024, G, cu, PA + C_CKV, PAW, wb + WB_WUKV, 128); pg8::EpiKV E{KN, VB, SKP}; pg8::gemm_phase(lds, 128, PAW, S, E); }
#pragma unroll 1
                for (int rep = 0; rep < (PROBE_JOB == 3 ? 2 : 1); ++rep)
                if (K1MASK & 4) for (int task = gw; task < NB * 32 * SSM_NC; task += NGW) ssm_task<false>(lds + wave * 16896, task, PA, tab, (const float*)args.in[12] + l * 512, SS);
                __syncthreads();
            } else if (k == 2 && (PHMASK & 8)) {
#pragma unroll 1
                for (int rep = 0; rep < (PROBE_JOB == 4 ? 2 : 1); ++rep)
                if (K1MASK & 8) for (int ui = vcu; ui < NB * 4 * 16; ui += G) { const bool dummy = (PROBE_JOB == 4 && rep == 0); const int b = ui >> 6, hh = (ui >> 4) & 3, qb = ui & 15; const size_t t0 = (size_t)b * SEQ;
#pragma unroll 1
                    for (int e = 0; e < 2; ++e)
                    attn_unit<128, 128, 64, false>(lds, PA + t0 * PAW + C_QX + 128 * hh, PAW, MEMKV + (size_t)b * MEML * 1024 + 128 * hh, 1024, nullptr, 0,
                                                    MEMKV + (size_t)b * MEML * 1024 + 512 + 128 * hh + 64 * e, 1024, dummy ? DUMMY + t0 * 64 : PA + t0 * PAW + C_ZX + 128 * hh + 64 * e, dummy ? 64 : PAW, 256 * qb, MEML / 64); }
#pragma unroll 1
                for (int rep = 0; rep < (PROBE_JOB == 2 ? 2 : 1); ++rep)
                for (int pi = vcu; pi < NB * 8 * 8; pi += G) { const bool dummy = (PROBE_JOB == 2 && rep == 0); const int bh = pi >> 3, j = pi & 7, b = bh >> 3, hh = bh & 7; const size_t t0 = (size_t)b * SEQ;
#pragma unroll 1
                    for (int e = 0; e < 2; ++e) { const int qb = e ? 15 - j : j;
                        attn_unit<96, 64, 64, true>(lds, QB + t0 * 768 + 96 * hh, 768, KN + t0 * 512 + 64 * hh, 512, KR + t0 * 32, 32, VB + t0 * 512 + 64 * hh, 512, dummy ? DUMMY + t0 * 64 : PA + t0 * PAW + C_ZM + 64 * hh, dummy ? 64 : PAW, 256 * qb, 4 * (qb + 1)); } }
                for (int task = gw; task < NB * 32 * SSM_NC; task += NGW) ssm_task<true>(lds + wave * 16896, task, PA, tab, (const float*)args.in[12] + l * 512, SS);
                __syncthreads();
            } else if (k == 3 && (PHMASK & 16)) {
#pragma unroll 1
                for (int rep = 0; rep < (PROBE_JOB == 5 ? 2 : 1); ++rep)
                { pg8::StaticOrder S; S.init(MTOK, PAW, G, cu, XB, DM, wb + WB_WIN + (size_t)PAW * DM * 2, DM); pg8::EpiGate E{G8, (const float*)args.in[4] + l * 3072}; pg8::gemm_phase(lds, DM, DM, S, E); }
                { pg8::StaticOrder S; S.init(MTOK, 1024, G, cu, PA + C_U, PAW, wb + WB_WGLU, 512); pg8::EpiGlu E{PA, (const float*)args.in[14] + l * 1024}; pg8::gemm_phase(lds, 512, PAW, S, E); }
            } else if (k == 4 && (PHMASK & 32)) {
                { pg8::MergeOrder S{G, cu, (const char*)PA, (const char*)(wb + WB_WP)}; pg8::EpiMerge E{G8, MG}; pg8::gemm_phase(lds, 512, PAW, S, E); }
            } else if (k == 5 && (PHMASK & 64)) {
#pragma unroll 1
                for (int rep = 0; rep < (PROBE_JOB == 8 ? 2 : 1); ++rep) { const bool dummy = (PROBE_JOB == 8 && rep == 0);
                pg8::StaticOrder S; S.init(MTOK, DM, G, cu, MG, DM, wb + WB_WOUT, DM); pg8::EpiOut E{l == 0 ? xin : (const float*)out, dummy ? (float*)PA : out}; pg8::gemm_phase(lds, DM, DM, S, E); }
            } else if (k == 6 && (PHMASK & 128)) {
                const float* lg = (const float*)args.in[24] + l * DM; const float* lb = (const float*)args.in[25] + l * DM;
                f32x4 gv[4], bv[4];
#pragma unroll
                for (int j = 0; j < 4; ++j) { gv[j] = ((const f32x4*)lg)[lane + 64 * j]; bv[j] = ((const f32x4*)lb)[lane + 64 * j]; }
#pragma unroll 1
                for (int rep = 0; rep < (PROBE_JOB == 7 ? 2 : 1); ++rep) { const bool dummy = (PROBE_JOB == 7 && rep == 0);
                for (int m = gw; m < MTOK; m += NGW) { f32x4* xr = (f32x4*)(out + (size_t)m * DM) + lane; f32x4* xw = dummy ? (f32x4*)((float*)PA + (size_t)m * DM) + lane : xr; f32x4 v[4]; float s = 0.f;
#pragma unroll
                    for (int j = 0; j < 4; ++j) { v[j] = xr[64 * j]; s += (v[j][0] + v[j][1]) + (v[j][2] + v[j][3]); }
                    const float mean = wave_sum(s) * (1.f / DM); float s2 = 0.f;
#pragma unroll
                    for (int j = 0; j < 4; ++j) { v[j] = v[j] - mean; s2 += (v[j][0] * v[j][0] + v[j][1] * v[j][1]) + (v[j][2] * v[j][2] + v[j][3] * v[j][3]); }
                    const float rstd = 1.f / sqrtf(wave_sum(s2) * (1.f / DM) + LN_EPS);
                    u32x2* xb = (u32x2*)((dummy ? RG : XB) + (size_t)m * DM) + lane;
#pragma unroll
                    for (int j = 0; j < 4; ++j) { const f32x4 y = v[j] * rstd * gv[j] + bv[j]; xw[64 * j] = y; u32x2 w; w.x = cvtpk(y[0], y[1]); w.y = cvtpk(y[2], y[3]); xb[64 * j] = w; } } }
                if (l + 1 < DEPTH) convert_layer(args, l + 1, (LAS float*)(lds + wave * 16384), gw, NGW, lane);
            }
        }
#if !MK_MULTI
        if (ph + 1 < args.ph_hi) { xcd_barrier(gbar); if (PROBE_JOB == 6) { xcd_barrier(gbar); xcd_barrier(gbar); } }
#endif
    }
}

extern "C" void kernel_launch(void* const* d_in, const int* in_sizes, int n_in, void* d_out, int out_size, void* d_ws, size_t ws_size, hipStream_t stream) {
    static int grid = 0;
    if (grid == 0) {
        if (n_in != 26 || out_size != MTOK * DM || ws_size < WS_END) { fprintf(stderr, "kernel_launch: unexpected sizes n_in %d out %d ws %zu\n", n_in, out_size, ws_size); grid = -1; return; }
        int dev = 0, cus = 0, per_cu = 0;
        hipGetDevice(&dev); hipDeviceGetAttribute(&cus, hipDeviceAttributeMultiprocessorCount, dev);
        hipFuncSetAttribute((const void*)mk_fwd, hipFuncAttributeMaxDynamicSharedMemorySize, LDS_BYTES);
        hipOccupancyMaxActiveBlocksPerMultiprocessor(&per_cu, (const void*)mk_fwd, NWAVES * 64, LDS_BYTES);
        if (per_cu < 1) { fprintf(stderr, "kernel_launch: occupancy query says %d blocks/CU\n", per_cu); per_cu = 1; }
        (void)hipGetLastError();
        grid = cus * 1;
    }
    if (grid < 0) return;
    Args a{};
    for (int i = 0; i < 26; ++i) a.in[i] = d_in[i];
    a.out = (float*)d_out; a.ws = (unsigned char*)d_ws;
#if MK_MULTI
    for (int ph = 0; ph < N_PHASES; ++ph) { a.ph_lo = ph; a.ph_hi = ph + 1; hipLaunchKernelGGL(mk_fwd, dim3(grid), dim3(NWAVES * 64), LDS_BYTES, stream, a); }
#else
    a.ph_lo = 0; a.ph_hi = N_PHASES;
    if (hipMemsetAsync((char*)d_ws + WS_CTL, 0, CTL_BYTES, stream) != hipSuccess) { fprintf(stderr, "kernel_launch: memset of barrier words failed\n"); return; }
    void* kargs[] = {&a};
    hipError_t e = hipLaunchCooperativeKernel((const void*)mk_fwd, dim3(grid), dim3(NWAVES * 64), kargs, LDS_BYTES, stream);
    if (e != hipSuccess) fprintf(stderr, "cooperative launch failed: %s (grid %d)\n", hipGetErrorString(e), grid);
#endif
}
```

```cpp
#include <hip/hip_runtime.h>
#include <hip/hip_cooperative_groups.h>
#include <cstdio>
#include <cstdint>
namespace cg = cooperative_groups;

#ifndef MK_MULTI
#define MK_MULTI 0
#endif

#ifndef PROBE_JOB
#define PROBE_JOB 0
#endif
#ifndef K1MASK
#define K1MASK 15
#endif
#ifndef PHMASK
#define PHMASK 255
#endif
#define LAS __attribute__((address_space(3)))
typedef unsigned short bf16_t;
typedef short bf16x8 __attribute__((ext_vector_type(8)));
typedef float f32x2 __attribute__((ext_vector_type(2)));
typedef float f32x4 __attribute__((ext_vector_type(4)));
typedef float f32x16 __attribute__((ext_vector_type(16)));
typedef unsigned u32x2 __attribute__((ext_vector_type(2)));
typedef unsigned u32x4 __attribute__((ext_vector_type(4)));
typedef __bf16 bf16x2_t __attribute__((ext_vector_type(2)));
typedef short v4i16_t __attribute__((ext_vector_type(4)));

constexpr int DM = 1024, NB = 8, SEQ = 4096, DEPTH = 4, MEML = 256;
constexpr int MTOK = NB * SEQ;
constexpr int DIN = 6048;
constexpr int PAW = 3072;
constexpr float LN_EPS = 1e-5f;
constexpr float ALPHA = 1.6817928305074292f;
constexpr float LOG2E = 1.4426950408889634f;
constexpr float MLA_SCALE = 0.10206207261596577f * LOG2E;
constexpr float QMEM_SCALE = 0.08838834764831845f * LOG2E;
constexpr int SSM_L = 512, SSM_NC = SEQ / SSM_L;

constexpr size_t MiB = 1u << 20;
constexpr size_t WS_TAB = 1 * MiB;
constexpr size_t TAB_L = 288 * 1024;
constexpr size_t WS_ROPE = 3 * MiB;
constexpr size_t WS_SS = 7 * MiB;
constexpr size_t WS_SQP = 8 * MiB;
constexpr size_t WS_SKP = WS_SQP + 512 * 1024;
constexpr size_t WS_MEMB = 9 * MiB;
constexpr size_t WS_MEMKV = 13 * MiB;
constexpr size_t WS_WB = 21 * MiB;
constexpr size_t WB_WIN = 0, WB_WGLU = 12 * MiB, WB_WUQ = 13 * MiB, WB_WUKV = WB_WUQ + 512 * 1024, WB_WMEM = 14 * MiB, WB_WP = 18 * MiB, WB_WOUT = 21 * MiB;
constexpr size_t WS_XB = 45 * MiB;
constexpr size_t WS_PA = 109 * MiB;
constexpr size_t WS_R = 301 * MiB;
constexpr size_t R_Q = 0, R_KN = 48 * MiB, R_KR = 80 * MiB, R_V = 82 * MiB;
constexpr size_t WS_END = 493 * MiB;

constexpr int C_U = 0, C_ZS = 512, C_CQ = 1024, C_CKV = 1280, C_KR = 1408, C_ZM = 1536, C_QX = 2048, C_ZX = 2560;

__device__ __forceinline__ unsigned cvtpk(float lo, float hi) { f32x2 v = {lo, hi}; bf16x2_t b = __builtin_convertvector(v, bf16x2_t); return __builtin_bit_cast(unsigned, b); }
__device__ __forceinline__ bf16_t f2bf(float f) { return (bf16_t)(cvtpk(f, 0.f) & 0xffffu); }
__device__ __forceinline__ float bflo(unsigned w) { return __uint_as_float(w << 16); }
__device__ __forceinline__ float bfhi(unsigned w) { return __uint_as_float(w & 0xffff0000u); }
__device__ __forceinline__ float bf2f(bf16_t b) { return __uint_as_float((unsigned)b << 16); }
__device__ __forceinline__ float sigmoidf_(float x) { return __builtin_amdgcn_rcpf(1.0f + __expf(-x)); }
__device__ __forceinline__ float siluf_(float x) { return x * sigmoidf_(x); }
__device__ __forceinline__ float gelu_tanh(float x) { const float z = 0.7978845608028654f * (x + 0.044715f * x * x * x); return x * sigmoidf_(2.0f * z); }
__device__ __forceinline__ float wave_sum(float v) {
#pragma unroll
    for (int o = 1; o < 64; o <<= 1) v += __shfl_xor(v, o);
    return v;
}
#define LDS_WAIT() asm volatile("s_waitcnt lgkmcnt(0)" ::: "memory")
__device__ __forceinline__ int crow(int i, int h) { return (i & 3) + 8 * (i >> 2) + 4 * h; }
__device__ __forceinline__ void cossin_d(double a, double& c, double& s) {
    const double q = rint(a * 0.63661977236758134308);
    const double y = a - q * 1.57079632679489661923;
    const double y2 = y * y;
    const double sp = y * (1.0 + y2 * (-1.0 / 6 + y2 * (1.0 / 120 + y2 * (-1.0 / 5040 + y2 * (1.0 / 362880 + y2 * (-1.0 / 39916800 + y2 * (1.0 / 6227020800.0)))))));
    const double cp = 1.0 + y2 * (-0.5 + y2 * (1.0 / 24 + y2 * (-1.0 / 720 + y2 * (1.0 / 40320 + y2 * (-1.0 / 3628800 + y2 * (1.0 / 479001600.0))))));
    const int qi = ((int)((long long)q)) & 3;
    c = (qi == 0) ? cp : (qi == 1) ? -sp : (qi == 2) ? -cp : sp;
    s = (qi == 0) ? sp : (qi == 1) ? cp : (qi == 2) ? -sp : -cp;
}

namespace pg8 {
constexpr int BM = 256, BK = 64, HALF = 128, HTB = HALF * BK * 2, STAGE_BYTES = 8 * HTB, NXCD = 8, WGM = 8;
__host__ __device__ __forceinline__ int lds_byte(int r, int c) { const int st = (r >> 4) * 2 + (c >> 5), rr = r & 15, cc = c & 31, ob = rr * 64 + cc * 2; return st * 1024 + (ob ^ (((ob >> 9) & 1) << 5)); }
__host__ __device__ __forceinline__ void stage_rc(int b, int& R, int& C) { const int st = b / 1024, sb = b % 1024, swz = sb ^ (((sb >> 9) & 1) << 5); R = (st >> 1) * 16 + swz / 64; C = (st & 1) * 32 + (swz % 64) / 2; }
__host__ __device__ __forceinline__ int perm32(int rho) { const int n = rho >> 4, i = rho & 15; return 8 * (i >> 2) + 4 * n + (i & 3); }

struct Unit { int pm, pn, sub; const char* a; const char* b; };

struct StaticOrder {
    int nM, nN, nwg, G, c; const char* A; const char* B; size_t tA, tB;
    __device__ void init(int M, int N, int G_, int c_, const void* A_, int lda, const void* B_, int K) { nM = M / BM; nN = N / BM; nwg = nM * nN; G = G_; c = c_; A = (const char*)A_; B = (const char*)B_; tA = (size_t)BM * lda * 2; tB = (size_t)BM * K * 2; }
    __device__ bool next(int i, Unit& u) const {
        const long L = (long)i * G + c; if (L >= nwg) return false;
        int wgid = (int)L; { const int q = nwg / NXCD, r = nwg % NXCD, xcd = wgid % NXCD, off = wgid / NXCD; wgid = (xcd < r ? xcd * (q + 1) : r * (q + 1) + (xcd - r) * q) + off; }
        const int nig = WGM * nN, gid = wgid / nig, fm = gid * WGM, gsz = (nM - fm) < WGM ? (nM - fm) : WGM;
        u.pm = fm + ((wgid % nig) % gsz); u.pn = (wgid % nig) / gsz; u.sub = 0; u.a = A + (size_t)u.pm * tA; u.b = B + (size_t)u.pn * tB; return true;
    }
};

template <class Epi, class Sched>
__device__ __forceinline__ void gemm_phase(LAS unsigned char* lds, const int K_, const int lda_, const Sched& S, const Epi& E) {
    int K = K_, lda = lda_, tid = threadIdx.x;
    asm volatile("" : "+s"(K), "+s"(lda), "+v"(tid));
    const int wid = __builtin_amdgcn_readfirstlane(tid >> 6), lane = tid & 63, wr = wid >> 2, wc = wid & 3, fr = lane & 15, fq = lane >> 4;
    const int nt = K / BK;
    unsigned voffA[2], voffB[2];
#pragma unroll
    for (int i = 0; i < 2; ++i) { int R, C; stage_rc(tid * 16 + i * 8192, R, C); const int Rb = (R & ~31) + perm32(R & 31);
        voffA[i] = (unsigned)(R * lda + C) * 2u; voffB[i] = (unsigned)(Rb * K + C) * 2u; }
    const size_t kstep = (size_t)(BK * 2);
    const size_t hA = (size_t)HALF * lda * 2, hB = (size_t)HALF * K * 2;
    const unsigned ldsw = (unsigned)wid * 1024u;
    const int aoff = lds_byte(wr * 64 + fr, fq * 8), boff = lds_byte(wc * 32 + fr, fq * 8);
#define PG8_SA(b, h) (((b) * 2 + (h)) * HTB)
#define PG8_SB(b, h) ((4 + (b) * 2 + (h)) * HTB)
#define PG8_STAGE(bufoff, gbase, voff) do { _Pragma("unroll") for (int _i = 0; _i < 2; ++_i) \
        __builtin_amdgcn_global_load_lds((const unsigned*)((const char*)(gbase) + (voff)[_i]), (LAS unsigned*)(lds + (bufoff) + ldsw + _i * 8192), 16, 0, 0); } while (0)
#define PG8_LDA(dst, b, h) do { _Pragma("unroll") for (int m = 0; m < 4; ++m) _Pragma("unroll") for (int k = 0; k < 2; ++k) dst[m][k] = *(const LAS bf16x8*)(lds + PG8_SA(b, h) + aoff + m * 2048 + k * 1024); } while (0)
#define PG8_LDB(dst, b, h) do { _Pragma("unroll") for (int n = 0; n < 2; ++n) _Pragma("unroll") for (int k = 0; k < 2; ++k) dst[n][k] = *(const LAS bf16x8*)(lds + PG8_SB(b, h) + boff + n * 2048 + k * 1024); } while (0)
#define PG8_MMA(ai, bj, At, Bt) do { __builtin_amdgcn_s_setprio(1); _Pragma("unroll") for (int m = 0; m < 4; ++m) _Pragma("unroll") for (int n = 0; n < 2; ++n) _Pragma("unroll") for (int k = 0; k < 2; ++k) \
        acc[ai][bj][m][n] = __builtin_amdgcn_mfma_f32_16x16x32_bf16(Bt[n][k], At[m][k], acc[ai][bj][m][n], 0, 0, 0); __builtin_amdgcn_s_setprio(0); } while (0)
#define PG8_WAIT_V(n) asm volatile("s_waitcnt vmcnt(" #n ")" ::: "memory")
#define PG8_WAIT_L(n) asm volatile("s_waitcnt lgkmcnt(" #n ")" ::: "memory")
#define PG8_BAR __builtin_amdgcn_s_barrier()
#define PG8_SCHED __builtin_amdgcn_sched_barrier(0)
    Unit cur, nxt; int ui = 0;
    if (!S.next(0, cur)) return;
    f32x4 acc[2][2][4][2];
#pragma unroll
    for (int a = 0; a < 2; ++a)
#pragma unroll
        for (int b = 0; b < 2; ++b)
#pragma unroll
            for (int m = 0; m < 4; ++m)
#pragma unroll
                for (int n = 0; n < 2; ++n) acc[a][b][m][n] = (f32x4){0.f, 0.f, 0.f, 0.f};
    bf16x8 At[4][2], B0[2][2], B1[2][2];
    const char* cA = cur.a; const char* cB = cur.b;
    PG8_STAGE(PG8_SB(0, 0), cB, voffB); PG8_STAGE(PG8_SB(0, 1), cB + hB, voffB); PG8_STAGE(PG8_SA(0, 0), cA, voffA); PG8_STAGE(PG8_SA(0, 1), cA + hA, voffA);
    if (wr == 1) PG8_BAR;
    PG8_WAIT_V(2); PG8_BAR;
    PG8_STAGE(PG8_SB(1, 0), cB + kstep, voffB); PG8_STAGE(PG8_SA(1, 0), cA + kstep, voffA); PG8_STAGE(PG8_SB(1, 1), cB + hB + kstep, voffB);
    PG8_WAIT_V(6); PG8_BAR;
    for (;;) {
        const bool has_next = S.next(ui + 1, nxt);
        const char* nA = has_next ? nxt.a : cA; const char* nB = has_next ? nxt.b : cB;
        for (int t = 0; t < nt; t += 2) {
            const bool last = (t == nt - 2);
            const char* a1 = cA + (size_t)(t + 1) * kstep;
            const char* a2 = last ? nA : cA + (size_t)(t + 2) * kstep; const char* b2 = last ? nB : cB + (size_t)(t + 2) * kstep;
            const char* a3 = a2 + kstep; const char* b3 = b2 + kstep;
            PG8_LDB(B0, 0, 0); PG8_LDB(B1, 0, 1); PG8_SCHED; PG8_LDA(At, 0, 0); PG8_STAGE(PG8_SA(1, 1), a1 + hA, voffA);
            PG8_WAIT_V(8); PG8_WAIT_L(0); PG8_BAR; PG8_MMA(0, 0, At, B0); PG8_MMA(0, 1, At, B1); PG8_BAR; PG8_SCHED;
            PG8_LDA(At, 0, 1); PG8_STAGE(PG8_SB(0, 0), b2, voffB); PG8_STAGE(PG8_SB(0, 1), b2 + hB, voffB); PG8_STAGE(PG8_SA(0, 0), a2, voffA);
            PG8_WAIT_V(8); PG8_WAIT_L(0); PG8_BAR; PG8_MMA(1, 0, At, B0); PG8_MMA(1, 1, At, B1); PG8_BAR; PG8_SCHED;
            PG8_LDB(B0, 1, 0); PG8_LDB(B1, 1, 1); PG8_SCHED; PG8_LDA(At, 1, 0); PG8_STAGE(PG8_SA(0, 1), a2 + hA, voffA);
            PG8_WAIT_V(8); PG8_WAIT_L(0); PG8_BAR; PG8_MMA(0, 0, At, B0); PG8_MMA(0, 1, At, B1); PG8_BAR; PG8_SCHED;
            PG8_LDA(At, 1, 1); PG8_STAGE(PG8_SB(1, 0), b3, voffB); PG8_STAGE(PG8_SB(1, 1), b3 + hB, voffB); PG8_STAGE(PG8_SA(1, 0), a3, voffA);
            PG8_WAIT_V(8); PG8_WAIT_L(0); PG8_BAR; PG8_MMA(1, 0, At, B0); PG8_MMA(1, 1, At, B1); PG8_BAR; PG8_SCHED;
        }
        if (wr == 0) PG8_BAR;
        E(acc, cur, wr, wc, fr, fq);
        if (!has_next) break;
        if (!E.keep(cur)) {
#pragma unroll
        for (int a = 0; a < 2; ++a)
#pragma unroll
            for (int b = 0; b < 2; ++b)
#pragma unroll
                for (int m = 0; m < 4; ++m)
#pragma unroll
                    for (int n = 0; n < 2; ++n) acc[a][b][m][n] = (f32x4){0.f, 0.f, 0.f, 0.f};
        }
        cur = nxt; cA = nA; cB = nB; ++ui;
        if (wr == 1) PG8_BAR;
    }
    PG8_WAIT_V(0);
    PG8_BAR;
#undef PG8_SA
#undef PG8_SB
#undef PG8_STAGE
#undef PG8_LDA
#undef PG8_LDB
#undef PG8_MMA
#undef PG8_WAIT_V
#undef PG8_WAIT_L
#undef PG8_BAR
#undef PG8_SCHED
}
typedef f32x4 Acc[2][2][4][2];
#define EPI_ROW(u, ai, m) ((u).pm * 256 + (ai) * 128 + wr * 64 + (m) * 16 + fr)
#define EPI_COL(u, bj) ((u).pn * 256 + (bj) * 128 + wc * 32 + 8 * fq)

struct EpiIn {
    bf16_t* PA; float* SQP; float* SKP; bf16_t* KR; const float* ROPE;
    __device__ __forceinline__ bool keep(const Unit&) const { return false; }
    __device__ __forceinline__ void operator()(Acc& acc, const Unit& u, int wr, int wc, int fr, int fq) const {
        const int pn = u.pn; const bool act = (pn == 2 || pn == 3 || pn == 6 || pn == 7 || pn == 10 || pn == 11);
#pragma unroll
        for (int ai = 0; ai < 2; ++ai)
#pragma unroll
            for (int m = 0; m < 4; ++m) { const int row = EPI_ROW(u, ai, m); bf16_t* rowp = PA + (size_t)row * PAW + EPI_COL(u, 0);
#pragma unroll
                for (int bj = 0; bj < 2; ++bj) { f32x4 v0 = acc[ai][bj][m][0], v1 = acc[ai][bj][m][1];
                    if (act) {
#pragma unroll
                        for (int e = 0; e < 4; ++e) { v0[e] = siluf_(v0[e]); v1[e] = siluf_(v1[e]); } }
                    u32x4 w; w.x = cvtpk(v0[0], v0[1]); w.y = cvtpk(v0[2], v0[3]); w.z = cvtpk(v1[0], v1[1]); w.w = cvtpk(v1[2], v1[3]);
                    *(u32x4*)(rowp + bj * 128) = w; }
                if (pn == 4 || pn == 5) {
                    float s = 0.f;
#pragma unroll
                    for (int bj = 0; bj < 2; ++bj) if (pn == 4 || bj == 0) {
#pragma unroll
                        for (int n = 0; n < 2; ++n) { const f32x4 x = acc[ai][bj][m][n]; s += (x[0] * x[0] + x[1] * x[1]) + (x[2] * x[2] + x[3] * x[3]); } }
                    s += __shfl_xor(s, 16); s += __shfl_xor(s, 32);
                    if (fq == 0) (pn == 4 ? SQP : SKP)[(size_t)row * 4 + wc] = s;
                    if (pn == 5 && wc == 0) {
                        f32x4 o[2];
#pragma unroll
                        for (int n = 0; n < 2; ++n) { const f32x4 v = acc[ai][1][m][n]; const f32x4 cs = *(const f32x4*)(ROPE + (size_t)row * 32 + 2 * (4 * fq + 2 * n));
                            o[n][0] = v[0] * cs[0] - v[1] * cs[1]; o[n][1] = v[0] * cs[1] + v[1] * cs[0]; o[n][2] = v[2] * cs[2] - v[3] * cs[3]; o[n][3] = v[2] * cs[3] + v[3] * cs[2]; }
                        u32x4 w; w.x = cvtpk(o[0][0], o[0][1]); w.y = cvtpk(o[0][2], o[0][3]); w.z = cvtpk(o[1][0], o[1][1]); w.w = cvtpk(o[1][2], o[1][3]);
                        *(u32x4*)(KR + (size_t)row * 32 + 8 * fq) = w;
                    }
                }
                asm volatile("" ::: "memory");
            }
    }
};
struct EpiPlain {
    bf16_t* O; int ldc;
    __device__ __forceinline__ bool keep(const Unit&) const { return false; }
    __device__ __forceinline__ void operator()(Acc& acc, const Unit& u, int wr, int wc, int fr, int fq) const {
#pragma unroll
        for (int ai = 0; ai < 2; ++ai)
#pragma unroll
            for (int m = 0; m < 4; ++m) { bf16_t* rowp = O + (size_t)EPI_ROW(u, ai, m) * ldc + EPI_COL(u, 0);
#pragma unroll
                for (int bj = 0; bj < 2; ++bj) { const f32x4 v0 = acc[ai][bj][m][0], v1 = acc[ai][bj][m][1];
                    u32x4 w; w.x = cvtpk(v0[0], v0[1]); w.y = cvtpk(v0[2], v0[3]); w.z = cvtpk(v1[0], v1[1]); w.w = cvtpk(v1[2], v1[3]);
                    *(u32x4*)(rowp + bj * 128) = w; } }
    }
};
__device__ __forceinline__ unsigned q8f(float g) { const float q = fminf(fmaxf(g * 255.0f + 0.5f, 1.0f), 255.0f); return (unsigned)q; }
struct EpiGate {
    unsigned char* G8; const float* bias;
    __device__ __forceinline__ bool keep(const Unit&) const { return false; }
    __device__ __forceinline__ void operator()(Acc& acc, const Unit& u, int wr, int wc, int fr, int fq) const {
        f32x4 bv[2][2];
#pragma unroll
        for (int bj = 0; bj < 2; ++bj)
#pragma unroll
            for (int n = 0; n < 2; ++n) bv[bj][n] = *(const f32x4*)(bias + EPI_COL(u, bj) + 4 * n);
#pragma unroll
        for (int ai = 0; ai < 2; ++ai)
#pragma unroll
            for (int m = 0; m < 4; ++m) { unsigned char* rowp = G8 + (size_t)EPI_ROW(u, ai, m) * PAW + EPI_COL(u, 0);
#pragma unroll
                for (int bj = 0; bj < 2; ++bj) { f32x4 v0 = acc[ai][bj][m][0] + bv[bj][0], v1 = acc[ai][bj][m][1] + bv[bj][1];
#pragma unroll
                    for (int e = 0; e < 4; ++e) { v0[e] = sigmoidf_(v0[e]); v1[e] = sigmoidf_(v1[e]); }
                    u32x2 w; w.x = q8f(v0[0]) | (q8f(v0[1]) << 8) | (q8f(v0[2]) << 16) | (q8f(v0[3]) << 24); w.y = q8f(v1[0]) | (q8f(v1[1]) << 8) | (q8f(v1[2]) << 16) | (q8f(v1[3]) << 24);
                    *(u32x2*)(rowp + bj * 128) = w; }
                asm volatile("" ::: "memory"); }
    }
};
struct EpiQ {
    bf16_t* Q; const float* SQP; const float* ROPE;
    __device__ __forceinline__ bool keep(const Unit&) const { return false; }
    __device__ __forceinline__ void operator()(Acc& acc, const Unit& u, int wr, int wc, int fr, int fq) const {
#pragma unroll
        for (int ai = 0; ai < 2; ++ai)
#pragma unroll
            for (int m = 0; m < 4; ++m) { const int row = EPI_ROW(u, ai, m); const f32x4 sq = *(const f32x4*)(SQP + (size_t)row * 4);
                const float sr = 1.0f / sqrtf(((sq[0] + sq[1]) + (sq[2] + sq[3])) * (1.0f / 256.0f) + LN_EPS);
#pragma unroll
                for (int bj = 0; bj < 2; ++bj) { const int col = EPI_COL(u, bj); f32x4 v[2];
#pragma unroll
                    for (int n = 0; n < 2; ++n) { v[n] = acc[ai][bj][m][n] * sr; const int d = (col + 4 * n) % 96;
                        if (d >= 64) { const f32x4 cs = *(const f32x4*)(ROPE + (size_t)row * 32 + (d - 64)); const f32x4 t = v[n];
                            v[n][0] = t[0] * cs[0] - t[1] * cs[1]; v[n][1] = t[0] * cs[1] + t[1] * cs[0]; v[n][2] = t[2] * cs[2] - t[3] * cs[3]; v[n][3] = t[2] * cs[3] + t[3] * cs[2]; } }
                    u32x4 w; w.x = cvtpk(v[0][0], v[0][1]); w.y = cvtpk(v[0][2], v[0][3]); w.z = cvtpk(v[1][0], v[1][1]); w.w = cvtpk(v[1][2], v[1][3]);
                    *(u32x4*)(Q + (size_t)row * 768 + col) = w; }
                asm volatile("" ::: "memory"); }
    }
};
struct EpiKV {
    bf16_t* KN; bf16_t* V; const float* SKP;
    __device__ __forceinline__ bool keep(const Unit&) const { return false; }
    __device__ __forceinline__ void operator()(Acc& acc, const Unit& u, int wr, int wc, int fr, int fq) const {
#pragma unroll
        for (int ai = 0; ai < 2; ++ai)
#pragma unroll
            for (int m = 0; m < 4; ++m) { const int row = EPI_ROW(u, ai, m); const f32x4 sq = *(const f32x4*)(SKP + (size_t)row * 4);
                const float sr = 1.0f / sqrtf(((sq[0] + sq[1]) + (sq[2] + sq[3])) * (1.0f / 128.0f) + LN_EPS);
#pragma unroll
                for (int bj = 0; bj < 2; ++bj) { const int head = 2 * u.pn + bj, local = wc * 32 + 8 * fq; const f32x4 v0 = acc[ai][bj][m][0] * sr, v1 = acc[ai][bj][m][1] * sr;
                    u32x4 w; w.x = cvtpk(v0[0], v0[1]); w.y = cvtpk(v0[2], v0[3]); w.z = cvtpk(v1[0], v1[1]); w.w = cvtpk(v1[2], v1[3]);
                    bf16_t* dst = (wc < 2) ? KN + (size_t)row * 512 + head * 64 + local : V + (size_t)row * 512 + head * 64 + (local - 64);
                    *(u32x4*)dst = w; }
                asm volatile("" ::: "memory"); }
    }
};
struct EpiGlu {
    bf16_t* PA; const float* bglu;
    __device__ __forceinline__ bool keep(const Unit&) const { return false; }
    __device__ __forceinline__ void operator()(Acc& acc, const Unit& u, int wr, int wc, int fr, int fq) const {
        const int j0 = 128 * u.pn + wc * 32 + 8 * fq;
        f32x4 ba[2], bb[2];
#pragma unroll
        for (int n = 0; n < 2; ++n) { ba[n] = *(const f32x4*)(bglu + j0 + 4 * n); bb[n] = *(const f32x4*)(bglu + 512 + j0 + 4 * n); }
#pragma unroll
        for (int ai = 0; ai < 2; ++ai)
#pragma unroll
            for (int m = 0; m < 4; ++m) { bf16_t* p = PA + (size_t)EPI_ROW(u, ai, m) * PAW + C_ZS + j0; const u32x4 z = *(const u32x4*)p; float y[8];
#pragma unroll
                for (int n = 0; n < 2; ++n) { const f32x4 a = acc[ai][0][m][n] + ba[n], b = acc[ai][1][m][n] + bb[n];
#pragma unroll
                    for (int e = 0; e < 4; ++e) y[4 * n + e] = a[e] * sigmoidf_(b[e]); }
                u32x4 w; w.x = cvtpk(y[0] * bflo(z.x), y[1] * bfhi(z.x)); w.y = cvtpk(y[2] * bflo(z.y), y[3] * bfhi(z.y)); w.z = cvtpk(y[4] * bflo(z.z), y[5] * bfhi(z.z)); w.w = cvtpk(y[6] * bflo(z.w), y[7] * bfhi(z.w));
                *(u32x4*)p = w; asm volatile("" ::: "memory"); }
    }
};
#define UB(w, k) ((float)(((w) >> (8 * (k))) & 0xffu))
struct EpiMerge {
    const unsigned char* G8; bf16_t* MG;
    __device__ __forceinline__ bool keep(const Unit& u) const { return u.sub < 2; }
    __device__ __forceinline__ void operator()(Acc& acc, const Unit& u, int wr, int wc, int fr, int fq) const {
        const int sub = u.sub;
#pragma unroll
        for (int ai = 0; ai < 2; ++ai)
#pragma unroll
            for (int m = 0; m < 4; ++m) { const int row = EPI_ROW(u, ai, m); const unsigned char* rowp = G8 + (size_t)row * PAW + EPI_COL(u, 0);
#pragma unroll
                for (int bj = 0; bj < 2; ++bj) { const u32x2 ga = *(const u32x2*)(rowp + bj * 128 + sub * 1024);
                    float f[8] = {UB(ga.x, 0), UB(ga.x, 1), UB(ga.x, 2), UB(ga.x, 3), UB(ga.y, 0), UB(ga.y, 1), UB(ga.y, 2), UB(ga.y, 3)};
                    if (sub < 2) { const u32x2 gb = *(const u32x2*)(rowp + bj * 128 + (sub + 1) * 1024);
                        const float d[8] = {UB(gb.x, 0), UB(gb.x, 1), UB(gb.x, 2), UB(gb.x, 3), UB(gb.y, 0), UB(gb.y, 1), UB(gb.y, 2), UB(gb.y, 3)};
#pragma unroll
                        for (int e = 0; e < 8; ++e) f[e] = f[e] * __builtin_amdgcn_rcpf(d[e]); }
                    else {
#pragma unroll
                        for (int e = 0; e < 8; ++e) f[e] *= (1.0f / 255.0f); }
                    f32x4 v0 = acc[ai][bj][m][0], v1 = acc[ai][bj][m][1];
#pragma unroll
                    for (int e = 0; e < 4; ++e) { v0[e] *= f[e]; v1[e] *= f[4 + e]; }
                    acc[ai][bj][m][0] = v0; acc[ai][bj][m][1] = v1;
                    if (sub == 2) { u32x4 w; w.x = cvtpk(v0[0], v0[1]); w.y = cvtpk(v0[2], v0[3]); w.z = cvtpk(v1[0], v1[1]); w.w = cvtpk(v1[2], v1[3]); *(u32x4*)(MG + (size_t)row * DM + EPI_COL(u, bj)) = w; } } }
    }
};
struct MergeOrder {
    int G, c; const char* PA; const char* WP;
    __device__ bool next(int i, Unit& u) const {
        const int tile = (i / 3) * G + c; if (tile >= 512) return false;
        u.sub = i % 3; u.pm = tile >> 2; u.pn = tile & 3;
        const int colA = (u.sub == 0) ? C_ZS : (u.sub == 1) ? C_ZM : C_ZX;
        u.a = PA + ((size_t)u.pm * 256 * PAW + colA) * 2; u.b = WP + (size_t)u.sub * (1024 * 512 * 2) + (size_t)u.pn * (256 * 512 * 2); return true;
    }
};
struct EpiOut {
    const float* xres; float* out;
    __device__ __forceinline__ bool keep(const Unit&) const { return false; }
    __device__ __forceinline__ void operator()(Acc& acc, const Unit& u, int wr, int wc, int fr, int fq) const {
#pragma unroll
        for (int ai = 0; ai < 2; ++ai)
#pragma unroll
            for (int m = 0; m < 4; ++m) { const size_t off = (size_t)EPI_ROW(u, ai, m) * DM + EPI_COL(u, 0);
#pragma unroll
                for (int bj = 0; bj < 2; ++bj)
#pragma unroll
                    for (int n = 0; n < 2; ++n) { const f32x4 x = *(const f32x4*)(xres + off + bj * 128 + 4 * n); *(f32x4*)(out + off + bj * 128 + 4 * n) = x * ALPHA + acc[ai][bj][m][n]; } }
    }
};
}

#define MFMA32(a, b, c) __builtin_amdgcn_mfma_f32_32x32x16_bf16((a), (b), (c), 0, 0, 0)
template <int DQK, int DK1, int DV, bool CAUSAL>
__device__ __forceinline__ void attn_unit(LAS unsigned char* lds, const bf16_t* Q, int ldq, const bf16_t* K1, int ldk1, const bf16_t* K2, int ldk2,
                                          const bf16_t* V, int ldv, bf16_t* ZO, int ldo, int q0, int nt) {
    constexpr int KROW = (DQK + 8) * 2, VROW = 192, KBUF = 64 * KROW, VBUF = 64 * VROW, BUF = KBUF + VBUF;
    static_assert(DV == 64, "V tile layout assumes 64 value columns per pass");
    constexpr int KCH = DQK / 8, VCH = DV / 8, NKL = (64 * KCH + 511) / 512, NVL = (64 * VCH) / 512, NS = DQK / 16, NDB = DV / 32;
    int tid = threadIdx.x; asm volatile("" : "+v"(tid));
    const int lane = tid & 63, r = lane & 31, h = lane >> 5, w = __builtin_amdgcn_readfirstlane(tid >> 6);
    bf16x8 qf[NS];
    { const bf16_t* qrow = Q + (size_t)(q0 + 32 * w + r) * ldq + 8 * h;
#pragma unroll
      for (int s = 0; s < NS; ++s) qf[s] = *(const bf16x8*)(qrow + 16 * s); }
    f32x16 o[NDB];
#pragma unroll
    for (int db = 0; db < NDB; ++db)
#pragma unroll
        for (int i = 0; i < 16; ++i) o[db][i] = 0.f;
    float mref = 0.f, lrun = 0.f;
    f32x16 negm;
#pragma unroll
    for (int i = 0; i < 16; ++i) negm[i] = 0.f;
    u32x4 kA[NKL], vA[NVL], kB[NKL], vB[NVL];
#define ATT_LOAD(t, kreg, vreg) do { \
    _Pragma("unroll") for (int i_ = 0; i_ < NKL; ++i_) { const int c_ = tid + 512 * i_; if (c_ < 64 * KCH) { const int row_ = c_ / KCH, col_ = 8 * (c_ % KCH); const size_t kv_ = (size_t)(64 * (t) + row_); \
        const bf16_t* src_ = (col_ < DK1) ? K1 + kv_ * ldk1 + col_ : K2 + kv_ * ldk2 + (col_ - DK1); kreg[i_] = *(const u32x4*)src_; } } \
    _Pragma("unroll") for (int i_ = 0; i_ < NVL; ++i_) { const int c_ = tid + 512 * i_; const int row_ = c_ / VCH, ch_ = c_ % VCH; vreg[i_] = *(const u32x4*)(V + (size_t)(64 * (t) + row_) * ldv + 8 * ch_); } } while (0)
#define ATT_STORE(buf, kreg, vreg) do { LAS unsigned char* kb_ = lds + (buf) * BUF; LAS unsigned char* vb_ = kb_ + KBUF; \
    _Pragma("unroll") for (int i_ = 0; i_ < NKL; ++i_) { const int c_ = tid + 512 * i_; if (c_ < 64 * KCH) { const int row_ = c_ / KCH, col_ = 8 * (c_ % KCH); *(LAS u32x4*)(kb_ + row_ * KROW + col_ * 2) = kreg[i_]; } } \
    _Pragma("unroll") for (int i_ = 0; i_ < NVL; ++i_) { const int c_ = tid + 512 * i_; const int row_ = c_ / VCH, ch_ = c_ % VCH; *(LAS u32x4*)(vb_ + row_ * VROW + ch_ * 16) = vreg[i_]; } } while (0)
#define ATT_BAR() asm volatile("s_waitcnt lgkmcnt(0)\n\ts_barrier" ::: "memory")
    ATT_LOAD(0, kA, vA); ATT_STORE(0, kA, vA); ATT_LOAD(1, kA, vA); ATT_BAR();
    const int qg = q0 + 32 * w + r;
    bool first = true;
    for (int t2 = 0; t2 < nt; t2 += 2) {
#pragma unroll
      for (int u = 0; u < 2; ++u) {
        const int t = t2 + u, buf = u;
        if (u == 0) { if (t + 2 < nt) ATT_LOAD(t + 2, kB, vB); } else { if (t + 2 < nt) ATT_LOAD(t + 2, kA, vA); }
        const bool active = !CAUSAL || (64 * t <= q0 + 32 * w + 31);
        if (active) {
            LAS unsigned char* kb = lds + buf * BUF; LAS unsigned char* vb = kb + KBUF;
            f32x16 s0 = negm, s1 = negm;
            bf16x8 kf[2 * NS];
#pragma unroll
            for (int s = 0; s < NS; ++s) { kf[2 * s] = *(const LAS bf16x8*)(kb + r * KROW + (16 * s + 8 * h) * 2); kf[2 * s + 1] = *(const LAS bf16x8*)(kb + (32 + r) * KROW + (16 * s + 8 * h) * 2); }
            __builtin_amdgcn_sched_barrier(0);
#pragma unroll
            for (int s = 0; s < NS; ++s) { s0 = MFMA32(kf[2 * s], qf[s], s0); s1 = MFMA32(kf[2 * s + 1], qf[s], s1); }
            u32x2 vlo[NDB * 4], vhi[NDB * 4];
#pragma unroll
            for (int db = 0; db < NDB; ++db)
#pragma unroll
                for (int ks = 0; ks < 4; ++ks) { LAS unsigned char* vp = vb + (16 * ks + 4 * h + ((lane & 15) >> 2)) * VROW + (32 * db + 16 * ((lane >> 4) & 1) + 4 * (lane & 3)) * 2;
                    vlo[db * 4 + ks] = __builtin_bit_cast(u32x2, __builtin_amdgcn_ds_read_tr16_b64_v4i16((LAS v4i16_t*)vp)); vhi[db * 4 + ks] = __builtin_bit_cast(u32x2, __builtin_amdgcn_ds_read_tr16_b64_v4i16((LAS v4i16_t*)(vp + 8 * VROW))); }
            __builtin_amdgcn_sched_barrier(0);
            if (CAUSAL && (64 * t + 63 > q0 + 32 * w)) {
#pragma unroll
                for (int i = 0; i < 16; ++i) { const int kv = 64 * t + crow(i, h); if (kv > qg) s0[i] = -1e30f; if (kv + 32 > qg) s1[i] = -1e30f; } }
            float mx = fmaxf(fmaxf(s0[0], s1[0]), s0[1]);
#pragma unroll
            for (int i = 2; i < 16; i += 2) mx = fmaxf(fmaxf(mx, s0[i]), s0[i + 1]);
#pragma unroll
            for (int i = 1; i < 16; i += 2) mx = fmaxf(fmaxf(mx, s1[i]), s1[(i + 1) & 15]);
            { const auto rr = __builtin_amdgcn_permlane32_swap(__float_as_uint(mx), __float_as_uint(mx), false, false); mx = fmaxf(__uint_as_float(rr[0]), __uint_as_float(rr[1])); }
            if (first || __any(mx > 8.0f)) {
                const float dl = first ? mx : fmaxf(mx, 0.f); first = false; mref += dl;
                const float alpha = __builtin_amdgcn_exp2f(-dl); lrun *= alpha;
#pragma unroll
                for (int i = 0; i < 16; ++i) { s0[i] -= dl; s1[i] -= dl; negm[i] = -mref; }
#pragma unroll
                for (int db = 0; db < NDB; ++db)
#pragma unroll
                    for (int i = 0; i < 16; ++i) o[db][i] *= alpha;
            }
            float ps = 0.f;
#pragma unroll
            for (int i = 0; i < 16; ++i) { s0[i] = __builtin_amdgcn_exp2f(s0[i]); s1[i] = __builtin_amdgcn_exp2f(s1[i]); ps += s0[i] + s1[i]; }
            lrun += ps;
            bf16x8 pf[4];
#pragma unroll
            for (int s = 0; s < 2; ++s) { u32x4 a, b;
                a.x = cvtpk(s0[8 * s], s0[8 * s + 1]); a.y = cvtpk(s0[8 * s + 2], s0[8 * s + 3]); a.z = cvtpk(s0[8 * s + 4], s0[8 * s + 5]); a.w = cvtpk(s0[8 * s + 6], s0[8 * s + 7]);
                b.x = cvtpk(s1[8 * s], s1[8 * s + 1]); b.y = cvtpk(s1[8 * s + 2], s1[8 * s + 3]); b.z = cvtpk(s1[8 * s + 4], s1[8 * s + 5]); b.w = cvtpk(s1[8 * s + 6], s1[8 * s + 7]);
                pf[s] = __builtin_bit_cast(bf16x8, a); pf[2 + s] = __builtin_bit_cast(bf16x8, b); }
#pragma unroll
            for (int db = 0; db < NDB; ++db)
#pragma unroll
                for (int ks = 0; ks < 4; ++ks) {
                    u32x4 vv; vv.x = vlo[db * 4 + ks].x; vv.y = vlo[db * 4 + ks].y; vv.z = vhi[db * 4 + ks].x; vv.w = vhi[db * 4 + ks].y;
                    o[db] = MFMA32(__builtin_bit_cast(bf16x8, vv), pf[ks], o[db]); }
        }
        if (u == 0) ATT_STORE(1, kA, vA); else { if (t + 1 < nt) ATT_STORE(0, kB, vB); }
        ATT_BAR();
      }
    }
#undef ATT_LOAD
#undef ATT_STORE
#undef ATT_BAR
    const float lt = lrun + __shfl_xor(lrun, 32), inv = 1.0f / lt;
#pragma unroll
    for (int db = 0; db < NDB; ++db)
#pragma unroll
        for (int g4 = 0; g4 < 4; ++g4) { bf16_t* zp = ZO + (size_t)qg * ldo + 32 * db + 8 * g4 + 4 * h; const u32x2 z = *(const u32x2*)zp;
            u32x2 wv; wv.x = cvtpk(o[db][4 * g4] * inv * bflo(z.x), o[db][4 * g4 + 1] * inv * bfhi(z.x)); wv.y = cvtpk(o[db][4 * g4 + 2] * inv * bflo(z.y), o[db][4 * g4 + 3] * inv * bfhi(z.y));
            *(u32x2*)zp = wv; }
}

template <bool OUT>
__device__ __forceinline__ void ssm_task(LAS unsigned char* wl, int task, bf16_t* PA, const unsigned char* tab, const float* dskip, f32x2* SS) {
    int lane = threadIdx.x & 63; asm volatile("" : "+v"(lane));
    const int r = lane & 31, h = lane >> 5, row16 = lane & 15, quad = lane >> 4;
    const int chunk = task & 7, g = (task >> 3) & 31, b = task >> 8;
    const bf16_t* BBt = (const bf16_t*)tab; const bf16_t* CMt = (const bf16_t*)(tab + 128 * 1024);
    const f32x2* LAM = (const f32x2*)(tab + 256 * 1024); const f32x2* LAML = (const f32x2*)(tab + 272 * 1024);
    bf16x8 bbf[4], cmf[4];
#pragma unroll
    for (int nb = 0; nb < 4; ++nb) bbf[nb] = *(const bf16x8*)(BBt + ((size_t)(g * 128 + 32 * nb + r)) * 16 + 8 * h);
    if (OUT) {
#pragma unroll
        for (int ks = 0; ks < 4; ++ks) cmf[ks] = *(const bf16x8*)(CMt + ((size_t)(g * 16 + row16)) * 128 + 32 * ks + 8 * quad);
    }
    const f32x2 lam = LAM[g * 64 + lane];
    const float dsk = OUT ? dskip[16 * g + row16] : 0.f;
    float hr = 0.f, hi = 0.f;
    f32x2* ssb = SS + ((size_t)(b * 32 + g) * SSM_NC) * 64 + lane;
    if (OUT) { const f32x2 lL = LAML[g * 64 + lane];
        for (int k = 0; k < chunk; ++k) { const f32x2 s = ssb[(size_t)k * 64]; const float nr = lL.x * hr - lL.y * hi + s.x, ni = lL.x * hi + lL.y * hr + s.y; hr = nr; hi = ni; } }
    LAS float* W = (LAS float*)wl;
    const size_t tokc = (size_t)b * SEQ + chunk * SSM_L;
    bf16x8 uf = *(const bf16x8*)(PA + (tokc + r) * PAW + C_U + 16 * g + 8 * h);
    for (int sub = 0; sub < SSM_L / 32; ++sub) {
        const size_t tok0 = tokc + sub * 32;
        bf16x8 ufn = uf;
        if (sub + 1 < SSM_L / 32) ufn = *(const bf16x8*)(PA + (tok0 + 32 + r) * PAW + C_U + 16 * g + 8 * h);
        bf16_t uv[2][4];
        if (OUT) {
#pragma unroll
            for (int mb = 0; mb < 2; ++mb)
#pragma unroll
                for (int j = 0; j < 4; ++j) uv[mb][j] = PA[(tok0 + 16 * mb + 4 * quad + j) * PAW + C_U + 16 * g + row16];
        }
#pragma unroll
        for (int nb = 0; nb < 4; ++nb) { f32x16 z;
#pragma unroll
            for (int i = 0; i < 16; ++i) z[i] = 0.f;
            const f32x16 bu = MFMA32(uf, bbf[nb], z);
#pragma unroll
            for (int i = 0; i < 16; ++i) W[crow(i, h) * 132 + 32 * nb + r] = bu[i]; }
        LDS_WAIT();
        f32x2 bq[32];
#pragma unroll
        for (int t = 0; t < 32; ++t) bq[t] = *(const LAS f32x2*)(W + t * 132 + 2 * lane);
        LDS_WAIT();
#pragma unroll
        for (int t = 0; t < 32; ++t) { const float nr = lam.x * hr - lam.y * hi + bq[t].x, ni = lam.x * hi + lam.y * hr + bq[t].y; hr = nr; hi = ni;
            if (OUT) *(LAS unsigned*)((LAS unsigned char*)W + t * 528 + 4 * lane) = cvtpk(hr, hi); }
        if (OUT) {
            LDS_WAIT();
#pragma unroll
            for (int mb = 0; mb < 2; ++mb) { f32x4 acc = (f32x4){0.f, 0.f, 0.f, 0.f};
#pragma unroll
                for (int ks = 0; ks < 4; ++ks) { const bf16x8 af = *(const LAS bf16x8*)((LAS unsigned char*)W + (16 * mb + row16) * 528 + (32 * ks + 8 * quad) * 2);
                    acc = __builtin_amdgcn_mfma_f32_16x16x32_bf16(af, cmf[ks], acc, 0, 0, 0); }
#pragma unroll
                for (int j = 0; j < 4; ++j) { bf16_t* p = PA + (tok0 + 16 * mb + 4 * quad + j) * PAW + C_U + 16 * g + row16; const float y = acc[j] + dsk * bf2f(uv[mb][j]); *p = f2bf(gelu_tanh(y)); } }
            LDS_WAIT();
        }
        uf = ufn;
    }
    if (!OUT) ssb[(size_t)chunk * 64] = (f32x2){hr, hi};
}

enum { MAT_PLAIN = 0, MAT_WIN = 1, MAT_WGLU = 2, MAT_WUQ = 3 };
__device__ __forceinline__ void cvt_item(const float* W, int ldw, int K, bf16_t* WT, int mat, int item, int nblk, LAS float* scr, int lane, const float* kscale) {
    const int kb = item / nblk, nb = item % nblk, k0 = 64 * kb, n0 = 32 * nb, n = n0 + (lane & 31);
    int src = n; float sc = 1.f;
    if (mat == MAT_WIN) {
        if (n < 1408) src = n; else if (n < 1440) { const int j = n - 1408; src = 1408 + ((j & 1) ? 16 + (j >> 1) : (j >> 1)); } else if (n < 1536) src = -1; else src = n - 96;
        if (n >= C_QX && n < C_ZX) sc = QMEM_SCALE;
    } else if (mat == MAT_WGLU) { const int pn = n >> 8, bj = (n >> 7) & 1, i = n & 127; src = bj * 512 + 128 * pn + i; }
    else if (mat == MAT_WUQ) { const int hd = n / 96; int d = n % 96; if (d >= 64) { const int j = d - 64; d = 64 + ((j & 1) ? 16 + (j >> 1) : (j >> 1)); } src = 96 * hd + d; sc = MLA_SCALE; }
#pragma unroll 8
    for (int i = 0; i < 32; ++i) { const int kk = 2 * i + (lane >> 5); float v = (src >= 0) ? W[(size_t)(k0 + kk) * ldw + src] : 0.f; v *= sc; if (kscale) v *= kscale[k0 + kk]; scr[kk * 33 + (lane & 31)] = v; }
    LDS_WAIT();
    const int c = lane & 7;
#pragma unroll
    for (int j = 0; j < 4; ++j) { const int nn = (lane >> 3) + 8 * j; const LAS float* s = scr + (8 * c) * 33 + nn;
        u32x4 o; o.x = cvtpk(s[0 * 33], s[1 * 33]); o.y = cvtpk(s[2 * 33], s[3 * 33]); o.z = cvtpk(s[4 * 33], s[5 * 33]); o.w = cvtpk(s[6 * 33], s[7 * 33]);
        *(u32x4*)(WT + (size_t)(n0 + nn) * K + k0 + 8 * c) = o; }
    LDS_WAIT();
}

struct Args { const void* in[26]; float* out; unsigned char* ws; int ph_lo, ph_hi; };

__device__ __forceinline__ void convert_layer(const Args& a, int l, LAS float* scr, int gw, int NGW, int lane) {
    unsigned char* wb = a.ws + WS_WB;
    constexpr int I_WIN = 16 * 192, I_GLU = 8 * 32, I_UQ = 4 * 24, I_UKV = 2 * 32, I_MEM = 16 * 32, I_P = 8 * 32, I_OUT = 16 * 32;
    constexpr int NIT = I_WIN + I_GLU + I_UQ + I_UKV + I_MEM + 3 * I_P + I_OUT;
    for (int it = gw; it < NIT; it += NGW) {
        int r = it;
        if (r < I_WIN) { cvt_item((const float*)a.in[3] + (size_t)l * DM * DIN, DIN, 1024, (bf16_t*)(wb + WB_WIN), MAT_WIN, r, 192, scr, lane, nullptr); continue; } r -= I_WIN;
        if (r < I_GLU) { cvt_item((const float*)a.in[13] + (size_t)l * 512 * 1024, 1024, 512, (bf16_t*)(wb + WB_WGLU), MAT_WGLU, r, 32, scr, lane, nullptr); continue; } r -= I_GLU;
        if (r < I_UQ) { cvt_item((const float*)a.in[16] + (size_t)l * 256 * 768, 768, 256, (bf16_t*)(wb + WB_WUQ), MAT_WUQ, r, 24, scr, lane, (const float*)a.in[15] + l * 256); continue; } r -= I_UQ;
        if (r < I_UKV) { cvt_item((const float*)a.in[18] + (size_t)l * 128 * 1024, 1024, 128, (bf16_t*)(wb + WB_WUKV), MAT_PLAIN, r, 32, scr, lane, (const float*)a.in[17] + l * 128); continue; } r -= I_UKV;
        if (r < I_MEM) { cvt_item((const float*)a.in[19] + (size_t)l * 1024 * 1024, 1024, 1024, (bf16_t*)(wb + WB_WMEM), MAT_PLAIN, r, 32, scr, lane, nullptr); continue; } r -= I_MEM;
        if (r < 3 * I_P) { const int which = r / I_P; cvt_item((const float*)a.in[20 + which] + (size_t)l * 512 * 1024, 1024, 512, (bf16_t*)(wb + WB_WP) + (size_t)which * 1024 * 512, MAT_PLAIN, r % I_P, 32, scr, lane, nullptr); continue; } r -= 3 * I_P;
        cvt_item((const float*)a.in[23] + (size_t)l * 1024 * 1024, 1024, 1024, (bf16_t*)(wb + WB_WOUT), MAT_PLAIN, r, 32, scr, lane, nullptr);
    }
}


typedef unsigned gu32_plain;
#define XB_TMO      128
#define XB_XCNT(j)  (256  + 64 * (j))
#define XB_XSUB(j)  (1280 + 64 * (j))
#define XB_XGEN(j)  (2304 + 64 * (j))
#define XB_TOP      3328
#define XB_TOPGEN   3392
#define XCD_BAR_WORDS 3456
#define XB_SPIN_CAP (1u << 18)

__device__ __forceinline__ unsigned xb_ld(unsigned* p)              { return __hip_atomic_load(p, __ATOMIC_RELAXED, __HIP_MEMORY_SCOPE_AGENT); }
__device__ __forceinline__ unsigned xb_add(unsigned* p, unsigned v) { return __hip_atomic_fetch_add(p, v, __ATOMIC_RELAXED, __HIP_MEMORY_SCOPE_AGENT); }
__device__ __forceinline__ unsigned xb_xcc_id() { return (unsigned)__builtin_amdgcn_s_getreg((3 << 11) | 20) & 0xFu; }
#define XB_SPIN(cond, bar) do { unsigned _sp = 0; while (cond) { __builtin_amdgcn_s_sleep(1); \
    if ((++_sp & 255u) == 0u) { if (xb_ld(&(bar)[XB_TMO])) break; if (_sp > XB_SPIN_CAP) { atomicAdd(&(bar)[XB_TMO], 1u); break; } } } } while (0)

struct XcdBarrier {
    unsigned* bar; unsigned x;
    volatile LAS unsigned* st;
};

__device__ __forceinline__ XcdBarrier xcd_barrier_post(unsigned* bar, volatile LAS unsigned* st) {
    XcdBarrier b; b.bar = bar; b.x = xb_xcc_id(); b.st = st;
    if (threadIdx.x == 0) (void)xb_add(&bar[XB_XCNT(b.x)], 1u);
    return b;
}
__device__ __forceinline__ void xcd_barrier_complete(unsigned* bar, unsigned x, unsigned& nloc, unsigned& nx) {
    const unsigned G = gridDim.x * gridDim.y * gridDim.z;
    unsigned sum, cnt, mine, sp = 0u;
    for (;;) {
        sum = 0u; cnt = 0u; mine = 0u;
#pragma unroll
        for (unsigned j = 0; j < 16; ++j) { const unsigned c = xb_ld(&bar[XB_XCNT(j)]); sum += c; cnt += (c > 0u) ? 1u : 0u; mine = (j == x) ? c : mine; }
        if (sum == G) break;
        __builtin_amdgcn_s_sleep(1);
        if ((++sp & 255u) == 0u) { if (xb_ld(&bar[XB_TMO])) break; if (sp > XB_SPIN_CAP) { atomicAdd(&bar[XB_TMO], 1u); break; } }
    }
    nloc = mine > 0u ? mine : 1u; nx = cnt > 0u ? cnt : 1u;
}

__device__ __forceinline__ void xcd_barrier(const XcdBarrier& b) {
    asm volatile("s_waitcnt vmcnt(0)" ::: "memory");
    __syncthreads();
    if (threadIdx.x == 0) {
        unsigned* bar = b.bar;
        __builtin_amdgcn_s_waitcnt(0);
        unsigned nloc = b.st[0], nx = b.st[1];
        if (nloc == 0u) { xcd_barrier_complete(bar, b.x, nloc, nx); b.st[0] = nloc; b.st[1] = nx; }
        const unsigned old = xb_add(&bar[XB_XSUB(b.x)], 1u);
        const unsigned gen = old / nloc;
        if (old + 1u == (gen + 1u) * nloc) {
            __builtin_amdgcn_fence(__ATOMIC_RELEASE, "agent");
            asm volatile("s_waitcnt vmcnt(0)" ::: "memory");
            const unsigned og = xb_add(&bar[XB_TOP], 1u);
            const unsigned tg = og / nx;
            if (og + 1u == (tg + 1u) * nx) xb_add(&bar[XB_TOPGEN], 1u);
            else XB_SPIN(xb_ld(&bar[XB_TOPGEN]) == tg, bar);
            __builtin_amdgcn_fence(__ATOMIC_ACQUIRE, "agent");
            xb_add(&bar[XB_XGEN(b.x)], 1u);
            asm volatile("s_waitcnt vmcnt(0)" ::: "memory");
        } else {
            XB_SPIN(xb_ld(&bar[XB_XGEN(b.x)]) == gen, bar);
            __builtin_amdgcn_fence(__ATOMIC_ACQUIRE, "agent");
            asm volatile("s_waitcnt vmcnt(0)" ::: "memory");
        }
    }
    __syncthreads();
}
constexpr int NWAVES = 8, LDS_BYTES = 147456, LDS_BARST = 147392;
constexpr size_t WS_CTL = 0, CTL_BYTES = 16384;
constexpr int N_PHASES = 1 + 7 * DEPTH;

__global__ void __launch_bounds__(NWAVES * 64, 2) mk_fwd(Args args) {
    extern __shared__ __attribute__((aligned(16))) unsigned char lds_raw[];
    LAS unsigned char* lds = (LAS unsigned char*)lds_raw;
    const int G = gridDim.x, cu = blockIdx.x, NGW = G * NWAVES;
    const int vcu = (G % 8 == 0) ? (cu % 8) * (G / 8) + cu / 8 : cu;
    unsigned char* ws = args.ws;
#if !MK_MULTI
    if (threadIdx.x < 2) ((LAS unsigned*)(lds + LDS_BARST))[threadIdx.x] = 0u;
    __syncthreads();
    const XcdBarrier gbar = xcd_barrier_post((unsigned*)(ws + WS_CTL), (volatile LAS unsigned*)(lds + LDS_BARST));
#endif
    bf16_t* XB = (bf16_t*)(ws + WS_XB); bf16_t* PA = (bf16_t*)(ws + WS_PA); bf16_t* RG = (bf16_t*)(ws + WS_R);
    bf16_t* QB = (bf16_t*)(ws + WS_R + R_Q); bf16_t* KN = (bf16_t*)(ws + WS_R + R_KN); bf16_t* KR = (bf16_t*)(ws + WS_R + R_KR); bf16_t* VB = (bf16_t*)(ws + WS_R + R_V);
    bf16_t* MEMB = (bf16_t*)(ws + WS_MEMB); bf16_t* MEMKV = (bf16_t*)(ws + WS_MEMKV);
    float* SQP = (float*)(ws + WS_SQP); float* SKP = (float*)(ws + WS_SKP); float* ROPE = (float*)(ws + WS_ROPE); f32x2* SS = (f32x2*)(ws + WS_SS);
    unsigned char* wb = ws + WS_WB;
    unsigned char* G8 = ws + WS_R; bf16_t* MG = (bf16_t*)(ws + WS_R + 96 * MiB);
    bf16_t* DUMMY = (bf16_t*)(ws + WS_R + 120 * MiB);
    const float* xin = (const float*)args.in[0];
    float* out = args.out;

    if (args.ph_lo == 0 && (PHMASK & 1)) {
        int tid = threadIdx.x; asm volatile("" : "+v"(tid));
        const int lane = tid & 63, wave = __builtin_amdgcn_readfirstlane(tid >> 6), gw = cu * NWAVES + wave;

            convert_layer(args, 0, (LAS float*)(lds + wave * 16384), gw, NGW, lane);
            { const size_t n4 = (size_t)MTOK * DM / 4;
              for (size_t i = (size_t)cu * 512 + tid; i < n4; i += (size_t)G * 512) { const f32x4 v = ((const f32x4*)xin)[i]; u32x2 w; w.x = cvtpk(v[0], v[1]); w.y = cvtpk(v[2], v[3]); ((u32x2*)XB)[i] = w; } }
            { const size_t n4 = (size_t)NB * MEML * DM / 4; const float* mem = (const float*)args.in[1];
              for (size_t i = (size_t)cu * 512 + tid; i < n4; i += (size_t)G * 512) { const f32x4 v = ((const f32x4*)mem)[i]; u32x2 w; w.x = cvtpk(v[0], v[1]); w.y = cvtpk(v[2], v[3]); ((u32x2*)MEMB)[i] = w; } }
            { const int* pos = (const int*)args.in[2];
              for (int i = cu * 512 + tid; i < MTOK * 16; i += G * 512) { const int m = i >> 4, f = i & 15; const double invf = exp(-(double)f * (9.210340371976184 / 16.0)); double c, s; cossin_d((double)pos[m] * invf, c, s);
                  ROPE[(size_t)i * 2] = (float)c; ROPE[(size_t)i * 2 + 1] = (float)s; } }
            {
              for (int i = cu * 512 + tid; i < DEPTH * 32 * 64; i += G * 512) { const int p = i & 63, g = (i >> 6) & 31, l = i >> 11;
                  unsigned char* tab = ws + WS_TAB + (size_t)l * TAB_L; bf16_t* BBt = (bf16_t*)tab; bf16_t* CMt = (bf16_t*)(tab + 128 * 1024); f32x2* LAM = (f32x2*)(tab + 256 * 1024); f32x2* LAML = (f32x2*)(tab + 272 * 1024);
                  const double dt = exp((double)((const float*)args.in[7])[l * 32 + g]); const double lr = ((const float*)args.in[5])[(l * 32 + g) * 64 + p], li = ((const float*)args.in[6])[(l * 32 + g) * 64 + p];
                  const double mag = exp(lr * dt); double c, s; cossin_d(li * dt, c, s); const double lbr = mag * c, lbi = mag * s, nr = lbr - 1.0, ni = lbi, den = lr * lr + li * li;
                  const double fre = (nr * lr + ni * li) / den, fim = (ni * lr - nr * li) / den;
                  const float* bre = (const float*)args.in[8] + ((size_t)(l * 32 + g) * 64 + p) * 16; const float* bim = (const float*)args.in[9] + ((size_t)(l * 32 + g) * 64 + p) * 16;
                  for (int cc = 0; cc < 16; ++cc) { const double br = bre[cc], bi = bim[cc]; BBt[((size_t)g * 128 + 2 * p) * 16 + cc] = f2bf((float)(fre * br - fim * bi)); BBt[((size_t)g * 128 + 2 * p + 1) * 16 + cc] = f2bf((float)(fre * bi + fim * br)); }
                  const float* cre = (const float*)args.in[10] + (size_t)(l * 32 + g) * 16 * 64; const float* cim = (const float*)args.in[11] + (size_t)(l * 32 + g) * 16 * 64;
                  for (int cc = 0; cc < 16; ++cc) { CMt[((size_t)g * 16 + cc) * 128 + 2 * p] = f2bf(cre[cc * 64 + p]); CMt[((size_t)g * 16 + cc) * 128 + 2 * p + 1] = f2bf(-cim[cc * 64 + p]); }
                  LAM[g * 64 + p] = (f32x2){(float)lbr, (float)lbi};
                  const double magL = exp(lr * dt * (double)SSM_L); double cL, sL; cossin_d(li * dt * (double)SSM_L, cL, sL); LAML[g * 64 + p] = (f32x2){(float)(magL * cL), (float)(magL * sL)}; } }
#if !MK_MULTI
        if (args.ph_hi > 1) { __threadfence(); cg::this_grid().sync(); }
#endif
    }
    for (int ph = (args.ph_lo > 1 ? args.ph_lo : 1); ph < args.ph_hi; ++ph) {
        int tid = threadIdx.x; asm volatile("" : "+v"(tid));
        const int lane = tid & 63, wave = __builtin_amdgcn_readfirstlane(tid >> 6), gw = cu * NWAVES + wave;
        {
            const int l = (ph - 1) / 7, k = (ph - 1) % 7;
            const unsigned char* tab = ws + WS_TAB + (size_t)l * TAB_L;
            if (k == 0 && (PHMASK & 2)) {
#pragma unroll 1
                for (int rep = 0; rep < (PROBE_JOB == 1 ? 2 : 1); ++rep)
                { pg8::StaticOrder S; S.init(MTOK, PAW, G, cu, XB, DM, wb + WB_WIN, DM); pg8::EpiIn E{PA, SQP, SKP, KR, ROPE}; pg8::gemm_phase(lds, DM, DM, S, E); }
            } else if (k == 1 && (PHMASK & 4)) {
                { pg8::StaticOrder S; S.init(NB * MEML, 1024, G, (G == 256) ? (cu >= 128 ? cu - 128 : 1 << 20) : cu, MEMB, DM, wb + WB_WMEM, DM); pg8::EpiPlain E{MEMKV, 1024}; pg8::gemm_phase(lds, DM, DM, S, E); }
                if (K1MASK & 1) { pg8::StaticOrder S; S.init(MTOK, 768, G, cu, PA + C_CQ, PAW, wb + WB_WUQ, 256); pg8::EpiQ E{QB, SQP, ROPE}; pg8::gemm_phase(lds, 256, PAW, S, E); }
                if (K1MASK & 2) { pg8::StaticOrder S; S.init(MTOK, 1024, G, cu, PA + C_CKV, PAW, wb + WB_WUKV, 128); pg8::EpiKV E{KN, VB, SKP}; pg8::gemm_phase(lds, 128, PAW, S, E); }
#pragma unroll 1
                for (int rep = 0; rep < (PROBE_JOB == 3 ? 2 : 1); ++rep)
                if (K1MASK & 4) for (int task = gw; task < NB * 32 * SSM_NC; task += NGW) ssm_task<false>(lds + wave * 16896, task, PA, tab, (const float*)args.in[12] + l * 512, SS);
                __syncthreads();
            } else if (k == 2 && (PHMASK & 8)) {
#pragma unroll 1
                for (int rep = 0; rep < (PROBE_JOB == 4 ? 2 : 1); ++rep)
                if (K1MASK & 8) for (int ui = vcu; ui < NB * 4 * 16; ui += G) { const bool dummy = (PROBE_JOB == 4 && rep == 0); const int b = ui >> 6, hh = (ui >> 4) & 3, qb = ui & 15; const size_t t0 = (size_t)b * SEQ;
#pragma unroll 1
                    for (int e = 0; e < 2; ++e)
                    attn_unit<128, 128, 64, false>(lds, PA + t0 * PAW + C_QX + 128 * hh, PAW, MEMKV + (size_t)b * MEML * 1024 + 128 * hh, 1024, nullptr, 0,
                                                    MEMKV + (size_t)b * MEML * 1024 + 512 + 128 * hh + 64 * e, 1024, dummy ? DUMMY + t0 * 64 : PA + t0 * PAW + C_ZX + 128 * hh + 64 * e, dummy ? 64 : PAW, 256 * qb, MEML / 64); }
#pragma unroll 1
                for (int rep = 0; rep < (PROBE_JOB == 2 ? 2 : 1); ++rep)
                for (int pi = vcu; pi < NB * 8 * 8; pi += G) { const bool dummy = (PROBE_JOB == 2 && rep == 0); const int bh = pi >> 3, j = pi & 7, b = bh >> 3, hh = bh & 7; const size_t t0 = (size_t)b * SEQ;
#pragma unroll 1
                    for (int e = 0; e < 2; ++e) { const int qb = e ? 15 - j : j;
                        attn_unit<96, 64, 64, true>(lds, QB + t0 * 768 + 96 * hh, 768, KN + t0 * 512 + 64 * hh, 512, KR + t0 * 32, 32, VB + t0 * 512 + 64 * hh, 512, dummy ? DUMMY + t0 * 64 : PA + t0 * PAW + C_ZM + 64 * hh, dummy ? 64 : PAW, 256 * qb, 4 * (qb + 1)); } }
                for (int task = gw; task < NB * 32 * SSM_NC; task += NGW) ssm_task<true>(lds + wave * 16896, task, PA, tab, (const float*)args.in[12] + l * 512, SS);
                __syncthreads();
            } else if (k == 3 && (PHMASK & 16)) {
#pragma unroll 1
                for (int rep = 0; rep < (PROBE_JOB == 5 ? 2 : 1); ++rep)
                { pg8::StaticOrder S; S.init(MTOK, PAW, G, cu, XB, DM, wb + WB_WIN + (size_t)PAW * DM * 2, DM); pg8::EpiGate E{G8, (const float*)args.in[4] + l * 3072}; pg8::gemm_phase(lds, DM, DM, S, E); }
                { pg8::StaticOrder S; S.init(MTOK, 1024, G, cu, PA + C_U, PAW, wb + WB_WGLU, 512); pg8::EpiGlu E{PA, (const float*)args.in[14] + l * 1024}; pg8::gemm_phase(lds, 512, PAW, S, E); }
            } else if (k == 4 && (PHMASK & 32)) {
                { pg8::MergeOrder S{G, cu, (const char*)PA, (const char*)(wb + WB_WP)}; pg8::EpiMerge E{G8, MG}; pg8::gemm_phase(lds, 512, PAW, S, E); }
            } else if (k == 5 && (PHMASK & 64)) {
#pragma unroll 1
                for (int rep = 0; rep < (PROBE_JOB == 8 ? 2 : 1); ++rep) { const bool dummy = (PROBE_JOB == 8 && rep == 0);
                pg8::StaticOrder S; S.init(MTOK, DM, G, cu, MG, DM, wb + WB_WOUT, DM); pg8::EpiOut E{l == 0 ? xin : (const float*)out, dummy ? (float*)PA : out}; pg8::gemm_phase(lds, DM, DM, S, E); }
            } else if (k == 6 && (PHMASK & 128)) {
                const float* lg = (const float*)args.in[24] + l * DM; const float* lb = (const float*)args.in[25] + l * DM;
                f32x4 gv[4], bv[4];
#pragma unroll
                for (int j = 0; j < 4; ++j) { gv[j] = ((const f32x4*)lg)[lane + 64 * j]; bv[j] = ((const f32x4*)lb)[lane + 64 * j]; }
#pragma unroll 1
                for (int rep = 0; rep < (PROBE_JOB == 7 ? 2 : 1); ++rep) { const bool dummy = (PROBE_JOB == 7 && rep == 0);
                for (int m = gw; m < MTOK; m += NGW) { f32x4* xr = (f32x4*)(out + (size_t)m * DM) + lane; f32x4* xw = dummy ? (f32x4*)((float*)PA + (size_t)m * DM) + lane : xr; f32x4 v[4]; float s = 0.f;
#pragma unroll
                    for (int j = 0; j < 4; ++j) { v[j] = xr[64 * j]; s += (v[j][0] + v[j][1]) + (v[j][2] + v[j][3]); }
                    const float mean = wave_sum(s) * (1.f / DM); float s2 = 0.f;
#pragma unroll
                    for (int j = 0; j < 4; ++j) { v[j] = v[j] - mean; s2 += (v[j][0] * v[j][0] + v[j][1] * v[j][1]) + (v[j][2] * v[j][2] + v[j][3] * v[j][3]); }
                    const float rstd = 1.f / sqrtf(wave_sum(s2) * (1.f / DM) + LN_EPS);
                    u32x2* xb = (u32x2*)((dummy ? RG : XB) + (size_t)m * DM) + lane;
#pragma unroll
                    for (int j = 0; j < 4; ++j) { const f32x4 y = v[j] * rstd * gv[j] + bv[j]; xw[64 * j] = y; u32x2 w; w.x = cvtpk(y[0], y[1]); w.y = cvtpk(y[2], y[3]); xb[64 * j] = w; } } }
                if (l + 1 < DEPTH) convert_layer(args, l + 1, (LAS float*)(lds + wave * 16384), gw, NGW, lane);
            }
        }
#if !MK_MULTI
        if (ph + 1 < args.ph_hi) { xcd_barrier(gbar); if (PROBE_JOB == 6) { xcd_barrier(gbar); xcd_barrier(gbar); } }
#endif
    }
}

extern "C" void kernel_launch(void* const* d_in, const int* in_sizes, int n_in, void* d_out, int out_size, void* d_ws, size_t ws_size, hipStream_t stream) {
    static int grid = 0;
    if (grid == 0) {
        if (n_in != 26 || out_size != MTOK * DM || ws_size < WS_END) { fprintf(stderr, "kernel_launch: unexpected sizes n_in %d out %d ws %zu\n", n_in, out_size, ws_size); grid = -1; return; }
        int dev = 0, cus = 0, per_cu = 0;
        hipGetDevice(&dev); hipDeviceGetAttribute(&cus, hipDeviceAttributeMultiprocessorCount, dev);
        hipFuncSetAttribute((const void*)mk_fwd, hipFuncAttributeMaxDynamicSharedMemorySize, LDS_BYTES);
        hipOccupancyMaxActiveBlocksPerMultiprocessor(&per_cu, (const void*)mk_fwd, NWAVES * 64, LDS_BYTES);
        if (per_cu < 1) { fprintf(stderr, "kernel_launch: occupancy query says %d blocks/CU\n", per_cu); per_cu = 1; }
        (void)hipGetLastError();
        grid = cus * 1;
    }
    if (grid < 0) return;
    Args a{};
    for (int i = 0; i < 26; ++i) a.in[i] = d_in[i];
    a.out = (float*)d_out; a.ws = (unsigned char*)d_ws;
#if MK_MULTI
    for (int ph = 0; ph < N_PHASES; ++ph) { a.ph_lo = ph; a.ph_hi = ph + 1; hipLaunchKernelGGL(mk_fwd, dim3(grid), dim3(NWAVES * 64), LDS_BYTES, stream, a); }
#else
    a.ph_lo = 0; a.ph_hi = N_PHASES;
    if (hipMemsetAsync((char*)d_ws + WS_CTL, 0, CTL_BYTES, stream) != hipSuccess) { fprintf(stderr, "kernel_launch: memset of barrier words failed\n"); return; }
    void* kargs[] = {&a};
    hipError_t e = hipLaunchCooperativeKernel((const void*)mk_fwd, dim3(grid), dim3(NWAVES * 64), kargs, LDS_BYTES, stream);
    if (e != hipSuccess) fprintf(stderr, "cooperative launch failed: %s (grid %d)\n", hipGetErrorString(e), grid);
#endif
}
```
